# Optimizing an MI355X kernel written in HIP

```python
import jax, jax.numpy as jnp
from jax import lax
import numpy as np

D_MODEL = 2048
BATCH = 4
SEQ = 4096
DEPTH = 2

CTX_LEN = 256
GRID_W = 64
HEAD_DIM = 128
MIX_GROUP = D_MODEL // 4
POOL_WINDOWS = (2, 4, 8, 16)
POOL_GROUPS = len(POOL_WINDOWS)
POOL_DIM = MIX_GROUP
POOL_GW = POOL_DIM // POOL_GROUPS
GQA_Q_HEADS = MIX_GROUP // HEAD_DIM
GQA_KV_HEADS = GQA_Q_HEADS // 2
GQA_GROUP = GQA_Q_HEADS // GQA_KV_HEADS
GQA_Q_DIM = GQA_Q_HEADS * HEAD_DIM
GQA_KV_DIM = GQA_KV_HEADS * HEAD_DIM
ROPE_THETA = 10000.0
FNET_GROUPS = 4
FNET_DIM = MIX_GROUP
FNET_GW = FNET_DIM // FNET_GROUPS
NA_HEADS = MIX_GROUP // HEAD_DIM
NA_DIM = NA_HEADS * HEAD_DIM
NA_WIN_R = 8
NA_WIN_C = 16
IN_SPLITS = (POOL_DIM, GQA_Q_DIM, GQA_KV_DIM, GQA_KV_DIM, FNET_DIM, NA_DIM, NA_DIM, NA_DIM)
IN_DIM = sum(IN_SPLITS)
MIX_DIM = POOL_DIM + GQA_Q_DIM + FNET_DIM + NA_DIM
D_FF = ((8 * D_MODEL // 3 + 255) // 256) * 256
BLOCK_Q = 128
EPS = 1e-6
N_MOD = 9

kernel_name = "hybrid_parallel_groups_dit_block"


def rmsnorm(x, g):
    xf = x.astype(jnp.float32)
    y = xf * lax.rsqrt(jnp.mean(xf * xf, axis=-1, keepdims=True) + EPS)
    return (y * g.astype(jnp.float32)).astype(x.dtype)


def modulate(h, shift, scale):
    return h * (1.0 + scale) + shift


def swiglu(h, w_gate, w_up, w_down):
    return (jax.nn.silu(h @ w_gate) * (h @ w_up)) @ w_down


def split_in(z):
    points = np.cumsum(IN_SPLITS)[:-1].tolist()
    return jnp.split(z, points, axis=-1)


def axial_rope_tables(n):
    t = jnp.arange(n, dtype=jnp.int32)
    row = (t // GRID_W).astype(jnp.float32)
    col = (t % GRID_W).astype(jnp.float32)
    n_freq = HEAD_DIM // 4
    inv = 1.0 / (ROPE_THETA ** (jnp.arange(n_freq, dtype=jnp.float32) / n_freq))
    ang = jnp.concatenate([row[:, None] * inv, col[:, None] * inv], axis=-1)
    return jnp.cos(ang), jnp.sin(ang)


def apply_rope(x, cos, sin):
    xf = x.astype(jnp.float32).reshape(x.shape[:-1] + (HEAD_DIM // 2, 2))
    x1, x2 = xf[..., 0], xf[..., 1]
    cs, sn = cos[None, :, None, :], sin[None, :, None, :]
    out = jnp.stack([x1 * cs - x2 * sn, x1 * sn + x2 * cs], axis=-1)
    return out.reshape(x.shape).astype(x.dtype)


def block_attention(q, k, v):
    b, kh, g, n, dh = q.shape
    nb = n // BLOCK_Q
    qb = jnp.moveaxis(q.reshape(b, kh, g, nb, BLOCK_Q, dh), 3, 0)
    scale = dh ** -0.5

    def one(qblk):
        s = jnp.einsum("bkgqd,bkmd->bkgqm", qblk, k).astype(jnp.float32) * scale
        p = jax.nn.softmax(s, axis=-1).astype(v.dtype)
        return jnp.einsum("bkgqm,bkmd->bkgqd", p, v)

    o = lax.map(one, qb)
    return jnp.moveaxis(o, 0, 3).reshape(b, kh, g, n, dh)


def pool_mix(u, w_pool, scale):
    b, n, _ = u.shape
    uf = u.astype(jnp.float32)
    csum = jnp.concatenate([jnp.zeros((b, 1, POOL_DIM), jnp.float32), jnp.cumsum(uf, axis=1)], axis=1)
    t = jnp.arange(n, dtype=jnp.int32)
    outs = []
    for gi, w in enumerate(POOL_WINDOWS):
        lo = jnp.maximum(t - w // 2, 0)
        hi = jnp.minimum(t + w // 2 - 1, n - 1)
        cg = csum[..., gi * POOL_GW:(gi + 1) * POOL_GW]
        mean = (jnp.take(cg, hi + 1, axis=1) - jnp.take(cg, lo, axis=1)) / (hi - lo + 1).astype(jnp.float32)[None, :, None]
        diff = mean - uf[..., gi * POOL_GW:(gi + 1) * POOL_GW]
        outs.append(diff @ w_pool[gi].astype(jnp.float32))
    return (jnp.concatenate(outs, axis=-1) * scale.astype(jnp.float32)).astype(u.dtype)


def gqa_heads_q(q, g_norm):
    b, n, _ = q.shape
    return rmsnorm(q.reshape(b, n, GQA_Q_HEADS, HEAD_DIM), g_norm)


def gqa_ctx_kv(k, v, k_norm):
    b, m, _ = k.shape
    kh = rmsnorm(k.reshape(b, m, GQA_KV_HEADS, HEAD_DIM), k_norm).transpose(0, 2, 1, 3)
    vh = v.reshape(b, m, GQA_KV_HEADS, HEAD_DIM).transpose(0, 2, 1, 3)
    return kh, vh


def gqa_group_q(qh):
    b, n = qh.shape[:2]
    return qh.reshape(b, n, GQA_KV_HEADS, GQA_GROUP, HEAD_DIM).transpose(0, 2, 3, 1, 4)


def gqa_merge(o):
    b, n = o.shape[0], o.shape[3]
    return o.transpose(0, 3, 1, 2, 4).reshape(b, n, GQA_Q_DIM)


def gqa_latent(q, k, v, k_c, v_c, cos, sin, q_norm, k_norm):
    b, n, _ = q.shape
    qh = apply_rope(gqa_heads_q(q, q_norm), cos, sin)
    kh = apply_rope(rmsnorm(k.reshape(b, n, GQA_KV_HEADS, HEAD_DIM), k_norm), cos, sin)
    vh = v.reshape(b, n, GQA_KV_HEADS, HEAD_DIM)
    k_all = jnp.concatenate([kh.transpose(0, 2, 1, 3), k_c], axis=2)
    v_all = jnp.concatenate([vh.transpose(0, 2, 1, 3), v_c], axis=2)
    return gqa_merge(block_attention(gqa_group_q(qh), k_all, v_all))


def gqa_context(q, k_c, v_c, q_norm):
    return gqa_merge(block_attention(gqa_group_q(gqa_heads_q(q, q_norm)), k_c, v_c))


def fourier_mix(u, w_fnet):
    b, n, _ = u.shape
    ug = u.astype(jnp.float32).reshape(b, n, FNET_GROUPS, FNET_GW)
    f = jnp.fft.fft2(ug, axes=(1, 3), norm="ortho").real
    y = jnp.einsum("bngc,gcd->bngd", f, w_fnet.astype(jnp.float32))
    return y.reshape(b, n, FNET_DIM).astype(u.dtype)


def na_tables(rows):
    wr = min(NA_WIN_R, rows)
    t = jnp.arange(rows * GRID_W, dtype=jnp.int32)
    qr, qc = t // GRID_W, t % GRID_W
    rs = jnp.clip(qr - wr // 2, 0, rows - wr)
    cs = jnp.clip(qc - NA_WIN_C // 2, 0, GRID_W - NA_WIN_C)
    j = jnp.arange(wr * NA_WIN_C, dtype=jnp.int32)
    kr = rs[:, None] + (j // NA_WIN_C)[None, :]
    kc = cs[:, None] + (j % NA_WIN_C)[None, :]
    idx = kr * GRID_W + kc
    dr = kr - qr[:, None] + (NA_WIN_R - 1)
    dc = kc - qc[:, None] + (NA_WIN_C - 1)
    return idx, dr, dc


def na_heads(u):
    b, n, _ = u.shape
    return u.reshape(b, n, NA_HEADS, HEAD_DIM).transpose(0, 2, 1, 3)


def na_latent(q, k, v, k_c, v_c, idx, bias):
    b, n, _ = q.shape
    qh, kh, vh = na_heads(q), na_heads(k), na_heads(v)
    nb = n // BLOCK_Q
    kw = idx.shape[-1]
    qb = jnp.moveaxis(qh.reshape(b, NA_HEADS, nb, BLOCK_Q, HEAD_DIM), 2, 0)
    ib = idx.reshape(nb, BLOCK_Q, kw)
    bb = jnp.moveaxis(bias.reshape(NA_HEADS, nb, BLOCK_Q, kw), 1, 0)
    scale = HEAD_DIM ** -0.5

    def one(args):
        qblk, iblk, bblk = args
        kg = jnp.take(kh, iblk, axis=2)
        vg = jnp.take(vh, iblk, axis=2)
        s_loc = jnp.einsum("bhqd,bhqkd->bhqk", qblk, kg).astype(jnp.float32) * scale + bblk[None]
        s_ctx = jnp.einsum("bhqd,bhmd->bhqm", qblk, k_c).astype(jnp.float32) * scale
        p = jax.nn.softmax(jnp.concatenate([s_loc, s_ctx], axis=-1), axis=-1).astype(vh.dtype)
        return (jnp.einsum("bhqk,bhqkd->bhqd", p[..., :kw], vg)
                + jnp.einsum("bhqm,bhmd->bhqd", p[..., kw:], v_c))

    o = lax.map(one, (qb, ib, bb))
    o = jnp.moveaxis(o, 0, 2).reshape(b, NA_HEADS, n, HEAD_DIM)
    return o.transpose(0, 2, 1, 3).reshape(b, n, NA_DIM)


def na_context(q, k_c, v_c):
    b, m, _ = q.shape
    o = block_attention(na_heads(q)[:, :, None], k_c, v_c)[:, :, 0]
    return o.transpose(0, 2, 1, 3).reshape(b, m, NA_DIM)


def setup_inputs(seed: int = 0) -> dict:
    key = jax.random.key(seed)
    ks = jax.random.split(key, 24)
    f32 = jnp.float32
    L, D = DEPTH, D_MODEL

    def nrm(k, shape, s):
        return jax.random.normal(k, shape, f32) * s

    return {
        "x": nrm(ks[0], (BATCH, SEQ, D), 1.0),
        "c": nrm(ks[1], (BATCH, D), 1.0),
        "ctx": nrm(ks[2], (BATCH, CTX_LEN, D), 1.0),
        "c_ctx": nrm(ks[3], (D,), 1.0),
        "w_mod": nrm(ks[4], (L, D, N_MOD * D), 0.5 * D ** -0.5),
        "b_mod": nrm(ks[5], (L, N_MOD * D), 0.01),
        "ffn1_norm": 1.0 + nrm(ks[6], (L, D), 0.05),
        "ffn1_gate": nrm(ks[7], (L, D, D_FF), D ** -0.5),
        "ffn1_up": nrm(ks[8], (L, D, D_FF), D ** -0.5),
        "ffn1_down": nrm(ks[9], (L, D_FF, D), D_FF ** -0.5),
        "mix_norm": 1.0 + nrm(ks[10], (L, D), 0.05),
        "w_in": nrm(ks[11], (L, D, IN_DIM), D ** -0.5),
        "w_out": nrm(ks[12], (L, MIX_DIM, D), MIX_DIM ** -0.5),
        "pool_w": nrm(ks[13], (L, POOL_GROUPS, POOL_GW, POOL_GW), POOL_GW ** -0.5),
        "pool_scale": 1.0 + nrm(ks[14], (L, POOL_DIM), 0.1),
        "q_norm": 1.0 + nrm(ks[15], (L, HEAD_DIM), 0.05),
        "k_norm": 1.0 + nrm(ks[16], (L, HEAD_DIM), 0.05),
        "fnet_w": nrm(ks[17], (L, FNET_GROUPS, FNET_GW, FNET_GW), FNET_GW ** -0.5),
        "na_rpb": nrm(ks[18], (L, NA_HEADS, 2 * NA_WIN_R - 1, 2 * NA_WIN_C - 1), 0.1),
        "ffn2_norm": 1.0 + nrm(ks[19], (L, D), 0.05),
        "ffn2_gate": nrm(ks[20], (L, D, D_FF), D ** -0.5),
        "ffn2_up": nrm(ks[21], (L, D, D_FF), D ** -0.5),
        "ffn2_down": nrm(ks[22], (L, D_FF, D), D_FF ** -0.5),
        "final_norm": 1.0 + nrm(ks[23], (D,), 0.05),
    }


def reference(x, c, ctx, c_ctx, w_mod, b_mod, ffn1_norm, ffn1_gate, ffn1_up, ffn1_down,
              mix_norm, w_in, w_out, pool_w, pool_scale, q_norm, k_norm, fnet_w, na_rpb,
              ffn2_norm, ffn2_gate, ffn2_up, ffn2_down, final_norm):
    n = x.shape[1]
    rows = n // GRID_W
    cos, sin = axial_rope_tables(n)
    idx, dr, dc = na_tables(rows)
    xc = ctx
    for l in range(DEPTH):
        last = l == DEPTH - 1
        mod_x = (jax.nn.silu(c) @ w_mod[l] + b_mod[l])[:, None, :]
        mod_c = (jax.nn.silu(c_ctx)[None, :] @ w_mod[l] + b_mod[l])[:, None, :]
        sh1, sc1, g1, sh2, sc2, g2, sh3, sc3, g3 = jnp.split(mod_x, N_MOD, axis=-1)
        ch1, cs1, cg1, ch2, cs2, cg2, ch3, cs3, cg3 = jnp.split(mod_c, N_MOD, axis=-1)
        f1 = (ffn1_gate[l], ffn1_up[l], ffn1_down[l])
        f2 = (ffn2_gate[l], ffn2_up[l], ffn2_down[l])

        x = x + 0.5 * g1 * swiglu(modulate(rmsnorm(x, ffn1_norm[l]), sh1, sc1), *f1)
        xc = xc + 0.5 * cg1 * swiglu(modulate(rmsnorm(xc, ffn1_norm[l]), ch1, cs1), *f1)

        px, gqx, gkx, gvx, fx, nqx, nkx, nvx = split_in(modulate(rmsnorm(x, mix_norm[l]), sh2, sc2) @ w_in[l])
        pc, gqc, gkc, gvc, fc, nqc, nkc, nvc = split_in(modulate(rmsnorm(xc, mix_norm[l]), ch2, cs2) @ w_in[l])

        gk_c, gv_c = gqa_ctx_kv(gkc, gvc, k_norm[l])
        nk_c, nv_c = na_heads(nkc), na_heads(nvc)
        bias = na_rpb[l][:, dr, dc].astype(jnp.float32)

        y = jnp.concatenate([
            pool_mix(px, pool_w[l], pool_scale[l]),
            gqa_latent(gqx, gkx, gvx, gk_c, gv_c, cos, sin, q_norm[l], k_norm[l]),
            fourier_mix(fx, fnet_w[l]),
            na_latent(nqx, nkx, nvx, nk_c, nv_c, idx, bias),
        ], axis=-1) @ w_out[l]
        x = x + g2 * y

        if not last:
            yc = jnp.concatenate([
                pool_mix(pc, pool_w[l], pool_scale[l]),
                gqa_context(gqc, gk_c, gv_c, q_norm[l]),
                fourier_mix(fc, fnet_w[l]),
                na_context(nqc, nk_c, nv_c),
            ], axis=-1) @ w_out[l]
            xc = xc + cg2 * yc
            xc = xc + 0.5 * cg3 * swiglu(modulate(rmsnorm(xc, ffn2_norm[l]), ch3, cs3), *f2)

        x = x + 0.5 * g3 * swiglu(modulate(rmsnorm(x, ffn2_norm[l]), sh3, sc3), *f2)
    return rmsnorm(x, final_norm)
```

```cpp
#include <hip/hip_runtime.h>
#include <cstdio>
#include <cstdint>

namespace pg8 {
#define PG8_LAS __attribute__((address_space(3)))
typedef unsigned short bf16_t;
typedef short bf16x8 __attribute__((ext_vector_type(8)));
typedef float f32x4 __attribute__((ext_vector_type(4)));
typedef unsigned u32x4 __attribute__((ext_vector_type(4)));
constexpr int BM = 256, BK = 64, HALF = 128, HTB = HALF * BK * 2, STAGE_BYTES = 8 * HTB, NXCD = 8, WGM = 8;

__host__ __device__ __forceinline__ int lds_byte(int r, int c) { const int st = (r >> 4) * 2 + (c >> 5), rr = r & 15, cc = c & 31, ob = rr * 64 + cc * 2; return st * 1024 + (ob ^ (((ob >> 9) & 1) << 5)); }
__host__ __device__ __forceinline__ void stage_rc(int b, int& R, int& C) { const int st = b / 1024, sb = b % 1024, swz = sb ^ (((sb >> 9) & 1) << 5); R = (st >> 1) * 16 + swz / 64; C = (st & 1) * 32 + (swz % 64) / 2; }
__host__ __device__ __forceinline__ int perm32(int rho) { const int n = rho >> 4, i = rho & 15; return 8 * (i >> 2) + 4 * n + (i & 3); }

struct Unit { int pm, pn; };
struct Dims { int K, lda, ldb; };
__device__ __forceinline__ int fresh_tid_pg8() { int t = threadIdx.x; asm volatile("" : "+v"(t)); return t; }

struct StaticOrder {
    int nM, nN, nwg, G, c;
    __host__ __device__ void init(int M, int N, int G_, int c_) { nM = M / BM; nN = N / BM; nwg = nM * nN; G = G_; c = c_; }
    __host__ __device__ bool next(int i, Unit& u) const {
        const long L = (long)i * G + c; if (L >= nwg) return false;
        int wgid = (int)L; { const int q = nwg / NXCD, r = nwg % NXCD, xcd = wgid % NXCD, off = wgid / NXCD; wgid = (xcd < r ? xcd * (q + 1) : r * (q + 1) + (xcd - r) * q) + off; }
        const int nig = WGM * nN, gid = wgid / nig, fm = gid * WGM, gsz = (nM - fm) < WGM ? (nM - fm) : WGM;
        u.pm = fm + ((wgid % nig) % gsz); u.pn = (wgid % nig) / gsz; return true;
    }
};

__device__ __forceinline__ unsigned cvt_pk_bf16(float lo, float hi) { unsigned r; asm volatile("v_cvt_pk_bf16_f32 %0, %1, %2" : "=v"(r) : "v"(lo), "v"(hi)); return r; }

template <class Epi, class Sched, class Prob, bool ALIGN_EPI = true, bool SP2 = true>
__device__ __forceinline__ void gemm_phase(PG8_LAS unsigned char* lds, const Dims g, const Prob& P, const Sched& S, const Epi& E) {
    const int tid = fresh_tid_pg8(), wid = __builtin_amdgcn_readfirstlane(tid >> 6), lane = tid & 63, wr = wid >> 2, wc = wid & 3, fr = lane & 15, fq = lane >> 4;
    const int K = g.K, nt = K / BK;
    unsigned voffA[2], voffB[2];
#pragma unroll
    for (int i = 0; i < 2; ++i) { int R, C; stage_rc(tid * 16 + i * 8192, R, C); const int Rb = Epi::PERM ? ((R & ~31) + perm32(R & 31)) : R;
        voffA[i] = (unsigned)(R * g.lda + C) * 2u; voffB[i] = (unsigned)(Rb * g.ldb + C) * 2u; }
    const size_t kstep = (size_t)(BK * 2);
    const size_t hstepA = (size_t)HALF * g.lda * 2, hstepB = (size_t)HALF * g.ldb * 2;
    const unsigned ldsw = (unsigned)wid * 1024u;
    const int aoff = lds_byte(wr * 64 + fr, fq * 8), boff = lds_byte(wc * 32 + fr, fq * 8);
#define PG8_SA(b, h) (((b) * 2 + (h)) * HTB)
#define PG8_SB(b, h) ((4 + (b) * 2 + (h)) * HTB)
#define PG8_STAGE(bufoff, gbase, voff) do { _Pragma("unroll") for (int _i = 0; _i < 2; ++_i) \
        __builtin_amdgcn_global_load_lds((const unsigned*)((const char*)(gbase) + (voff)[_i]), (PG8_LAS unsigned*)(lds + (bufoff) + ldsw + _i * 8192), 16, 0, 0); } while (0)
#define PG8_LDA(dst, b, h) do { _Pragma("unroll") for (int m = 0; m < 4; ++m) _Pragma("unroll") for (int k = 0; k < 2; ++k) dst[m][k] = *(const PG8_LAS bf16x8*)(lds + PG8_SA(b, h) + aoff + m * 2048 + k * 1024); } while (0)
#define PG8_LDB(dst, b, h) do { _Pragma("unroll") for (int n = 0; n < 2; ++n) _Pragma("unroll") for (int k = 0; k < 2; ++k) dst[n][k] = *(const PG8_LAS bf16x8*)(lds + PG8_SB(b, h) + boff + n * 2048 + k * 1024); } while (0)
#define PG8_MMA(ai, bj, At, Bt) do { __builtin_amdgcn_s_setprio(1); _Pragma("unroll") for (int m = 0; m < 4; ++m) _Pragma("unroll") for (int n = 0; n < 2; ++n) _Pragma("unroll") for (int k = 0; k < 2; ++k) \
        acc[ai][bj][m][n] = __builtin_amdgcn_mfma_f32_16x16x32_bf16(Bt[n][k], At[m][k], acc[ai][bj][m][n], 0, 0, 0); __builtin_amdgcn_s_setprio(0); } while (0)
#define PG8_WAIT_V(n) asm volatile("s_waitcnt vmcnt(" #n ")" ::: "memory")
#define PG8_WAIT_L(n) asm volatile("s_waitcnt lgkmcnt(" #n ")" ::: "memory")
#define PG8_BAR __builtin_amdgcn_s_barrier()
#define PG8_SCHED __builtin_amdgcn_sched_barrier(0)
    Unit cur, nxt; int ui = 0;
    if (!S.next(0, cur)) return;
    f32x4 acc[2][2][4][2];
#pragma unroll
    for (int a = 0; a < 2; ++a)
#pragma unroll
        for (int b = 0; b < 2; ++b)
#pragma unroll
            for (int m = 0; m < 4; ++m)
#pragma unroll
                for (int n = 0; n < 2; ++n) acc[a][b][m][n] = (f32x4){0.f, 0.f, 0.f, 0.f};
    bf16x8 At[4][2], B0[2][2], B1[2][2];
    const char* cA = P.a_panel(cur); const char* cB = P.b_panel(cur);
    if constexpr (SP2) {
        PG8_STAGE(PG8_SB(0, 0), cB, voffB); PG8_STAGE(PG8_SB(0, 1), cB + hstepB, voffB); PG8_STAGE(PG8_SA(0, 0), cA, voffA); PG8_STAGE(PG8_SA(0, 1), cA + hstepA, voffA);
        if (wr == 1) PG8_BAR;
        PG8_WAIT_V(2); PG8_BAR;
        PG8_STAGE(PG8_SB(1, 0), cB + kstep, voffB); PG8_STAGE(PG8_SA(1, 0), cA + kstep, voffA); PG8_STAGE(PG8_SB(1, 1), cB + hstepB + kstep, voffB);
        PG8_WAIT_V(6); PG8_BAR;
    } else {
        PG8_STAGE(PG8_SB(0, 0), cB, voffB); PG8_STAGE(PG8_SA(0, 0), cA, voffA); PG8_STAGE(PG8_SB(0, 1), cB + hstepB, voffB); PG8_STAGE(PG8_SA(0, 1), cA + hstepA, voffA);
        if (wr == 1) PG8_BAR;
        PG8_WAIT_V(4); PG8_BAR;
        PG8_STAGE(PG8_SB(1, 0), cB + kstep, voffB); PG8_STAGE(PG8_SA(1, 0), cA + kstep, voffA); PG8_STAGE(PG8_SB(1, 1), cB + hstepB + kstep, voffB);
        PG8_WAIT_V(6); PG8_BAR;
    }
    for (;;) {
        const bool has_next = S.next(ui + 1, nxt);
        const char* nA = has_next ? P.a_panel(nxt) : cA; const char* nB = has_next ? P.b_panel(nxt) : cB;
        for (int t = 0; t < nt; t += 2) {
            const bool last = (t == nt - 2);
            const char* a1 = cA + (size_t)(t + 1) * kstep;
            const char* a2 = last ? nA : cA + (size_t)(t + 2) * kstep; const char* b2 = last ? nB : cB + (size_t)(t + 2) * kstep;
            const char* a3 = a2 + kstep; const char* b3 = b2 + kstep;
            if constexpr (SP2) {
            PG8_LDB(B0, 0, 0); PG8_LDB(B1, 0, 1); PG8_SCHED; PG8_LDA(At, 0, 0); PG8_STAGE(PG8_SA(1, 1), a1 + hstepA, voffA);
            PG8_WAIT_V(8); PG8_WAIT_L(0); PG8_BAR; PG8_MMA(0, 0, At, B0); PG8_MMA(0, 1, At, B1); PG8_BAR; PG8_SCHED;
            PG8_LDA(At, 0, 1); PG8_STAGE(PG8_SB(0, 0), b2, voffB); PG8_STAGE(PG8_SB(0, 1), b2 + hstepB, voffB); PG8_STAGE(PG8_SA(0, 0), a2, voffA);
            PG8_WAIT_V(8); PG8_WAIT_L(0); PG8_BAR; PG8_MMA(1, 0, At, B0); PG8_MMA(1, 1, At, B1); PG8_BAR; PG8_SCHED;
            PG8_LDB(B0, 1, 0); PG8_LDB(B1, 1, 1); PG8_SCHED; PG8_LDA(At, 1, 0); PG8_STAGE(PG8_SA(0, 1), a2 + hstepA, voffA);
            PG8_WAIT_V(8); PG8_WAIT_L(0); PG8_BAR; PG8_MMA(0, 0, At, B0); PG8_MMA(0, 1, At, B1); PG8_BAR; PG8_SCHED;
            PG8_LDA(At, 1, 1); PG8_STAGE(PG8_SB(1, 0), b3, voffB); PG8_STAGE(PG8_SB(1, 1), b3 + hstepB, voffB); PG8_STAGE(PG8_SA(1, 0), a3, voffA);
            PG8_WAIT_V(8); PG8_WAIT_L(0); PG8_BAR; PG8_MMA(1, 0, At, B0); PG8_MMA(1, 1, At, B1); PG8_BAR; PG8_SCHED;
            } else {
            PG8_LDB(B0, 0, 0); PG8_SCHED; PG8_LDA(At, 0, 0); PG8_STAGE(PG8_SA(1, 1), a1 + hstepA, voffA);
            PG8_WAIT_L(8); PG8_BAR; PG8_WAIT_L(0); PG8_MMA(0, 0, At, B0); PG8_BAR; PG8_SCHED;
            PG8_LDB(B1, 0, 1); PG8_STAGE(PG8_SB(0, 0), b2, voffB);
            PG8_BAR; PG8_WAIT_L(0); PG8_MMA(0, 1, At, B1); PG8_BAR;
            PG8_LDA(At, 0, 1); PG8_STAGE(PG8_SA(0, 0), a2, voffA);
            PG8_BAR; PG8_WAIT_L(0); PG8_MMA(1, 0, At, B0); PG8_BAR; PG8_SCHED;
            PG8_STAGE(PG8_SB(0, 1), b2 + hstepB, voffB);
            PG8_WAIT_V(6); PG8_BAR; PG8_MMA(1, 1, At, B1); PG8_BAR;
            PG8_LDB(B0, 1, 0); PG8_SCHED; PG8_LDA(At, 1, 0); PG8_STAGE(PG8_SA(0, 1), a2 + hstepA, voffA);
            PG8_WAIT_L(8); PG8_BAR; PG8_WAIT_L(0); PG8_MMA(0, 0, At, B0); PG8_BAR; PG8_SCHED;
            PG8_LDB(B1, 1, 1); PG8_STAGE(PG8_SB(1, 0), b3, voffB);
            PG8_BAR; PG8_WAIT_L(0); PG8_MMA(0, 1, At, B1); PG8_BAR;
            PG8_LDA(At, 1, 1); PG8_STAGE(PG8_SA(1, 0), a3, voffA);
            PG8_BAR; PG8_WAIT_L(0); PG8_MMA(1, 0, At, B0); PG8_BAR; PG8_SCHED;
            PG8_STAGE(PG8_SB(1, 1), b3 + hstepB, voffB);
            PG8_WAIT_V(6); PG8_BAR; PG8_MMA(1, 1, At, B1); PG8_BAR;
            }
        }
        if constexpr (ALIGN_EPI) { if (wr == 0) PG8_BAR; }
        E(acc, cur, wr, wc, fr, fq);
        if (!has_next) break;
#pragma unroll
        for (int a = 0; a < 2; ++a)
#pragma unroll
            for (int b = 0; b < 2; ++b)
#pragma unroll
                for (int m = 0; m < 4; ++m)
#pragma unroll
                    for (int n = 0; n < 2; ++n) acc[a][b][m][n] = (f32x4){0.f, 0.f, 0.f, 0.f};
        cur = nxt; cA = nA; cB = nB; ++ui;
        if constexpr (ALIGN_EPI) { if (wr == 1) PG8_BAR; }
    }
    PG8_WAIT_V(0);
    if constexpr (!ALIGN_EPI) { if (wr == 0) PG8_BAR; }
    PG8_BAR;
#undef PG8_SA
#undef PG8_SB
#undef PG8_STAGE
#undef PG8_LDA
#undef PG8_LDB
#undef PG8_MMA
#undef PG8_WAIT_V
#undef PG8_WAIT_L
#undef PG8_BAR
#undef PG8_SCHED
}
}

constexpr int NWAVES = 8, NTHR = 512;
constexpr int NB = 4, SEQ = 4096, CTXL = 256, DM = 2048, FF = 5632, NGU = 2 * FF, NL = 2;
constexpr int TX = NB * SEQ, TC = NB * CTXL, T = TX + TC;
constexpr int ZW = 3072;
constexpr int ZP = 0, ZGQ = 512, ZGK = 1024, ZGV = 1280, ZNQ = 1536, ZNK = 2048, ZNV = 2560;
constexpr int NIN = 4096;
constexpr int LDT = 2 * NB * SEQ + 64, LDTC = 2 * NB * CTXL + 64;
constexpr int NMOD = 9 * DM;
constexpr float EPS = 1e-6f;
constexpr int IN_DIM = 3584;

constexpr size_t MiB = 1u << 20;
constexpr size_t WS_CTL = 0, CTL_ZERO_BYTES = 1 * MiB;
constexpr size_t WS_MODV = 1 * MiB;
constexpr size_t WS_ROPE = 1 * MiB + 768 * 1024;
constexpr size_t WS_DFTC = 2 * MiB;
constexpr size_t WS_ABTC = 3 * MiB;
constexpr size_t WS_W = 8 * MiB, W_LAYER = 156 * MiB;
constexpr size_t WO_GU1 = 0, WO_D1 = 44 * MiB, WO_IN = 66 * MiB, WO_OUT = 82 * MiB, WO_GU2 = 90 * MiB, WO_D2 = 134 * MiB;
constexpr size_t WS_DFTM = 320 * MiB;
constexpr size_t WS_XS = 384 * MiB;
constexpr size_t WS_H = 520 * MiB;
constexpr size_t WS_GU = 588 * MiB;
constexpr size_t WS_Z = 588 * MiB;
constexpr size_t WS_CC = 690 * MiB;
constexpr size_t WS_ABT = 775 * MiB;
constexpr size_t WS_END = 808 * MiB;
static_assert(WS_Z + (size_t)T * ZW * 2 <= WS_CC && WS_CC + (size_t)T * DM * 2 <= WS_GU + (size_t)T * FF * 2 && WS_GU + (size_t)T * FF * 2 <= WS_ABT && WS_ABT + (size_t)512 * LDT * 2 <= WS_END, "ws map");
static_assert(WS_XS + (size_t)T * DM * 4 <= WS_H && WS_H + (size_t)T * DM * 2 <= WS_GU && WS_DFTM + (size_t)4096 * 8192 * 2 <= WS_XS && WS_W + NL * W_LAYER <= WS_DFTM, "ws map 2");
constexpr int CW_BAR = 4096;

constexpr int RING_BYTES = 131072, LDSCTL_OFF = RING_BYTES, MISC_OFF = LDSCTL_OFF + 320, LDS_BYTES = 147456;

#define GAS __attribute__((address_space(1)))
#define LAS __attribute__((address_space(3)))
typedef unsigned short bf16;
typedef unsigned v4u __attribute__((ext_vector_type(4)));
typedef unsigned v2u __attribute__((ext_vector_type(2)));
typedef float f32x4 __attribute__((ext_vector_type(4)));
typedef float f32x2 __attribute__((ext_vector_type(2)));
#define LDS_WAIT() asm volatile("s_waitcnt lgkmcnt(0)" ::: "memory")
__device__ __forceinline__ unsigned f2bf(float f) { unsigned u = __builtin_bit_cast(unsigned, f); return (u + 0x7fffu + ((u >> 16) & 1u)) >> 16; }
__device__ __forceinline__ unsigned pk2(float lo, float hi) { return f2bf(lo) | (f2bf(hi) << 16); }
__device__ __forceinline__ float bflo(unsigned w) { return __builtin_bit_cast(float, w << 16); }
__device__ __forceinline__ float bfhi(unsigned w) { return __builtin_bit_cast(float, w & 0xffff0000u); }

#define XB_TMO      128
#define XB_XCNT(j)  (256  + 64 * (j))
#define XB_XSUB(j)  (1280 + 64 * (j))
#define XB_XGEN(j)  (2304 + 64 * (j))
#define XB_TOP      3328
#define XB_TOPGEN   3392
#define XCD_BAR_WORDS 3456
#define XB_SPIN_CAP (1u << 18)
__device__ __forceinline__ unsigned xb_ld(unsigned* p)              { return __hip_atomic_load(p, __ATOMIC_RELAXED, __HIP_MEMORY_SCOPE_AGENT); }
__device__ __forceinline__ unsigned xb_add(unsigned* p, unsigned v) { return __hip_atomic_fetch_add(p, v, __ATOMIC_RELAXED, __HIP_MEMORY_SCOPE_AGENT); }
__device__ __forceinline__ unsigned xb_xcc_id() { return (unsigned)__builtin_amdgcn_s_getreg((3 << 11) | 20) & 0xFu; }
#define XB_SPIN(cond, bar) do { unsigned _sp = 0; while (cond) { __builtin_amdgcn_s_sleep(1); \
    if ((++_sp & 255u) == 0u) { if (xb_ld(&(bar)[XB_TMO])) break; if (_sp > XB_SPIN_CAP) { atomicAdd(&(bar)[XB_TMO], 1u); break; } } } } while (0)
struct XcdBarrier { unsigned* bar; unsigned x; volatile LAS unsigned* st; };
__device__ __forceinline__ XcdBarrier xcd_barrier_post(unsigned* bar, volatile LAS unsigned* st) {
    XcdBarrier b; b.bar = bar; b.x = xb_xcc_id(); b.st = st;
    if (threadIdx.x == 0) (void)xb_add(&bar[XB_XCNT(b.x)], 1u);
    return b;
}
__device__ __forceinline__ void xcd_barrier_complete(unsigned* bar, unsigned x, unsigned& nloc, unsigned& nx) {
    const unsigned G = gridDim.x * gridDim.y * gridDim.z;
    unsigned sum, cnt, mine, sp = 0u;
    for (;;) {
        sum = 0u; cnt = 0u; mine = 0u;
#pragma unroll
        for (unsigned j = 0; j < 16; ++j) { const unsigned c = xb_ld(&bar[XB_XCNT(j)]); sum += c; cnt += (c > 0u) ? 1u : 0u; mine = (j == x) ? c : mine; }
        if (sum == G) break;
        __builtin_amdgcn_s_sleep(1);
        if ((++sp & 255u) == 0u) { if (xb_ld(&bar[XB_TMO])) break; if (sp > XB_SPIN_CAP) { atomicAdd(&bar[XB_TMO], 1u); break; } }
    }
    nloc = mine > 0u ? mine : 1u; nx = cnt > 0u ? cnt : 1u;
}
__device__ __forceinline__ void xcd_barrier(const XcdBarrier& b) {
    asm volatile("s_waitcnt vmcnt(0)" ::: "memory");
    __syncthreads();
    if (threadIdx.x == 0) {
        unsigned* bar = b.bar;
        __builtin_amdgcn_s_waitcnt(0);
        unsigned nloc = b.st[0], nx = b.st[1];
        if (nloc == 0u) { xcd_barrier_complete(bar, b.x, nloc, nx); b.st[0] = nloc; b.st[1] = nx; }
        const unsigned old = xb_add(&bar[XB_XSUB(b.x)], 1u);
        const unsigned gen = old / nloc;
        if (old + 1u == (gen + 1u) * nloc) {
            __builtin_amdgcn_fence(__ATOMIC_RELEASE, "agent");
            asm volatile("s_waitcnt vmcnt(0)" ::: "memory");
            const unsigned og = xb_add(&bar[XB_TOP], 1u);
            const unsigned tg = og / nx;
            if (og + 1u == (tg + 1u) * nx) xb_add(&bar[XB_TOPGEN], 1u);
            else XB_SPIN(xb_ld(&bar[XB_TOPGEN]) == tg, bar);
            __builtin_amdgcn_fence(__ATOMIC_ACQUIRE, "agent");
            xb_add(&bar[XB_XGEN(b.x)], 1u);
            asm volatile("s_waitcnt vmcnt(0)" ::: "memory");
        } else {
            XB_SPIN(xb_ld(&bar[XB_XGEN(b.x)]) == gen, bar);
            __builtin_amdgcn_fence(__ATOMIC_ACQUIRE, "agent");
            asm volatile("s_waitcnt vmcnt(0)" ::: "memory");
        }
    }
    __syncthreads();
}

struct Args {
    const float *x, *c, *ctx, *c_ctx, *w_mod, *b_mod, *ffn1_norm, *ffn1_gate, *ffn1_up, *ffn1_down, *mix_norm, *w_in, *w_out, *pool_w, *pool_scale,
                *q_norm, *k_norm, *fnet_w, *na_rpb, *ffn2_norm, *ffn2_gate, *ffn2_up, *ffn2_down, *final_norm;
    float* out; unsigned char* ws;
};
struct Ctx {
    LAS unsigned char* lds; int wave, wg, G;
};
__device__ __forceinline__ int fresh_tid() { int t = threadIdx.x; asm volatile("" : "+v"(t)); return t; }
__device__ __forceinline__ float wave_sum(float v) {
#pragma unroll
    for (int o = 1; o < 64; o <<= 1) v += __shfl_xor(v, o);
    return v;
}

struct EpiSwiglu {
    static constexpr bool PERM = true;
    bf16* GU;
    __device__ __forceinline__ void operator()(const pg8::f32x4 (&acc)[2][2][4][2], const pg8::Unit& u, int wr, int wc, int fr, int fq) const {
        const int row0 = u.pm * 256 + wr * 64 + fr, col0 = u.pn * 128 + wc * 32 + 8 * fq;
#pragma unroll
        for (int ai = 0; ai < 2; ++ai)
#pragma unroll
            for (int m = 0; m < 4; ++m) {
                float r[8];
#pragma unroll
                for (int n = 0; n < 2; ++n)
#pragma unroll
                    for (int j = 0; j < 4; ++j) { const float g = acc[ai][0][m][n][j], up = acc[ai][1][m][n][j];
                        const float e = __builtin_amdgcn_exp2f(-g * 1.4426950408889634f); r[n * 4 + j] = g * __builtin_amdgcn_rcpf(1.0f + e) * up; }
                v4u w; w.x = pg8::cvt_pk_bf16(r[0], r[1]); w.y = pg8::cvt_pk_bf16(r[2], r[3]); w.z = pg8::cvt_pk_bf16(r[4], r[5]); w.w = pg8::cvt_pk_bf16(r[6], r[7]);
                *(v4u*)(GU + (size_t)(row0 + ai * 128 + m * 16) * FF + col0) = w; }
    }
};
struct EpiResid {
    static constexpr bool PERM = false;
    const float* base_x; const float* base_c;
    float* XS; const float* gate;
    float coef;
    __device__ __forceinline__ void operator()(const pg8::f32x4 (&acc)[2][2][4][2], const pg8::Unit& u, int wr, int wc, int fr, int fq) const {
        const int s = u.pm < 64 ? (u.pm >> 4) : 4;
        const float* bp = u.pm < 64 ? base_x + (size_t)u.pm * 256 * DM : base_c + (size_t)(u.pm - 64) * 256 * DM;
        float* op = XS + (size_t)u.pm * 256 * DM;
        const int r0 = wr * 64 + fr, col0 = u.pn * 256 + wc * 32 + 4 * fq;
        f32x4 gv[2][2];
#pragma unroll
        for (int bj = 0; bj < 2; ++bj)
#pragma unroll
            for (int n = 0; n < 2; ++n) gv[bj][n] = *(const f32x4*)(gate + (size_t)s * NMOD + col0 + bj * 128 + n * 16) * coef;
#pragma unroll
        for (int ai = 0; ai < 2; ++ai)
#pragma unroll
            for (int m = 0; m < 4; ++m) { const size_t off = (size_t)(r0 + ai * 128 + m * 16) * DM + col0;
#pragma unroll
                for (int bj = 0; bj < 2; ++bj)
#pragma unroll
                    for (int n = 0; n < 2; ++n) { const f32x4 b = *(const f32x4*)(bp + off + bj * 128 + n * 16); *(f32x4*)(op + off + bj * 128 + n * 16) = b + gv[bj][n] * acc[ai][bj][m][n]; } }
    }
};
struct EpiZ {
    static constexpr bool PERM = true;
    bf16* Z; bf16* ABT; bf16* ABTC;
    __device__ __forceinline__ void operator()(const pg8::f32x4 (&acc)[2][2][4][2], const pg8::Unit& u, int wr, int wc, int fr, int fq) const {
        bf16* base; size_t ld;
        if (u.pn < 12) { base = Z + (size_t)u.pm * 256 * ZW + u.pn * 256; ld = ZW; }
        else { const int cc = (u.pn - 12) * 256, trig = cc >> 9, c0 = cc & 511;
            if (u.pm < 64) { const int b = u.pm >> 4, n0 = (u.pm & 15) * 256; base = ABT + (size_t)c0 * LDT + b * (2 * SEQ) + trig * SEQ + n0; ld = LDT; }
            else { const int b = u.pm - 64; base = ABTC + (size_t)c0 * LDTC + b * (2 * CTXL) + trig * CTXL; ld = LDTC; } }
        const int r0 = wr * 64 + fr, col0 = wc * 32 + 8 * fq;
#pragma unroll
        for (int ai = 0; ai < 2; ++ai)
#pragma unroll
            for (int m = 0; m < 4; ++m) { bf16* rowp = base + (size_t)(r0 + ai * 128 + m * 16) * ld + col0;
#pragma unroll
                for (int bj = 0; bj < 2; ++bj) { const pg8::f32x4 v0 = acc[ai][bj][m][0], v1 = acc[ai][bj][m][1];
                    v4u w; w.x = pg8::cvt_pk_bf16(v0[0], v0[1]); w.y = pg8::cvt_pk_bf16(v0[2], v0[3]); w.z = pg8::cvt_pk_bf16(v1[0], v1[1]); w.w = pg8::cvt_pk_bf16(v1[2], v1[3]);
                    *(v4u*)(rowp + bj * 128) = w; } }
    }
};
struct EpiBf16Plain {
    static constexpr bool PERM = true;
    bf16* O; int ldc;
    __device__ __forceinline__ void operator()(const pg8::f32x4 (&acc)[2][2][4][2], const pg8::Unit& u, int wr, int wc, int fr, int fq) const {
        bf16* base = O + (size_t)u.pm * 256 * ldc + u.pn * 256;
        const int r0 = wr * 64 + fr, col0 = wc * 32 + 8 * fq;
#pragma unroll
        for (int ai = 0; ai < 2; ++ai)
#pragma unroll
            for (int m = 0; m < 4; ++m) { bf16* rowp = base + (size_t)(r0 + ai * 128 + m * 16) * ldc + col0;
#pragma unroll
                for (int bj = 0; bj < 2; ++bj) { const pg8::f32x4 v0 = acc[ai][bj][m][0], v1 = acc[ai][bj][m][1];
                    v4u w; w.x = pg8::cvt_pk_bf16(v0[0], v0[1]); w.y = pg8::cvt_pk_bf16(v0[2], v0[3]); w.z = pg8::cvt_pk_bf16(v1[0], v1[1]); w.w = pg8::cvt_pk_bf16(v1[2], v1[3]);
                    *(v4u*)(rowp + bj * 128) = w; } }
    }
};
struct ProbPlain { const char* A; const char* B; size_t ta, tb;
    __device__ __forceinline__ const char* a_panel(const pg8::Unit& u) const { return A + (size_t)u.pm * ta; }
    __device__ __forceinline__ const char* b_panel(const pg8::Unit& u) const { return B + (size_t)u.pn * tb; } };
struct ProbInFt { const char* H; const char* W;
    __device__ __forceinline__ const char* a_panel(const pg8::Unit& u) const { return u.pn < 12 ? H + (size_t)u.pm * (256 * DM * 2) : W + (size_t)u.pn * (256 * DM * 2); }
    __device__ __forceinline__ const char* b_panel(const pg8::Unit& u) const { return u.pn < 12 ? W + (size_t)u.pn * (256 * DM * 2) : H + (size_t)u.pm * (256 * DM * 2); } };
struct ProbDft { const char* A; int amask; size_t astride; const char* B; int bshift; size_t bbatch, bpanel;
    __device__ __forceinline__ const char* a_panel(const pg8::Unit& u) const { return A + (size_t)(u.pm & amask) * astride; }
    __device__ __forceinline__ const char* b_panel(const pg8::Unit& u) const { return B + (size_t)(u.pm >> bshift) * bbatch + (size_t)u.pn * bpanel; } };

__device__ __forceinline__ void transpose_tile(const float* W, int ldw, int k0, int n0, bf16* WT, int ldt, int drow0, LAS float* scr, int lane) {
#pragma unroll 8
    for (int i = 0; i < 32; ++i) { const int kk = 2 * i + (lane >> 5); scr[kk * 33 + (lane & 31)] = W[(size_t)(k0 + kk) * ldw + n0 + (lane & 31)]; }
    LDS_WAIT(); asm volatile("" ::: "memory");
    const int c = lane & 7;
#pragma unroll
    for (int j = 0; j < 4; ++j) { const int n = (lane >> 3) + 8 * j; const LAS float* s = scr + (8 * c) * 33 + n;
        v4u o; o.x = pk2(s[0 * 33], s[1 * 33]); o.y = pk2(s[2 * 33], s[3 * 33]); o.z = pk2(s[4 * 33], s[5 * 33]); o.w = pk2(s[6 * 33], s[7 * 33]);
        *(GAS v4u*)(WT + (size_t)(drow0 + n) * ldt + k0 + 8 * c) = o; }
    LDS_WAIT(); asm volatile("" ::: "memory");
}
constexpr int CV_GU = (DM / 64) * (FF / 256), CV_D = (FF / 64) * (DM / 256), CV_IN = (DM / 64) * 10, CV_OUT = (DM / 64) * (DM / 256);
constexpr int CONV_PER_LAYER = 4 * CV_GU + 2 * CV_D + CV_IN + CV_OUT;
__device__ __forceinline__ void conv_item(const Ctx& C, const Args& a, int it) {
    const int lane = fresh_tid() & 63;
    const int l = it / CONV_PER_LAYER; int r = it % CONV_PER_LAYER;
    unsigned char* wl = a.ws + WS_W + (size_t)l * W_LAYER;
    LAS float* scr = (LAS float*)(C.lds + C.wave * 16384);
    const float* W; int ldw, kb, nb, ldt; bf16* WT; int mode;
    if (r < 4 * CV_GU) { const int which = r / CV_GU; r %= CV_GU;
        W = ((which == 0) ? a.ffn1_gate : (which == 1) ? a.ffn1_up : (which == 2) ? a.ffn2_gate : a.ffn2_up) + (size_t)l * DM * FF;
        ldw = FF; kb = r / (FF / 256); nb = r % (FF / 256); WT = (bf16*)(wl + ((which < 2) ? WO_GU1 : WO_GU2)); ldt = DM; mode = which & 1; }
    else if ((r -= 4 * CV_GU) < 2 * CV_D) { const int which = r / CV_D; r %= CV_D;
        W = (which ? a.ffn2_down : a.ffn1_down) + (size_t)l * FF * DM; ldw = DM; kb = r / (DM / 256); nb = r % (DM / 256); WT = (bf16*)(wl + (which ? WO_D2 : WO_D1)); ldt = FF; mode = 2; }
    else if ((r -= 2 * CV_D) < CV_IN) { W = a.w_in + (size_t)l * DM * IN_DIM; ldw = IN_DIM; kb = r / 10; nb = r % 10; WT = (bf16*)(wl + WO_IN); ldt = DM; mode = 3; }
    else { r -= CV_IN; W = a.w_out + (size_t)l * DM * DM; ldw = DM; kb = r / (DM / 256); nb = r % (DM / 256); WT = (bf16*)(wl + WO_OUT); ldt = DM; mode = 2; }
    int n0 = nb * 256 + C.wave * 32, drow0;
    if (mode == 3) { n0 = (nb < 4 ? 512 + nb * 256 : 2048 + (nb - 4) * 256) + C.wave * 32; drow0 = n0 < 2048 ? n0 : n0 - 512; }
    else if (mode == 2) drow0 = n0;
    else drow0 = (n0 >> 7) * 256 + mode * 128 + (n0 & 127);
    transpose_tile(W, ldw, kb * 64, n0, WT, ldt, drow0, scr, lane);
}
__device__ __forceinline__ void fold_item(const Ctx& C, const Args& a, int it) {
    const int khalf = it & 1, dblk = (it >> 1) & 3, g = (it >> 3) & 3, kind = (it >> 5) % 3, l = it / 96;
    LAS float* Mb = (LAS float*)C.lds;
    LAS float* Wl = (LAS float*)(C.lds + 16384);
    LAS float* tab = (LAS float*)(C.lds + 16384 + 64 * 129 * 4);
    const int tid = fresh_tid(), d0 = dblk * 32;
    __syncthreads();
    if (tid < 128) tab[tid] = cospif((float)tid * (1.0f / 64.0f));
    __syncthreads();
    if (kind == 0) {
        const float* pw = a.pool_w + ((size_t)(l * 4 + g) * 128) * 128; const float* ps = a.pool_scale + (size_t)l * 512 + g * 128;
        for (int i = tid; i < 128 * 32; i += NTHR) { const int c = i >> 5, d = i & 31; Mb[i] = pw[c * 128 + d0 + d] * ps[d0 + d]; }
    } else {
        const float* fw = a.fnet_w + ((size_t)(l * 4 + g) * 128) * 128;
        const int c = tid >> 2, dq = (tid & 3) * 8, sh = (kind == 2) ? 96 : 0;
        float acc[8];
#pragma unroll
        for (int j = 0; j < 8; ++j) acc[j] = 0.f;
        for (int e = 0; e < 128; ++e) { const float t = tab[(c * e + sh) & 127]; const f32x4 w0 = *(const f32x4*)(fw + e * 128 + d0 + dq), w1 = *(const f32x4*)(fw + e * 128 + d0 + dq + 4);
#pragma unroll
            for (int j = 0; j < 4; ++j) { acc[j] += t * w0[j]; acc[4 + j] += t * w1[j]; } }
#pragma unroll
        for (int j = 0; j < 8; ++j) Mb[c * 32 + dq + j] = acc[j];
    }
    __syncthreads();
    const int colbase = (kind == 0 ? 0 : 1536) + g * 128, rowbase = (kind == 0 ? 0 : (kind == 1 ? 3072 : 3584)) + g * 128 + d0;
    const float* Wi = a.w_in + (size_t)l * DM * IN_DIM;
    bf16* WT = (bf16*)(a.ws + WS_W + (size_t)l * W_LAYER + WO_IN);
    const int k = tid & 63, dg = (tid >> 6) * 4;
    for (int kb = khalf * 16; kb < khalf * 16 + 16; ++kb) {
        const int k0 = kb * 64;
        for (int i = tid; i < 64 * 128; i += NTHR) { const int kk = i >> 7, cc = i & 127; Wl[kk * 129 + cc] = Wi[(size_t)(k0 + kk) * IN_DIM + colbase + cc]; }
        __syncthreads();
        float acc[4] = {0.f, 0.f, 0.f, 0.f};
        for (int c = 0; c < 128; ++c) { const float w = Wl[k * 129 + c]; const f32x4 m = *(const LAS f32x4*)(Mb + c * 32 + dg);
            acc[0] += w * m[0]; acc[1] += w * m[1]; acc[2] += w * m[2]; acc[3] += w * m[3]; }
#pragma unroll
        for (int j = 0; j < 4; ++j) WT[(size_t)(rowbase + dg + j) * DM + k0 + k] = (bf16)f2bf(acc[j]);
        __syncthreads();
    }
}
__device__ __forceinline__ void mod_item(const Ctx& C, const Args& a, int it) {
    const int tid = fresh_tid(), lane = tid & 63;
    const int l = it / 144, ch = it % 144;
    LAS float* sc = (LAS float*)C.lds;
    LAS float* red = (LAS float*)(C.lds + 5 * 2048 * 4);
    __syncthreads();
    for (int i = tid; i < 5 * DM; i += NTHR) { const int s = i / DM, k = i % DM; const float v = s < 4 ? a.c[s * DM + k] : a.c_ctx[k]; sc[i] = v / (1.0f + __expf(-v)); }
    __syncthreads();
    const float* wm = a.w_mod + (size_t)l * DM * NMOD + ch * 128 + 2 * lane;
    float acc[5][2];
#pragma unroll
    for (int s = 0; s < 5; ++s) { acc[s][0] = 0.f; acc[s][1] = 0.f; }
    const int kbeg = C.wave * 256;
#pragma unroll 4
    for (int k = kbeg; k < kbeg + 256; ++k) { const f32x2 w = *(const f32x2*)(wm + (size_t)k * NMOD);
#pragma unroll
        for (int s = 0; s < 5; ++s) { const float sv = sc[s * DM + k]; acc[s][0] += sv * w.x; acc[s][1] += sv * w.y; } }
#pragma unroll
    for (int s = 0; s < 5; ++s) { red[(C.wave * 5 + s) * 128 + 2 * lane] = acc[s][0]; red[(C.wave * 5 + s) * 128 + 2 * lane + 1] = acc[s][1]; }
    __syncthreads();
    float* mv = (float*)(a.ws + WS_MODV) + (size_t)l * 5 * NMOD;
    for (int i = tid; i < 5 * 128; i += NTHR) { const int s = i >> 7, col = i & 127; float v = 0.f;
#pragma unroll
        for (int w = 0; w < 8; ++w) v += red[(w * 5 + s) * 128 + col];
        mv[(size_t)s * NMOD + ch * 128 + col] = v + a.b_mod[(size_t)l * NMOD + ch * 128 + col]; }
    __syncthreads();
}
__device__ __forceinline__ void gen_item(const Ctx& C, const Args& a, int it) {
    const int tid = fresh_tid();
    if (it < 256) {
        bf16* M = (bf16*)(a.ws + WS_DFTM); const float sc = 0.00138106793f;
        for (int i = tid; i < 16 * 8192 / 2; i += NTHR) { const int e = 2 * i, k = it * 16 + (e >> 13), kk = e & 8191, n = kk & 4095; const bool sn = kk >= 4096;
            float v[2];
#pragma unroll
            for (int j = 0; j < 2; ++j) { const int ph = (k * (n + j)) & 4095; const float x = (float)ph * (1.0f / 2048.0f); v[j] = sn ? -sinpif(x) * sc : cospif(x) * sc; }
            *(unsigned*)(M + (size_t)k * 8192 + kk) = pk2(v[0], v[1]); }
    } else {
        bf16* M = (bf16*)(a.ws + WS_DFTC); const float sc = 0.00552427173f;
        for (int i = tid; i < 256 * 512; i += NTHR) { const int k = i >> 9, kk = i & 511, n = kk & 255; const int ph = (k * n) & 255; const float x = (float)ph * (1.0f / 128.0f);
            M[i] = (bf16)f2bf(kk >= 256 ? -sinpif(x) * sc : cospif(x) * sc); }
        float* R = (float*)(a.ws + WS_ROPE);
        for (int i = tid; i < 64 * 32; i += NTHR) { const int p = i >> 5, j = i & 31; const float inv = exp2f(-(float)j * (13.287712379549449f / 32.0f));
            const float ang = (float)p * inv; R[2 * i] = cosf(ang); R[2 * i + 1] = sinf(ang); }
    }
}
constexpr int P0_FOLD = 192, P0_MOD = 288, P0_GEN = 257, P0_CONV = CONV_PER_LAYER * NL;
__device__ __forceinline__ void prologue_phase(const Ctx& C, const Args& a) {
    for (int it = C.wg; it < P0_FOLD; it += C.G) fold_item(C, a, it);
    for (int it = C.wg; it < P0_MOD; it += C.G) mod_item(C, a, it);
    for (int it = C.wg; it < P0_GEN; it += C.G) gen_item(C, a, it);
    __syncthreads();
    for (int it = C.wg; it < P0_CONV; it += C.G) conv_item(C, a, it);
}

__device__ __forceinline__ void norm_phase(const Ctx& C, const float* sx, const float* scx, const float* gain, const float* modl, int ish, int isc, int nrows, bf16* H) {
    const int lane = fresh_tid() & 63;
    const int ng = nrows / 8, g0 = (int)((long)ng * C.wg / C.G), g1 = (int)((long)ng * (C.wg + 1) / C.G);
    int cur = -1; f32x4 A[8], Bv[8];
    for (int g = g0; g < g1; ++g) {
        const int row = g * 8 + C.wave, s = row < TX ? (row >> 12) : 4;
        if (s != cur) { cur = s;
#pragma unroll
            for (int j = 0; j < 8; ++j) { const int col = 4 * lane + 256 * j; const f32x4 gn = *(const f32x4*)(gain + col), scv = *(const f32x4*)(modl + (size_t)s * NMOD + isc * DM + col);
                A[j] = gn * (scv + 1.0f); Bv[j] = *(const f32x4*)(modl + (size_t)s * NMOD + ish * DM + col); } }
        const float* src = row < TX ? sx + (size_t)row * DM : scx + (size_t)(row - TX) * DM;
        f32x4 v[8]; float ss = 0.f;
#pragma unroll
        for (int j = 0; j < 8; ++j) { v[j] = *(const f32x4*)(src + 4 * lane + 256 * j); ss += (v[j].x * v[j].x + v[j].y * v[j].y) + (v[j].z * v[j].z + v[j].w * v[j].w); }
        const float rs = 1.0f / sqrtf(wave_sum(ss) * (1.0f / DM) + EPS);
        bf16* o = H + (size_t)row * DM + 4 * lane;
#pragma unroll
        for (int j = 0; j < 8; ++j) { const f32x4 y = v[j] * rs * A[j] + Bv[j]; v2u w; w.x = pk2(y.x, y.y); w.y = pk2(y.z, y.w); *(v2u*)(o + 256 * j) = w; }
    }
}
__device__ __forceinline__ void final_phase(const Ctx& C, const float* XS, const float* gain, float* out) {
    const int lane = fresh_tid() & 63;
    const int gw = C.wg * NWAVES + C.wave, NGW = C.G * NWAVES;
    f32x4 A[8];
#pragma unroll
    for (int j = 0; j < 8; ++j) A[j] = *(const f32x4*)(gain + 4 * lane + 256 * j);
    for (int row = gw; row < TX; row += NGW) {
        const float* src = XS + (size_t)row * DM; f32x4 v[8]; float ss = 0.f;
#pragma unroll
        for (int j = 0; j < 8; ++j) { v[j] = *(const f32x4*)(src + 4 * lane + 256 * j); ss += (v[j].x * v[j].x + v[j].y * v[j].y) + (v[j].z * v[j].z + v[j].w * v[j].w); }
        const float rs = 1.0f / sqrtf(wave_sum(ss) * (1.0f / DM) + EPS);
        float* o = out + (size_t)row * DM + 4 * lane;
#pragma unroll
        for (int j = 0; j < 8; ++j) *(f32x4*)(o + 256 * j) = v[j] * rs * A[j];
    }
}

__device__ __forceinline__ void prep_phase(const Ctx& C, bf16* Z, bf16* CC, const float* qn, const float* kn, const float* rope) {
    const int gw = C.wg * NWAVES + C.wave, NGW = C.G * NWAVES, lane = fresh_tid() & 63, l16 = lane & 15;
    for (int row = gw; row < T; row += NGW) {
        const bool isx = row < TX; const int t = isx ? (row & (SEQ - 1)) : ((row - TX) & (CTXL - 1)), seqlen = isx ? SEQ : CTXL, seq0 = row - t;
        bf16* zr = Z + (size_t)row * ZW;
#pragma unroll
        for (int p = 0; p < 2; ++p) { const int head = 4 * p + (lane >> 4);
            if (head < 6) { bf16* ptr = zr + ZGQ + head * 128 + l16 * 8; const v4u w = *(const v4u*)ptr;
                float x[8] = {bflo(w.x), bfhi(w.x), bflo(w.y), bfhi(w.y), bflo(w.z), bfhi(w.z), bflo(w.w), bfhi(w.w)};
                float ss = 0.f;
#pragma unroll
                for (int j = 0; j < 8; ++j) ss += x[j] * x[j];
                ss += __shfl_xor(ss, 1); ss += __shfl_xor(ss, 2); ss += __shfl_xor(ss, 4); ss += __shfl_xor(ss, 8);
                const float rs = 1.0f / sqrtf(ss * (1.0f / 128.0f) + EPS); const float* gn = (head < 4 ? qn : kn) + l16 * 8;
#pragma unroll
                for (int j = 0; j < 8; ++j) x[j] = x[j] * rs * gn[j];
                if (isx) { const int grow = t >> 6, gcol = t & 63;
#pragma unroll
                    for (int jj = 0; jj < 4; ++jj) { const int i = l16 * 4 + jj, pos = i < 32 ? grow : gcol; const f32x2 cs = *(const f32x2*)(rope + (pos * 32 + (i & 31)) * 2);
                        const float x1 = x[2 * jj], x2 = x[2 * jj + 1]; x[2 * jj] = x1 * cs.x - x2 * cs.y; x[2 * jj + 1] = x1 * cs.y + x2 * cs.x; } }
                v4u o; o.x = pk2(x[0], x[1]); o.y = pk2(x[2], x[3]); o.z = pk2(x[4], x[5]); o.w = pk2(x[6], x[7]); *(v4u*)ptr = o; } }
        { const int half = 1 << (lane >> 4); const int lo = (t - half) > 0 ? (t - half) : 0, hi = (t + half - 1) < (seqlen - 1) ? (t + half - 1) : (seqlen - 1);
            float s[8] = {0.f, 0.f, 0.f, 0.f, 0.f, 0.f, 0.f, 0.f};
            for (int tt = lo; tt <= hi; ++tt) { const v4u w = *(const v4u*)(Z + (size_t)(seq0 + tt) * ZW + ZP + lane * 8);
                s[0] += bflo(w.x); s[1] += bfhi(w.x); s[2] += bflo(w.y); s[3] += bfhi(w.y); s[4] += bflo(w.z); s[5] += bfhi(w.z); s[6] += bflo(w.w); s[7] += bfhi(w.w); }
            const v4u w = *(const v4u*)(zr + ZP + lane * 8); const float inv = 1.0f / (float)(hi - lo + 1);
            const float u[8] = {bflo(w.x), bfhi(w.x), bflo(w.y), bfhi(w.y), bflo(w.z), bfhi(w.z), bflo(w.w), bfhi(w.w)};
            v4u o; o.x = pk2(s[0] * inv - u[0], s[1] * inv - u[1]); o.y = pk2(s[2] * inv - u[2], s[3] * inv - u[3]); o.z = pk2(s[4] * inv - u[4], s[5] * inv - u[5]); o.w = pk2(s[6] * inv - u[6], s[7] * inv - u[7]);
            *(v4u*)(CC + (size_t)row * DM + lane * 8) = o; }
    }
}

template <class KF>
__device__ __forceinline__ void naive_attn16(const bf16* Z, int qrow, int qcol, int kcol, int vcol, const KF& kf, int nkeys, bf16* outp, int sub) {
    float q[32], o[32];
    { const bf16* qp = Z + (size_t)qrow * ZW + qcol + 32 * sub;
#pragma unroll
        for (int i = 0; i < 4; ++i) { const v4u w = *(const v4u*)(qp + 8 * i); q[8 * i] = bflo(w.x); q[8 * i + 1] = bfhi(w.x); q[8 * i + 2] = bflo(w.y); q[8 * i + 3] = bfhi(w.y); q[8 * i + 4] = bflo(w.z); q[8 * i + 5] = bfhi(w.z); q[8 * i + 6] = bflo(w.w); q[8 * i + 7] = bfhi(w.w); } }
#pragma unroll
    for (int i = 0; i < 32; ++i) o[i] = 0.f;
    float m = -1e30f, l = 0.f;
    for (int j = 0; j < nkeys; ++j) {
        int kr; float bias; kf(j, kr, bias);
        const bf16* kp = Z + (size_t)kr * ZW + kcol + 32 * sub; const bf16* vp = Z + (size_t)kr * ZW + vcol + 32 * sub;
        float s = 0.f;
#pragma unroll
        for (int i = 0; i < 4; ++i) { const v4u w = *(const v4u*)(kp + 8 * i);
            s += q[8 * i] * bflo(w.x) + q[8 * i + 1] * bfhi(w.x) + q[8 * i + 2] * bflo(w.y) + q[8 * i + 3] * bfhi(w.y) + q[8 * i + 4] * bflo(w.z) + q[8 * i + 5] * bfhi(w.z) + q[8 * i + 6] * bflo(w.w) + q[8 * i + 7] * bfhi(w.w); }
        s += __shfl_xor(s, 1); s += __shfl_xor(s, 2);
        s = s * 0.08838834764831845f + bias;
        const float mn = fmaxf(m, s), al = __expf(m - mn), p = __expf(s - mn);
        l = l * al + p; m = mn;
#pragma unroll
        for (int i = 0; i < 4; ++i) { const v4u w = *(const v4u*)(vp + 8 * i);
            o[8 * i] = o[8 * i] * al + p * bflo(w.x); o[8 * i + 1] = o[8 * i + 1] * al + p * bfhi(w.x); o[8 * i + 2] = o[8 * i + 2] * al + p * bflo(w.y); o[8 * i + 3] = o[8 * i + 3] * al + p * bfhi(w.y);
            o[8 * i + 4] = o[8 * i + 4] * al + p * bflo(w.z); o[8 * i + 5] = o[8 * i + 5] * al + p * bfhi(w.z); o[8 * i + 6] = o[8 * i + 6] * al + p * bflo(w.w); o[8 * i + 7] = o[8 * i + 7] * al + p * bfhi(w.w); }
    }
    const float il = 1.0f / l;
#pragma unroll
    for (int i = 0; i < 4; ++i) { v4u w; w.x = pk2(o[8 * i] * il, o[8 * i + 1] * il); w.y = pk2(o[8 * i + 2] * il, o[8 * i + 3] * il); w.z = pk2(o[8 * i + 4] * il, o[8 * i + 5] * il); w.w = pk2(o[8 * i + 6] * il, o[8 * i + 7] * il);
        *(v4u*)(outp + 32 * sub + 8 * i) = w; }
}
struct KfGqa { int b; __device__ __forceinline__ void operator()(int j, int& kr, float& bias) const { kr = j < SEQ ? b * SEQ + j : TX + b * CTXL + (j - SEQ); bias = 0.f; } };
struct KfCtx { int b; __device__ __forceinline__ void operator()(int j, int& kr, float& bias) const { kr = TX + b * CTXL + j; bias = 0.f; } };
struct KfNa { int b, qr, qc, rs, cs; const float* rpb;
    __device__ __forceinline__ void operator()(int j, int& kr, float& bias) const {
        if (j < 128) { const int r = rs + (j >> 4), c = cs + (j & 15); kr = b * SEQ + r * 64 + c; bias = rpb[(r - qr + 7) * 31 + (c - qc + 15)]; }
        else { kr = TX + b * CTXL + (j - 128); bias = 0.f; } } };
__device__ __forceinline__ void naive_mix_phase(const Ctx& C, const bf16* Z, bf16* CC, const float* rpb_l, bool with_ctx) {
    const int gw = C.wg * NWAVES + C.wave, NGW = C.G * NWAVES, lane = fresh_tid() & 63, sub = lane & 3, qi = lane >> 2;
    for (int it = gw; it < NB * 4 * (SEQ / 16); it += NGW) { const int tg = it & 255, hq = (it >> 8) & 3, b = it >> 10; const int row = b * SEQ + tg * 16 + qi;
        KfGqa kf{b}; naive_attn16(Z, row, ZGQ + hq * 128, ZGK + (hq >> 1) * 128, ZGV + (hq >> 1) * 128, kf, SEQ + CTXL, CC + (size_t)row * DM + 512 + hq * 128, sub); }
    for (int it = gw; it < NB * 4 * (SEQ / 16); it += NGW) { const int tg = it & 255, h = (it >> 8) & 3, b = it >> 10; const int t = tg * 16 + qi, row = b * SEQ + t, qr = t >> 6, qc = t & 63;
        int rs = qr - 4; rs = rs < 0 ? 0 : (rs > 56 ? 56 : rs); int cs = qc - 8; cs = cs < 0 ? 0 : (cs > 48 ? 48 : cs);
        KfNa kf{b, qr, qc, rs, cs, rpb_l + h * (15 * 31)}; naive_attn16(Z, row, ZNQ + h * 128, ZNK + h * 128, ZNV + h * 128, kf, 128 + CTXL, CC + (size_t)row * DM + 1536 + h * 128, sub); }
    if (with_ctx) {
        for (int it = gw; it < NB * 4 * (CTXL / 16); it += NGW) { const int tg = it & 15, hq = (it >> 4) & 3, b = it >> 6; const int row = TX + b * CTXL + tg * 16 + qi;
            KfCtx kf{b}; naive_attn16(Z, row, ZGQ + hq * 128, ZGK + (hq >> 1) * 128, ZGV + (hq >> 1) * 128, kf, CTXL, CC + (size_t)row * DM + 512 + hq * 128, sub); }
        for (int it = gw; it < NB * 4 * (CTXL / 16); it += NGW) { const int tg = it & 15, h = (it >> 4) & 3, b = it >> 6; const int row = TX + b * CTXL + tg * 16 + qi;
            KfCtx kf{b}; naive_attn16(Z, row, ZNQ + h * 128, ZNK + h * 128, ZNV + h * 128, kf, CTXL, CC + (size_t)row * DM + 1536 + h * 128, sub); }
    }
}

__global__ void __launch_bounds__(NTHR, 2) dit_fwd(Args a) {
    extern __shared__ __attribute__((aligned(16))) unsigned char lds_raw[];
    Ctx C; C.lds = (LAS unsigned char*)lds_raw; C.wave = __builtin_amdgcn_readfirstlane((int)threadIdx.x >> 6); C.wg = blockIdx.x; C.G = gridDim.x;
    volatile LAS unsigned* MISC = (volatile LAS unsigned*)(C.lds + MISC_OFF);
    for (int u = threadIdx.x; u < (LDS_BYTES - LDSCTL_OFF) / 4; u += NTHR) ((LAS unsigned*)(C.lds + LDSCTL_OFF))[u] = 0u;
    __syncthreads();
    XcdBarrier bar = xcd_barrier_post((unsigned*)(a.ws + WS_CTL) + CW_BAR, MISC + 8);
    unsigned char* ws = a.ws;
    float* XS = (float*)(ws + WS_XS); bf16* H = (bf16*)(ws + WS_H); bf16* GU = (bf16*)(ws + WS_GU); bf16* Z = (bf16*)(ws + WS_Z); bf16* CC = (bf16*)(ws + WS_CC);
    bf16* ABT = (bf16*)(ws + WS_ABT); bf16* ABTC = (bf16*)(ws + WS_ABTC);
    const float* MODV = (const float*)(ws + WS_MODV);

    prologue_phase(C, a);
    xcd_barrier(bar);

    for (int step = 0; step < 2 * NL; ++step) {
        const int l = step >> 1, second = step & 1;
        const bool last = (l == NL - 1);
        const float* modl = MODV + (size_t)l * 5 * NMOD;
        const unsigned char* wl = ws + WS_W + (size_t)l * W_LAYER;
        const bool from_input = (step == 0);
        const float* sx = from_input ? a.x : XS; const float* scx = from_input ? a.ctx : XS + (size_t)TX * DM;
        const int rows = (second && last) ? TX : T;
        norm_phase(C, sx, scx, (second ? a.ffn2_norm : a.ffn1_norm) + (size_t)l * DM, modl, second ? 6 : 0, second ? 7 : 1, rows, H);
        xcd_barrier(bar);
        { pg8::Dims g{DM, DM, DM}; pg8::StaticOrder S; S.init(rows, NGU, C.G, C.wg);
            ProbPlain P{(const char*)H, (const char*)(wl + (second ? WO_GU2 : WO_GU1)), (size_t)256 * DM * 2, (size_t)256 * DM * 2}; EpiSwiglu E{GU};
            pg8::gemm_phase<EpiSwiglu, pg8::StaticOrder, ProbPlain>(C.lds, g, P, S, E); }
        xcd_barrier(bar);
        { pg8::Dims g{FF, FF, FF}; pg8::StaticOrder S; S.init(rows, DM, C.G, C.wg);
            ProbPlain P{(const char*)GU, (const char*)(wl + (second ? WO_D2 : WO_D1)), (size_t)256 * FF * 2, (size_t)256 * FF * 2};
            EpiResid E{sx, scx, XS, modl + (second ? 8 : 2) * DM, 0.5f};
            pg8::gemm_phase<EpiResid, pg8::StaticOrder, ProbPlain>(C.lds, g, P, S, E); }
        xcd_barrier(bar);
        if (!second) {
            norm_phase(C, XS, XS + (size_t)TX * DM, a.mix_norm + (size_t)l * DM, modl, 3, 4, T, H);
            xcd_barrier(bar);
            { pg8::Dims g{DM, DM, DM}; pg8::StaticOrder S; S.init(T, NIN, C.G, C.wg);
                ProbInFt P{(const char*)H, (const char*)(wl + WO_IN)}; EpiZ E{Z, ABT, ABTC};
                pg8::gemm_phase<EpiZ, pg8::StaticOrder, ProbInFt>(C.lds, g, P, S, E); }
            xcd_barrier(bar);
            prep_phase(C, Z, CC, a.q_norm + (size_t)l * 128, a.k_norm + (size_t)l * 128, (const float*)(ws + WS_ROPE));
            xcd_barrier(bar);
            for (int pass = 0; pass < (last ? 1 : 2); ++pass) {
                pg8::Dims g = pass ? pg8::Dims{2 * CTXL, 2 * CTXL, LDTC} : pg8::Dims{2 * SEQ, 2 * SEQ, LDT};
                pg8::StaticOrder S; if (pass) S.init(TC, 512, C.G, C.wg); else S.init(TX, 512, C.G, C.wg);
                ProbDft P = pass ? ProbDft{(const char*)(ws + WS_DFTC), 0, 0, (const char*)ABTC, 0, (size_t)2 * CTXL * 2, (size_t)256 * LDTC * 2}
                                 : ProbDft{(const char*)(ws + WS_DFTM), 15, (size_t)256 * 2 * SEQ * 2, (const char*)ABT, 4, (size_t)2 * SEQ * 2, (size_t)256 * LDT * 2};
                EpiBf16Plain E{CC + (pass ? (size_t)TX * DM : 0) + 1024, DM};
                pg8::gemm_phase<EpiBf16Plain, pg8::StaticOrder, ProbDft>(C.lds, g, P, S, E);
            }
            naive_mix_phase(C, Z, CC, a.na_rpb + (size_t)l * 4 * 15 * 31, !last);
            xcd_barrier(bar);
            { const int orows = last ? TX : T; pg8::Dims g{DM, DM, DM}; pg8::StaticOrder S; S.init(orows, DM, C.G, C.wg);
                ProbPlain P{(const char*)CC, (const char*)(wl + WO_OUT), (size_t)256 * DM * 2, (size_t)256 * DM * 2};
                EpiResid E{XS, XS + (size_t)TX * DM, XS, modl + 5 * DM, 1.0f};
                pg8::gemm_phase<EpiResid, pg8::StaticOrder, ProbPlain>(C.lds, g, P, S, E); }
            xcd_barrier(bar);
        }
    }
    final_phase(C, XS, a.final_norm, a.out);
}

extern "C" void kernel_launch(void* const* d_in, const int* in_sizes, int n_in, void* d_out, int out_size, void* d_ws, size_t ws_size, hipStream_t stream) {
    static int grid = 0;
    if (grid == 0) {
        if (n_in != 24 || in_sizes[0] != TX * DM || out_size != TX * DM || ws_size < WS_END) { fprintf(stderr, "kernel_launch: shape/workspace mismatch (n_in %d, in0 %d, out %d, ws %zu < %zu)\n", n_in, n_in > 0 ? in_sizes[0] : -1, out_size, ws_size, (size_t)WS_END); grid = -1; return; }
        int dev = 0, cus = 0, per_cu = 0;
        if (hipGetDevice(&dev) != hipSuccess || hipDeviceGetAttribute(&cus, hipDeviceAttributeMultiprocessorCount, dev) != hipSuccess) { grid = -1; return; }
        if (hipFuncSetAttribute((const void*)dit_fwd, hipFuncAttributeMaxDynamicSharedMemorySize, LDS_BYTES) != hipSuccess) { fprintf(stderr, "kernel_launch: hipFuncSetAttribute failed\n"); grid = -1; return; }
        if (hipOccupancyMaxActiveBlocksPerMultiprocessor(&per_cu, (const void*)dit_fwd, NTHR, LDS_BYTES) != hipSuccess || per_cu < 1) fprintf(stderr, "kernel_launch: occupancy query reports %d\n", per_cu);
        (void)hipGetLastError();
        grid = cus;
    }
    if (grid < 0) return;
    if (hipMemsetAsync((char*)d_ws + WS_CTL, 0, CTL_ZERO_BYTES, stream) != hipSuccess) return;
    Args a{};
    const float* const* in = (const float* const*)d_in;
    a.x = in[0]; a.c = in[1]; a.ctx = in[2]; a.c_ctx = in[3]; a.w_mod = in[4]; a.b_mod = in[5]; a.ffn1_norm = in[6]; a.ffn1_gate = in[7]; a.ffn1_up = in[8]; a.ffn1_down = in[9];
    a.mix_norm = in[10]; a.w_in = in[11]; a.w_out = in[12]; a.pool_w = in[13]; a.pool_scale = in[14]; a.q_norm = in[15]; a.k_norm = in[16]; a.fnet_w = in[17]; a.na_rpb = in[18];
    a.ffn2_norm = in[19]; a.ffn2_gate = in[20]; a.ffn2_up = in[21]; a.ffn2_down = in[22]; a.final_norm = in[23];
    a.out = (float*)d_out; a.ws = (unsigned char*)d_ws;
    hipLaunchKernelGGL(dit_fwd, dim3(grid), dim3(NTHR), LDS_BYTES, stream, a);
    const hipError_t le = hipPeekAtLastError();
    if (le != hipSuccess) fprintf(stderr, "kernel_launch: launch failed: %s\n", hipGetErrorName(le));
}
```

```cpp
#include <hip/hip_runtime.h>
#include <cstdio>
#include <cstdint>

namespace pg8 {
#define PG8_LAS __attribute__((address_space(3)))
typedef unsigned short bf16_t;
typedef short bf16x8 __attribute__((ext_vector_type(8)));
typedef float f32x4 __attribute__((ext_vector_type(4)));
typedef unsigned u32x4 __attribute__((ext_vector_type(4)));
constexpr int BM = 256, BK = 64, HALF = 128, HTB = HALF * BK * 2, STAGE_BYTES = 8 * HTB, NXCD = 8, WGM = 8;

__host__ __device__ __forceinline__ int lds_byte(int r, int c) { const int st = (r >> 4) * 2 + (c >> 5), rr = r & 15, cc = c & 31, ob = rr * 64 + cc * 2; return st * 1024 + (ob ^ (((ob >> 9) & 1) << 5)); }
__host__ __device__ __forceinline__ void stage_rc(int b, int& R, int& C) { const int st = b / 1024, sb = b % 1024, swz = sb ^ (((sb >> 9) & 1) << 5); R = (st >> 1) * 16 + swz / 64; C = (st & 1) * 32 + (swz % 64) / 2; }
__host__ __device__ __forceinline__ int perm32(int rho) { const int n = rho >> 4, i = rho & 15; return 8 * (i >> 2) + 4 * n + (i & 3); }

struct Unit { int pm, pn; };
struct Dims { int K, lda, ldb; };
__device__ __forceinline__ int fresh_tid_pg8() { int t = threadIdx.x; asm volatile("" : "+v"(t)); return t; }

struct StaticOrder {
    int nM, nN, nwg, G, c;
    __host__ __device__ void init(int M, int N, int G_, int c_) { nM = M / BM; nN = N / BM; nwg = nM * nN; G = G_; c = c_; }
    __host__ __device__ bool next(int i, Unit& u) const {
        const long L = (long)i * G + c; if (L >= nwg) return false;
        int wgid = (int)L; { const int q = nwg / NXCD, r = nwg % NXCD, xcd = wgid % NXCD, off = wgid / NXCD; wgid = (xcd < r ? xcd * (q + 1) : r * (q + 1) + (xcd - r) * q) + off; }
        const int nig = WGM * nN, gid = wgid / nig, fm = gid * WGM, gsz = (nM - fm) < WGM ? (nM - fm) : WGM;
        u.pm = fm + ((wgid % nig) % gsz); u.pn = (wgid % nig) / gsz; return true;
    }
};

__device__ __forceinline__ unsigned cvt_pk_bf16(float lo, float hi) { unsigned r; asm volatile("v_cvt_pk_bf16_f32 %0, %1, %2" : "=v"(r) : "v"(lo), "v"(hi)); return r; }

template <class Epi, class Sched, class Prob, bool ALIGN_EPI = true, bool SP2 = true>
__device__ __forceinline__ void gemm_phase(PG8_LAS unsigned char* lds, const Dims g, const Prob& P, const Sched& S, const Epi& E) {
    const int tid = fresh_tid_pg8(), wid = __builtin_amdgcn_readfirstlane(tid >> 6), lane = tid & 63, wr = wid >> 2, wc = wid & 3, fr = lane & 15, fq = lane >> 4;
    const int K = g.K, nt = K / BK;
    unsigned voffA[2], voffB[2];
#pragma unroll
    for (int i = 0; i < 2; ++i) { int R, C; stage_rc(tid * 16 + i * 8192, R, C); const int Rb = Epi::PERM ? ((R & ~31) + perm32(R & 31)) : R;
        voffA[i] = (unsigned)(R * g.lda + C) * 2u; voffB[i] = (unsigned)(Rb * g.ldb + C) * 2u; }
    const size_t kstep = (size_t)(BK * 2);
    const size_t hstepA = (size_t)HALF * g.lda * 2, hstepB = (size_t)HALF * g.ldb * 2;
    const unsigned ldsw = (unsigned)wid * 1024u;
    const int aoff = lds_byte(wr * 64 + fr, fq * 8), boff = lds_byte(wc * 32 + fr, fq * 8);
#define PG8_SA(b, h) (((b) * 2 + (h)) * HTB)
#define PG8_SB(b, h) ((4 + (b) * 2 + (h)) * HTB)
#define PG8_STAGE(bufoff, gbase, voff) do { _Pragma("unroll") for (int _i = 0; _i < 2; ++_i) \
        __builtin_amdgcn_global_load_lds((const unsigned*)((const char*)(gbase) + (voff)[_i]), (PG8_LAS unsigned*)(lds + (bufoff) + ldsw + _i * 8192), 16, 0, 0); } while (0)
#define PG8_LDA(dst, b, h) do { _Pragma("unroll") for (int m = 0; m < 4; ++m) _Pragma("unroll") for (int k = 0; k < 2; ++k) dst[m][k] = *(const PG8_LAS bf16x8*)(lds + PG8_SA(b, h) + aoff + m * 2048 + k * 1024); } while (0)
#define PG8_LDB(dst, b, h) do { _Pragma("unroll") for (int n = 0; n < 2; ++n) _Pragma("unroll") for (int k = 0; k < 2; ++k) dst[n][k] = *(const PG8_LAS bf16x8*)(lds + PG8_SB(b, h) + boff + n * 2048 + k * 1024); } while (0)
#define PG8_MMA(ai, bj, At, Bt) do { __builtin_amdgcn_s_setprio(1); _Pragma("unroll") for (int m = 0; m < 4; ++m) _Pragma("unroll") for (int n = 0; n < 2; ++n) _Pragma("unroll") for (int k = 0; k < 2; ++k) \
        acc[ai][bj][m][n] = __builtin_amdgcn_mfma_f32_16x16x32_bf16(Bt[n][k], At[m][k], acc[ai][bj][m][n], 0, 0, 0); __builtin_amdgcn_s_setprio(0); } while (0)
#define PG8_WAIT_V(n) asm volatile("s_waitcnt vmcnt(" #n ")" ::: "memory")
#define PG8_WAIT_L(n) asm volatile("s_waitcnt lgkmcnt(" #n ")" ::: "memory")
#define PG8_BAR __builtin_amdgcn_s_barrier()
#define PG8_SCHED __builtin_amdgcn_sched_barrier(0)
    Unit cur, nxt; int ui = 0;
    if (!S.next(0, cur)) return;
    f32x4 acc[2][2][4][2];
#pragma unroll
    for (int a = 0; a < 2; ++a)
#pragma unroll
        for (int b = 0; b < 2; ++b)
#pragma unroll
            for (int m = 0; m < 4; ++m)
#pragma unroll
                for (int n = 0; n < 2; ++n) acc[a][b][m][n] = (f32x4){0.f, 0.f, 0.f, 0.f};
    bf16x8 At[4][2], B0[2][2], B1[2][2];
    const char* cA = P.a_panel(cur); const char* cB = P.b_panel(cur);
    if constexpr (SP2) {
        PG8_STAGE(PG8_SB(0, 0), cB, voffB); PG8_STAGE(PG8_SB(0, 1), cB + hstepB, voffB); PG8_STAGE(PG8_SA(0, 0), cA, voffA); PG8_STAGE(PG8_SA(0, 1), cA + hstepA, voffA);
        if (wr == 1) PG8_BAR;
        PG8_WAIT_V(2); PG8_BAR;
        PG8_STAGE(PG8_SB(1, 0), cB + kstep, voffB); PG8_STAGE(PG8_SA(1, 0), cA + kstep, voffA); PG8_STAGE(PG8_SB(1, 1), cB + hstepB + kstep, voffB);
        PG8_WAIT_V(6); PG8_BAR;
    } else {
        PG8_STAGE(PG8_SB(0, 0), cB, voffB); PG8_STAGE(PG8_SA(0, 0), cA, voffA); PG8_STAGE(PG8_SB(0, 1), cB + hstepB, voffB); PG8_STAGE(PG8_SA(0, 1), cA + hstepA, voffA);
        if (wr == 1) PG8_BAR;
        PG8_WAIT_V(4); PG8_BAR;
        PG8_STAGE(PG8_SB(1, 0), cB + kstep, voffB); PG8_STAGE(PG8_SA(1, 0), cA + kstep, voffA); PG8_STAGE(PG8_SB(1, 1), cB + hstepB + kstep, voffB);
        PG8_WAIT_V(6); PG8_BAR;
    }
    for (;;) {
        const bool has_next = S.next(ui + 1, nxt);
        const char* nA = has_next ? P.a_panel(nxt) : cA; const char* nB = has_next ? P.b_panel(nxt) : cB;
        for (int t = 0; t < nt; t += 2) {
            const bool last = (t == nt - 2);
            const char* a1 = cA + (size_t)(t + 1) * kstep;
            const char* a2 = last ? nA : cA + (size_t)(t + 2) * kstep; const char* b2 = last ? nB : cB + (size_t)(t + 2) * kstep;
            const char* a3 = a2 + kstep; const char* b3 = b2 + kstep;
            if constexpr (SP2) {
            PG8_LDB(B0, 0, 0); PG8_LDB(B1, 0, 1); PG8_SCHED; PG8_LDA(At, 0, 0); PG8_STAGE(PG8_SA(1, 1), a1 + hstepA, voffA);
            PG8_WAIT_V(8); PG8_WAIT_L(0); PG8_BAR; PG8_MMA(0, 0, At, B0); PG8_MMA(0, 1, At, B1); PG8_BAR; PG8_SCHED;
            PG8_LDA(At, 0, 1); PG8_STAGE(PG8_SB(0, 0), b2, voffB); PG8_STAGE(PG8_SB(0, 1), b2 + hstepB, voffB); PG8_STAGE(PG8_SA(0, 0), a2, voffA);
            PG8_WAIT_V(8); PG8_WAIT_L(0); PG8_BAR; PG8_MMA(1, 0, At, B0); PG8_MMA(1, 1, At, B1); PG8_BAR; PG8_SCHED;
            PG8_LDB(B0, 1, 0); PG8_LDB(B1, 1, 1); PG8_SCHED; PG8_LDA(At, 1, 0); PG8_STAGE(PG8_SA(0, 1), a2 + hstepA, voffA);
            PG8_WAIT_V(8); PG8_WAIT_L(0); PG8_BAR; PG8_MMA(0, 0, At, B0); PG8_MMA(0, 1, At, B1); PG8_BAR; PG8_SCHED;
            PG8_LDA(At, 1, 1); PG8_STAGE(PG8_SB(1, 0), b3, voffB); PG8_STAGE(PG8_SB(1, 1), b3 + hstepB, voffB); PG8_STAGE(PG8_SA(1, 0), a3, voffA);
            PG8_WAIT_V(8); PG8_WAIT_L(0); PG8_BAR; PG8_MMA(1, 0, At, B0); PG8_MMA(1, 1, At, B1); PG8_BAR; PG8_SCHED;
            } else {
            PG8_LDB(B0, 0, 0); PG8_SCHED; PG8_LDA(At, 0, 0); PG8_STAGE(PG8_SA(1, 1), a1 + hstepA, voffA);
            PG8_WAIT_L(8); PG8_BAR; PG8_WAIT_L(0); PG8_MMA(0, 0, At, B0); PG8_BAR; PG8_SCHED;
            PG8_LDB(B1, 0, 1); PG8_STAGE(PG8_SB(0, 0), b2, voffB);
            PG8_BAR; PG8_WAIT_L(0); PG8_MMA(0, 1, At, B1); PG8_BAR;
            PG8_LDA(At, 0, 1); PG8_STAGE(PG8_SA(0, 0), a2, voffA);
            PG8_BAR; PG8_WAIT_L(0); PG8_MMA(1, 0, At, B0); PG8_BAR; PG8_SCHED;
            PG8_STAGE(PG8_SB(0, 1), b2 + hstepB, voffB);
            PG8_WAIT_V(6); PG8_BAR; PG8_MMA(1, 1, At, B1); PG8_BAR;
            PG8_LDB(B0, 1, 0); PG8_SCHED; PG8_LDA(At, 1, 0); PG8_STAGE(PG8_SA(0, 1), a2 + hstepA, voffA);
            PG8_WAIT_L(8); PG8_BAR; PG8_WAIT_L(0); PG8_MMA(0, 0, At, B0); PG8_BAR; PG8_SCHED;
            PG8_LDB(B1, 1, 1); PG8_STAGE(PG8_SB(1, 0), b3, voffB);
            PG8_BAR; PG8_WAIT_L(0); PG8_MMA(0, 1, At, B1); PG8_BAR;
            PG8_LDA(At, 1, 1); PG8_STAGE(PG8_SA(1, 0), a3, voffA);
            PG8_BAR; PG8_WAIT_L(0); PG8_MMA(1, 0, At, B0); PG8_BAR; PG8_SCHED;
            PG8_STAGE(PG8_SB(1, 1), b3 + hstepB, voffB);
            PG8_WAIT_V(6); PG8_BAR; PG8_MMA(1, 1, At, B1); PG8_BAR;
            }
        }
        if constexpr (ALIGN_EPI) { if (wr == 0) PG8_BAR; }
        E(acc, cur, wr, wc, fr, fq);
        if (!has_next) break;
#pragma unroll
        for (int a = 0; a < 2; ++a)
#pragma unroll
            for (int b = 0; b < 2; ++b)
#pragma unroll
                for (int m = 0; m < 4; ++m)
#pragma unroll
                    for (int n = 0; n < 2; ++n) acc[a][b][m][n] = (f32x4){0.f, 0.f, 0.f, 0.f};
        cur = nxt; cA = nA; cB = nB; ++ui;
        if constexpr (ALIGN_EPI) { if (wr == 1) PG8_BAR; }
    }
    PG8_WAIT_V(0);
    if constexpr (!ALIGN_EPI) { if (wr == 0) PG8_BAR; }
    PG8_BAR;
#undef PG8_SA
#undef PG8_SB
#undef PG8_STAGE
#undef PG8_LDA
#undef PG8_LDB
#undef PG8_MMA
#undef PG8_WAIT_V
#undef PG8_WAIT_L
#undef PG8_BAR
#undef PG8_SCHED
}
}

constexpr int NWAVES = 8, NTHR = 512;
constexpr int NB = 4, SEQ = 4096, CTXL = 256, DM = 2048, FF = 5632, NGU = 2 * FF, NL = 2;
constexpr int TX = NB * SEQ, TC = NB * CTXL, T = TX + TC;
constexpr int ZW = 3072;
constexpr int ZP = 0, ZGQ = 512, ZGK = 1024, ZGV = 1280, ZNQ = 1536, ZNK = 2048, ZNV = 2560;
constexpr int NIN = 4096;
constexpr int LDT = 2 * NB * SEQ + 64, LDTC = 2 * NB * CTXL + 64;
constexpr int NMOD = 9 * DM;
constexpr float EPS = 1e-6f;
constexpr int IN_DIM = 3584;

constexpr size_t MiB = 1u << 20;
constexpr size_t WS_CTL = 0, CTL_ZERO_BYTES = 1 * MiB;
constexpr size_t WS_MODV = 1 * MiB;
constexpr size_t WS_ROPE = 1 * MiB + 768 * 1024;
constexpr size_t WS_DFTC = 2 * MiB;
constexpr size_t WS_ABTC = 3 * MiB;
constexpr size_t WS_W = 8 * MiB, W_LAYER = 156 * MiB;
constexpr size_t WO_GU1 = 0, WO_D1 = 44 * MiB, WO_IN = 66 * MiB, WO_OUT = 82 * MiB, WO_GU2 = 90 * MiB, WO_D2 = 134 * MiB;
constexpr size_t WS_DFTM = 320 * MiB;
constexpr size_t WS_XS = 384 * MiB;
constexpr size_t WS_H = 520 * MiB;
constexpr size_t WS_GU = 588 * MiB;
constexpr size_t WS_Z = 588 * MiB;
constexpr size_t WS_CC = 690 * MiB;
constexpr size_t WS_ABT = 775 * MiB;
constexpr size_t WS_END = 808 * MiB;
static_assert(WS_Z + (size_t)T * ZW * 2 <= WS_CC && WS_CC + (size_t)T * DM * 2 <= WS_GU + (size_t)T * FF * 2 && WS_GU + (size_t)T * FF * 2 <= WS_ABT && WS_ABT + (size_t)512 * LDT * 2 <= WS_END, "ws map");
static_assert(WS_XS + (size_t)T * DM * 4 <= WS_H && WS_H + (size_t)T * DM * 2 <= WS_GU && WS_DFTM + (size_t)4096 * 8192 * 2 <= WS_XS && WS_W + NL * W_LAYER <= WS_DFTM, "ws map 2");
constexpr int CW_BAR = 4096;

constexpr int RING_BYTES = 131072, LDSCTL_OFF = RING_BYTES, MISC_OFF = LDSCTL_OFF + 320, LDS_BYTES = 147456;

#define GAS __attribute__((address_space(1)))
#define LAS __attribute__((address_space(3)))
typedef unsigned short bf16;
typedef unsigned v4u __attribute__((ext_vector_type(4)));
typedef unsigned v2u __attribute__((ext_vector_type(2)));
typedef float f32x4 __attribute__((ext_vector_type(4)));
typedef float f32x2 __attribute__((ext_vector_type(2)));
#define LDS_WAIT() asm volatile("s_waitcnt lgkmcnt(0)" ::: "memory")
__device__ __forceinline__ unsigned f2bf(float f) { unsigned u = __builtin_bit_cast(unsigned, f); return (u + 0x7fffu + ((u >> 16) & 1u)) >> 16; }
__device__ __forceinline__ unsigned pk2(float lo, float hi) { return f2bf(lo) | (f2bf(hi) << 16); }
__device__ __forceinline__ float bflo(unsigned w) { return __builtin_bit_cast(float, w << 16); }
__device__ __forceinline__ float bfhi(unsigned w) { return __builtin_bit_cast(float, w & 0xffff0000u); }

#define XB_TMO      128
#define XB_XCNT(j)  (256  + 64 * (j))
#define XB_XSUB(j)  (1280 + 64 * (j))
#define XB_XGEN(j)  (2304 + 64 * (j))
#define XB_TOP      3328
#define XB_TOPGEN   3392
#define XCD_BAR_WORDS 3456
#define XB_SPIN_CAP (1u << 18)
__device__ __forceinline__ unsigned xb_ld(unsigned* p)              { return __hip_atomic_load(p, __ATOMIC_RELAXED, __HIP_MEMORY_SCOPE_AGENT); }
__device__ __forceinline__ unsigned xb_add(unsigned* p, unsigned v) { return __hip_atomic_fetch_add(p, v, __ATOMIC_RELAXED, __HIP_MEMORY_SCOPE_AGENT); }
__device__ __forceinline__ unsigned xb_xcc_id() { return (unsigned)__builtin_amdgcn_s_getreg((3 << 11) | 20) & 0xFu; }
#define XB_SPIN(cond, bar) do { unsigned _sp = 0; while (cond) { __builtin_amdgcn_s_sleep(1); \
    if ((++_sp & 255u) == 0u) { if (xb_ld(&(bar)[XB_TMO])) break; if (_sp > XB_SPIN_CAP) { atomicAdd(&(bar)[XB_TMO], 1u); break; } } } } while (0)
struct XcdBarrier { unsigned* bar; unsigned x; volatile LAS unsigned* st; };
__device__ __forceinline__ unsigned* xb_bar_ptr();
__device__ __forceinline__ XcdBarrier xcd_barrier_post(unsigned* bar, volatile LAS unsigned* st) {
    XcdBarrier b; b.bar = bar; b.x = xb_xcc_id(); b.st = st;
    if (threadIdx.x == 0) (void)xb_add(&bar[XB_XCNT(b.x)], 1u);
    return b;
}
__device__ __forceinline__ void xcd_barrier_complete(unsigned* bar, unsigned x, unsigned& nloc, unsigned& nx) {
    const unsigned G = gridDim.x * gridDim.y * gridDim.z;
    unsigned sum, cnt, mine, sp = 0u;
    for (;;) {
        sum = 0u; cnt = 0u; mine = 0u;
#pragma unroll
        for (unsigned j = 0; j < 16; ++j) { const unsigned c = xb_ld(&bar[XB_XCNT(j)]); sum += c; cnt += (c > 0u) ? 1u : 0u; mine = (j == x) ? c : mine; }
        if (sum == G) break;
        __builtin_amdgcn_s_sleep(1);
        if ((++sp & 255u) == 0u) { if (xb_ld(&bar[XB_TMO])) break; if (sp > XB_SPIN_CAP) { atomicAdd(&bar[XB_TMO], 1u); break; } }
    }
    nloc = mine > 0u ? mine : 1u; nx = cnt > 0u ? cnt : 1u;
}
__device__ __forceinline__ void xcd_barrier(const XcdBarrier& b_in) {
    XcdBarrier b; b.st = b_in.st; b.bar = xb_bar_ptr(); b.x = (unsigned)__builtin_amdgcn_readfirstlane((int)xb_xcc_id());
    asm volatile("s_waitcnt vmcnt(0)" ::: "memory");
    __syncthreads();
    if (threadIdx.x == 0) {
        unsigned* bar = b.bar;
        __builtin_amdgcn_s_waitcnt(0);
        unsigned nloc = b.st[0], nx = b.st[1];
        if (nloc == 0u) { xcd_barrier_complete(bar, b.x, nloc, nx); b.st[0] = nloc; b.st[1] = nx; }
        const unsigned old = xb_add(&bar[XB_XSUB(b.x)], 1u);
        const unsigned gen = old / nloc;
        if (old + 1u == (gen + 1u) * nloc) {
            __builtin_amdgcn_fence(__ATOMIC_RELEASE, "agent");
            asm volatile("s_waitcnt vmcnt(0)" ::: "memory");
            const unsigned og = xb_add(&bar[XB_TOP], 1u);
            const unsigned tg = og / nx;
            if (og + 1u == (tg + 1u) * nx) xb_add(&bar[XB_TOPGEN], 1u);
            else XB_SPIN(xb_ld(&bar[XB_TOPGEN]) == tg, bar);
            __builtin_amdgcn_fence(__ATOMIC_ACQUIRE, "agent");
            xb_add(&bar[XB_XGEN(b.x)], 1u);
            asm volatile("s_waitcnt vmcnt(0)" ::: "memory");
        } else {
            XB_SPIN(xb_ld(&bar[XB_XGEN(b.x)]) == gen, bar);
            __builtin_amdgcn_fence(__ATOMIC_ACQUIRE, "agent");
            asm volatile("s_waitcnt vmcnt(0)" ::: "memory");
        }
    }
    __syncthreads();
}

struct Args {
    const float *x, *c, *ctx, *c_ctx, *w_mod, *b_mod, *ffn1_norm, *ffn1_gate, *ffn1_up, *ffn1_down, *mix_norm, *w_in, *w_out, *pool_w, *pool_scale,
                *q_norm, *k_norm, *fnet_w, *na_rpb, *ffn2_norm, *ffn2_gate, *ffn2_up, *ffn2_down, *final_norm;
    float* out; unsigned char* ws;
};
struct Ctx {
    LAS unsigned char* lds; int wave, wg, G;
};
__device__ __forceinline__ int fresh_tid() { int t = threadIdx.x; asm volatile("" : "+v"(t)); return t; }
typedef const Args __attribute__((address_space(4))) * ArgsP;
__device__ __forceinline__ ArgsP fresh_args() { ArgsP p = (ArgsP)__builtin_amdgcn_kernarg_segment_ptr(); asm volatile("" : "+s"(p)); return p; }
template <int CTRL> __device__ __forceinline__ float dpp_f(float v) { return __builtin_bit_cast(float, __builtin_amdgcn_update_dpp(0, __builtin_bit_cast(int, v), CTRL, 0xf, 0xf, false)); }
__device__ __forceinline__ float row16_sum(float v) {
    v += dpp_f<0xB1>(v); v += dpp_f<0x4E>(v); v += dpp_f<0x141>(v); v += dpp_f<0x140>(v); return v;
}
__device__ __forceinline__ unsigned* xb_bar_ptr() { return (unsigned*)(fresh_args()->ws + WS_CTL) + CW_BAR; }
__device__ __forceinline__ float row16_sum_bp(float v, int lane) {
#pragma unroll
    for (int m = 1; m < 16; m <<= 1) v += __builtin_bit_cast(float, __builtin_amdgcn_ds_bpermute((lane ^ m) << 2, __builtin_bit_cast(int, v)));
    return v;
}
__device__ __forceinline__ float wave_sum(float v) {
    v = row16_sum(v);
    const float r0 = __builtin_bit_cast(float, __builtin_amdgcn_readlane(__builtin_bit_cast(int, v), 0)), r1 = __builtin_bit_cast(float, __builtin_amdgcn_readlane(__builtin_bit_cast(int, v), 16));
    const float r2 = __builtin_bit_cast(float, __builtin_amdgcn_readlane(__builtin_bit_cast(int, v), 32)), r3 = __builtin_bit_cast(float, __builtin_amdgcn_readlane(__builtin_bit_cast(int, v), 48));
    return (r0 + r1) + (r2 + r3);
}

struct EpiSwiglu {
    static constexpr bool PERM = true;
    bf16* GU;
    __device__ __forceinline__ void operator()(const pg8::f32x4 (&acc)[2][2][4][2], const pg8::Unit& u, int wr, int wc, int fr, int fq) const {
        const int row0 = u.pm * 256 + wr * 64 + fr, col0 = u.pn * 128 + wc * 32 + 8 * fq;
#pragma unroll
        for (int ai = 0; ai < 2; ++ai)
#pragma unroll
            for (int m = 0; m < 4; ++m) {
                float r[8];
#pragma unroll
                for (int n = 0; n < 2; ++n)
#pragma unroll
                    for (int j = 0; j < 4; ++j) { const float g = acc[ai][0][m][n][j], up = acc[ai][1][m][n][j];
                        const float e = __builtin_amdgcn_exp2f(-g * 1.4426950408889634f); r[n * 4 + j] = g * __builtin_amdgcn_rcpf(1.0f + e) * up; }
                v4u w; w.x = pg8::cvt_pk_bf16(r[0], r[1]); w.y = pg8::cvt_pk_bf16(r[2], r[3]); w.z = pg8::cvt_pk_bf16(r[4], r[5]); w.w = pg8::cvt_pk_bf16(r[6], r[7]);
                *(v4u*)(GU + (size_t)(row0 + ai * 128 + m * 16) * FF + col0) = w; }
    }
};
struct EpiResid {
    static constexpr bool PERM = false;
    const float* base_x; const float* base_c;
    float* XS; const float* gate;
    float coef;
    __device__ __forceinline__ void operator()(const pg8::f32x4 (&acc)[2][2][4][2], const pg8::Unit& u, int wr, int wc, int fr, int fq) const {
        const int s = u.pm < 64 ? (u.pm >> 4) : 4;
        const float* bp = u.pm < 64 ? base_x + (size_t)u.pm * 256 * DM : base_c + (size_t)(u.pm - 64) * 256 * DM;
        float* op = XS + (size_t)u.pm * 256 * DM;
        const int r0 = wr * 64 + fr, col0 = u.pn * 256 + wc * 32 + 4 * fq;
        f32x4 gv[2][2];
#pragma unroll
        for (int bj = 0; bj < 2; ++bj)
#pragma unroll
            for (int n = 0; n < 2; ++n) gv[bj][n] = *(const f32x4*)(gate + (size_t)s * NMOD + col0 + bj * 128 + n * 16) * coef;
#pragma unroll
        for (int ai = 0; ai < 2; ++ai)
#pragma unroll
            for (int m = 0; m < 4; ++m) { const size_t off = (size_t)(r0 + ai * 128 + m * 16) * DM + col0;
#pragma unroll
                for (int bj = 0; bj < 2; ++bj)
#pragma unroll
                    for (int n = 0; n < 2; ++n) { const f32x4 b = *(const f32x4*)(bp + off + bj * 128 + n * 16); *(f32x4*)(op + off + bj * 128 + n * 16) = b + gv[bj][n] * acc[ai][bj][m][n]; } }
    }
};
struct EpiZ {
    static constexpr bool PERM = true;
    bf16* Z; bf16* ABT; bf16* ABTC;
    __device__ __forceinline__ void operator()(const pg8::f32x4 (&acc)[2][2][4][2], const pg8::Unit& u, int wr, int wc, int fr, int fq) const {
        bf16* base; size_t ld;
        if (u.pn < 12) { base = Z + (size_t)u.pm * 256 * ZW + u.pn * 256; ld = ZW; }
        else { const int cc = (u.pn - 12) * 256, trig = cc >> 9, c0 = cc & 511;
            if (u.pm < 64) { const int b = u.pm >> 4, n0 = (u.pm & 15) * 256; base = ABT + (size_t)c0 * LDT + b * (2 * SEQ) + trig * SEQ + n0; ld = LDT; }
            else { const int b = u.pm - 64; base = ABTC + (size_t)c0 * LDTC + b * (2 * CTXL) + trig * CTXL; ld = LDTC; } }
        const int r0 = wr * 64 + fr, col0 = wc * 32 + 8 * fq;
#pragma unroll
        for (int ai = 0; ai < 2; ++ai)
#pragma unroll
            for (int m = 0; m < 4; ++m) { bf16* rowp = base + (size_t)(r0 + ai * 128 + m * 16) * ld + col0;
#pragma unroll
                for (int bj = 0; bj < 2; ++bj) { const pg8::f32x4 v0 = acc[ai][bj][m][0], v1 = acc[ai][bj][m][1];
                    v4u w; w.x = pg8::cvt_pk_bf16(v0[0], v0[1]); w.y = pg8::cvt_pk_bf16(v0[2], v0[3]); w.z = pg8::cvt_pk_bf16(v1[0], v1[1]); w.w = pg8::cvt_pk_bf16(v1[2], v1[3]);
                    *(v4u*)(rowp + bj * 128) = w; } }
    }
};
struct EpiBf16Plain {
    static constexpr bool PERM = true;
    bf16* O; int ldc;
    __device__ __forceinline__ void operator()(const pg8::f32x4 (&acc)[2][2][4][2], const pg8::Unit& u, int wr, int wc, int fr, int fq) const {
        bf16* base = O + (size_t)u.pm * 256 * ldc + u.pn * 256;
        const int r0 = wr * 64 + fr, col0 = wc * 32 + 8 * fq;
#pragma unroll
        for (int ai = 0; ai < 2; ++ai)
#pragma unroll
            for (int m = 0; m < 4; ++m) { bf16* rowp = base + (size_t)(r0 + ai * 128 + m * 16) * ldc + col0;
#pragma unroll
                for (int bj = 0; bj < 2; ++bj) { const pg8::f32x4 v0 = acc[ai][bj][m][0], v1 = acc[ai][bj][m][1];
                    v4u w; w.x = pg8::cvt_pk_bf16(v0[0], v0[1]); w.y = pg8::cvt_pk_bf16(v0[2], v0[3]); w.z = pg8::cvt_pk_bf16(v1[0], v1[1]); w.w = pg8::cvt_pk_bf16(v1[2], v1[3]);
                    *(v4u*)(rowp + bj * 128) = w; } }
    }
};
struct ProbPlain { const char* A; const char* B; size_t ta, tb;
    __device__ __forceinline__ const char* a_panel(const pg8::Unit& u) const { return A + (size_t)u.pm * ta; }
    __device__ __forceinline__ const char* b_panel(const pg8::Unit& u) const { return B + (size_t)u.pn * tb; } };
struct ProbInFt { const char* H; const char* W;
    __device__ __forceinline__ const char* a_panel(const pg8::Unit& u) const { return u.pn < 12 ? H + (size_t)u.pm * (256 * DM * 2) : W + (size_t)u.pn * (256 * DM * 2); }
    __device__ __forceinline__ const char* b_panel(const pg8::Unit& u) const { return u.pn < 12 ? W + (size_t)u.pn * (256 * DM * 2) : H + (size_t)u.pm * (256 * DM * 2); } };
struct ProbDft { const char* A; int amask; size_t astride; const char* B; int bshift; size_t bbatch, bpanel;
    __device__ __forceinline__ const char* a_panel(const pg8::Unit& u) const { return A + (size_t)(u.pm & amask) * astride; }
    __device__ __forceinline__ const char* b_panel(const pg8::Unit& u) const { return B + (size_t)(u.pm >> bshift) * bbatch + (size_t)u.pn * bpanel; } };

__device__ __forceinline__ void transpose_tile(const float* W, int ldw, int k0, int n0, bf16* WT, int ldt, int drow0, LAS float* scr, int lane) {
#pragma unroll 8
    for (int i = 0; i < 32; ++i) { const int kk = 2 * i + (lane >> 5); scr[kk * 33 + (lane & 31)] = W[(size_t)(k0 + kk) * ldw + n0 + (lane & 31)]; }
    LDS_WAIT(); asm volatile("" ::: "memory");
    const int c = lane & 7;
#pragma unroll
    for (int j = 0; j < 4; ++j) { const int n = (lane >> 3) + 8 * j; const LAS float* s = scr + (8 * c) * 33 + n;
        v4u o; o.x = pk2(s[0 * 33], s[1 * 33]); o.y = pk2(s[2 * 33], s[3 * 33]); o.z = pk2(s[4 * 33], s[5 * 33]); o.w = pk2(s[6 * 33], s[7 * 33]);
        *(GAS v4u*)(WT + (size_t)(drow0 + n) * ldt + k0 + 8 * c) = o; }
    LDS_WAIT(); asm volatile("" ::: "memory");
}
constexpr int CV_GU = (DM / 64) * (FF / 256), CV_D = (FF / 64) * (DM / 256), CV_IN = (DM / 64) * 10, CV_OUT = (DM / 64) * (DM / 256);
constexpr int CONV_PER_LAYER = 4 * CV_GU + 2 * CV_D + CV_IN + CV_OUT;
__device__ __forceinline__ void conv_item(const Ctx& C, ArgsP a, int it) {
    const int lane = fresh_tid() & 63;
    const int l = it / CONV_PER_LAYER; int r = it % CONV_PER_LAYER;
    unsigned char* wl = a->ws + WS_W + (size_t)l * W_LAYER;
    LAS float* scr = (LAS float*)(C.lds + C.wave * 16384);
    const float* W; int ldw, kb, nb, ldt; bf16* WT; int mode;
    if (r < 4 * CV_GU) { const int which = r / CV_GU; r %= CV_GU;
        W = ((which == 0) ? a->ffn1_gate : (which == 1) ? a->ffn1_up : (which == 2) ? a->ffn2_gate : a->ffn2_up) + (size_t)l * DM * FF;
        ldw = FF; kb = r / (FF / 256); nb = r % (FF / 256); WT = (bf16*)(wl + ((which < 2) ? WO_GU1 : WO_GU2)); ldt = DM; mode = which & 1; }
    else if ((r -= 4 * CV_GU) < 2 * CV_D) { const int which = r / CV_D; r %= CV_D;
        W = (which ? a->ffn2_down : a->ffn1_down) + (size_t)l * FF * DM; ldw = DM; kb = r / (DM / 256); nb = r % (DM / 256); WT = (bf16*)(wl + (which ? WO_D2 : WO_D1)); ldt = FF; mode = 2; }
    else if ((r -= 2 * CV_D) < CV_IN) { W = a->w_in + (size_t)l * DM * IN_DIM; ldw = IN_DIM; kb = r / 10; nb = r % 10; WT = (bf16*)(wl + WO_IN); ldt = DM; mode = 3; }
    else { r -= CV_IN; W = a->w_out + (size_t)l * DM * DM; ldw = DM; kb = r / (DM / 256); nb = r % (DM / 256); WT = (bf16*)(wl + WO_OUT); ldt = DM; mode = 2; }
    int n0 = nb * 256 + C.wave * 32, drow0;
    if (mode == 3) { n0 = (nb < 4 ? 512 + nb * 256 : 2048 + (nb - 4) * 256) + C.wave * 32; drow0 = n0 < 2048 ? n0 : n0 - 512; }
    else if (mode == 2) drow0 = n0;
    else drow0 = (n0 >> 7) * 256 + mode * 128 + (n0 & 127);
    transpose_tile(W, ldw, kb * 64, n0, WT, ldt, drow0, scr, lane);
}
__device__ __forceinline__ void fold_item(const Ctx& C, ArgsP a, int it) {
    const int khalf = it & 1, dblk = (it >> 1) & 3, g = (it >> 3) & 3, kind = (it >> 5) % 3, l = it / 96;
    LAS float* Mb = (LAS float*)C.lds;
    LAS float* Wl = (LAS float*)(C.lds + 16384);
    LAS float* tab = (LAS float*)(C.lds + 16384 + 64 * 129 * 4);
    const int tid = fresh_tid(), d0 = dblk * 32;
    __syncthreads();
    if (tid < 128) tab[tid] = cospif((float)tid * (1.0f / 64.0f));
    __syncthreads();
    if (kind == 0) {
        const float* pw = a->pool_w + ((size_t)(l * 4 + g) * 128) * 128; const float* ps = a->pool_scale + (size_t)l * 512 + g * 128;
        for (int i = tid; i < 128 * 32; i += NTHR) { const int c = i >> 5, d = i & 31; Mb[i] = pw[c * 128 + d0 + d] * ps[d0 + d]; }
    } else {
        const float* fw = a->fnet_w + ((size_t)(l * 4 + g) * 128) * 128;
        const int c = tid >> 2, dq = (tid & 3) * 8, sh = (kind == 2) ? 96 : 0;
        float acc[8];
#pragma unroll
        for (int j = 0; j < 8; ++j) acc[j] = 0.f;
        for (int e = 0; e < 128; ++e) { const float t = tab[(c * e + sh) & 127]; const f32x4 w0 = *(const f32x4*)(fw + e * 128 + d0 + dq), w1 = *(const f32x4*)(fw + e * 128 + d0 + dq + 4);
#pragma unroll
            for (int j = 0; j < 4; ++j) { acc[j] += t * w0[j]; acc[4 + j] += t * w1[j]; } }
#pragma unroll
        for (int j = 0; j < 8; ++j) Mb[c * 32 + dq + j] = acc[j];
    }
    __syncthreads();
    const int colbase = (kind == 0 ? 0 : 1536) + g * 128, rowbase = (kind == 0 ? 0 : (kind == 1 ? 3072 : 3584)) + g * 128 + d0;
    const float* Wi = a->w_in + (size_t)l * DM * IN_DIM;
    bf16* WT = (bf16*)(a->ws + WS_W + (size_t)l * W_LAYER + WO_IN);
    const int k = tid & 63, dg = (tid >> 6) * 4;
    for (int kb = khalf * 16; kb < khalf * 16 + 16; ++kb) {
        const int k0 = kb * 64;
        for (int i = tid; i < 64 * 128; i += NTHR) { const int kk = i >> 7, cc = i & 127; Wl[kk * 129 + cc] = Wi[(size_t)(k0 + kk) * IN_DIM + colbase + cc]; }
        __syncthreads();
        float acc[4] = {0.f, 0.f, 0.f, 0.f};
        for (int c = 0; c < 128; ++c) { const float w = Wl[k * 129 + c]; const f32x4 m = *(const LAS f32x4*)(Mb + c * 32 + dg);
            acc[0] += w * m[0]; acc[1] += w * m[1]; acc[2] += w * m[2]; acc[3] += w * m[3]; }
#pragma unroll
        for (int j = 0; j < 4; ++j) WT[(size_t)(rowbase + dg + j) * DM + k0 + k] = (bf16)f2bf(acc[j]);
        __syncthreads();
    }
}
__device__ __forceinline__ void mod_item(const Ctx& C, ArgsP a, int it) {
    const int tid = fresh_tid(), lane = tid & 63;
    const int l = it / 144, ch = it % 144;
    LAS float* sc = (LAS float*)C.lds;
    LAS float* red = (LAS float*)(C.lds + 5 * 2048 * 4);
    __syncthreads();
    for (int i = tid; i < 5 * DM; i += NTHR) { const int s = i / DM, k = i % DM; const float v = s < 4 ? a->c[s * DM + k] : a->c_ctx[k]; sc[i] = v / (1.0f + __expf(-v)); }
    __syncthreads();
    const float* wm = a->w_mod + (size_t)l * DM * NMOD + ch * 128 + 2 * lane;
    float acc[5][2];
#pragma unroll
    for (int s = 0; s < 5; ++s) { acc[s][0] = 0.f; acc[s][1] = 0.f; }
    const int kbeg = C.wave * 256;
#pragma unroll 4
    for (int k = kbeg; k < kbeg + 256; ++k) { const f32x2 w = *(const f32x2*)(wm + (size_t)k * NMOD);
#pragma unroll
        for (int s = 0; s < 5; ++s) { const float sv = sc[s * DM + k]; acc[s][0] += sv * w.x; acc[s][1] += sv * w.y; } }
#pragma unroll
    for (int s = 0; s < 5; ++s) { red[(C.wave * 5 + s) * 128 + 2 * lane] = acc[s][0]; red[(C.wave * 5 + s) * 128 + 2 * lane + 1] = acc[s][1]; }
    __syncthreads();
    float* mv = (float*)(a->ws + WS_MODV) + (size_t)l * 5 * NMOD;
    for (int i = tid; i < 5 * 128; i += NTHR) { const int s = i >> 7, col = i & 127; float v = 0.f;
#pragma unroll
        for (int w = 0; w < 8; ++w) v += red[(w * 5 + s) * 128 + col];
        mv[(size_t)s * NMOD + ch * 128 + col] = v + a->b_mod[(size_t)l * NMOD + ch * 128 + col]; }
    __syncthreads();
}
__device__ __forceinline__ void gen_item(const Ctx& C, ArgsP a, int it) {
    const int tid = fresh_tid();
    if (it < 256) {
        bf16* M = (bf16*)(a->ws + WS_DFTM); const float sc = 0.00138106793f;
        for (int i = tid; i < 16 * 8192 / 2; i += NTHR) { const int e = 2 * i, k = it * 16 + (e >> 13), kk = e & 8191, n = kk & 4095; const bool sn = kk >= 4096;
            float v[2];
#pragma unroll
            for (int j = 0; j < 2; ++j) { const int ph = (k * (n + j)) & 4095; const float x = (float)ph * (1.0f / 2048.0f); v[j] = sn ? -sinpif(x) * sc : cospif(x) * sc; }
            *(unsigned*)(M + (size_t)k * 8192 + kk) = pk2(v[0], v[1]); }
    } else {
        bf16* M = (bf16*)(a->ws + WS_DFTC); const float sc = 0.00552427173f;
        for (int i = tid; i < 256 * 512; i += NTHR) { const int k = i >> 9, kk = i & 511, n = kk & 255; const int ph = (k * n) & 255; const float x = (float)ph * (1.0f / 128.0f);
            M[i] = (bf16)f2bf(kk >= 256 ? -sinpif(x) * sc : cospif(x) * sc); }
        float* R = (float*)(a->ws + WS_ROPE);
        for (int i = tid; i < 64 * 32; i += NTHR) { const int p = i >> 5, j = i & 31; const float inv = exp2f(-(float)j * (13.287712379549449f / 32.0f));
            const float ang = (float)p * inv; R[2 * i] = cosf(ang); R[2 * i + 1] = sinf(ang); }
    }
}
constexpr int P0_FOLD = 192, P0_MOD = 288, P0_GEN = 257, P0_CONV = CONV_PER_LAYER * NL;
__device__ __forceinline__ void prologue_phase(const Ctx& C, ArgsP a) {
    for (int it = C.wg; it < P0_FOLD; it += C.G) fold_item(C, a, it);
    for (int it = C.wg; it < P0_MOD; it += C.G) mod_item(C, a, it);
    for (int it = C.wg; it < P0_GEN; it += C.G) gen_item(C, a, it);
    __syncthreads();
    for (int it = C.wg; it < P0_CONV; it += C.G) conv_item(C, a, it);
}

__device__ __forceinline__ void norm_phase(const Ctx& C, const float* sx, const float* scx, const float* gain, const float* modl, int ish, int isc, int nrows, bf16* H) {
    const int lane = fresh_tid() & 63;
    int G = C.G; asm volatile("" : "+s"(G));
    const int ng = nrows / 8, g0 = (int)((unsigned)(ng * C.wg) / (unsigned)G), g1 = (int)((unsigned)(ng * (C.wg + 1)) / (unsigned)G);
    int cur = -1; f32x4 A[8], Bv[8];
    for (int g = g0; g < g1; ++g) {
        const int row = g * 8 + C.wave, s = row < TX ? (row >> 12) : 4;
        if (s != cur) { cur = s;
#pragma unroll
            for (int j = 0; j < 8; ++j) { const int col = 4 * lane + 256 * j; const f32x4 gn = *(const f32x4*)(gain + col), scv = *(const f32x4*)(modl + (size_t)s * NMOD + isc * DM + col);
                A[j] = gn * (scv + 1.0f); Bv[j] = *(const f32x4*)(modl + (size_t)s * NMOD + ish * DM + col); } }
        const float* src = row < TX ? sx + (size_t)row * DM : scx + (size_t)(row - TX) * DM;
        f32x4 v[8]; float ss = 0.f;
#pragma unroll
        for (int j = 0; j < 8; ++j) { v[j] = *(const f32x4*)(src + 4 * lane + 256 * j); ss += (v[j].x * v[j].x + v[j].y * v[j].y) + (v[j].z * v[j].z + v[j].w * v[j].w); }
        const float rs = 1.0f / sqrtf(wave_sum(ss) * (1.0f / DM) + EPS);
        bf16* o = H + (size_t)row * DM + 4 * lane;
#pragma unroll
        for (int j = 0; j < 8; ++j) { const f32x4 y = v[j] * rs * A[j] + Bv[j]; v2u w; w.x = pk2(y.x, y.y); w.y = pk2(y.z, y.w); *(v2u*)(o + 256 * j) = w; }
    }
}
__device__ __forceinline__ void final_phase(const Ctx& C, const float* XS, const float* gain, float* out) {
    const int lane = fresh_tid() & 63;
    const int gw = C.wg * NWAVES + C.wave, NGW = C.G * NWAVES;
    f32x4 A[8];
#pragma unroll
    for (int j = 0; j < 8; ++j) A[j] = *(const f32x4*)(gain + 4 * lane + 256 * j);
    for (int row = gw; row < TX; row += NGW) {
        const float* src = XS + (size_t)row * DM; f32x4 v[8]; float ss = 0.f;
#pragma unroll
        for (int j = 0; j < 8; ++j) { v[j] = *(const f32x4*)(src + 4 * lane + 256 * j); ss += (v[j].x * v[j].x + v[j].y * v[j].y) + (v[j].z * v[j].z + v[j].w * v[j].w); }
        const float rs = 1.0f / sqrtf(wave_sum(ss) * (1.0f / DM) + EPS);
        float* o = out + (size_t)row * DM + 4 * lane;
#pragma unroll
        for (int j = 0; j < 8; ++j) *(f32x4*)(o + 256 * j) = v[j] * rs * A[j];
    }
}

__device__ __forceinline__ void prep_phase(const Ctx& C, bf16* Z, bf16* CC, const float* qn, const float* kn, const float* rope) {
    const int gw = C.wg * NWAVES + C.wave, NGW = C.G * NWAVES, lane = fresh_tid() & 63, l16 = lane & 15;
    for (int row = gw; row < T; row += NGW) {
        const bool isx = row < TX; const int t = isx ? (row & (SEQ - 1)) : ((row - TX) & (CTXL - 1)), seqlen = isx ? SEQ : CTXL, seq0 = row - t;
        bf16* zr = Z + (size_t)row * ZW;
#pragma unroll
        for (int p = 0; p < 2; ++p) { const int head = 4 * p + (lane >> 4);
            if (head < 6) { bf16* ptr = zr + ZGQ + head * 128 + l16 * 8; const v4u w = *(const v4u*)ptr;
                float x[8] = {bflo(w.x), bfhi(w.x), bflo(w.y), bfhi(w.y), bflo(w.z), bfhi(w.z), bflo(w.w), bfhi(w.w)};
                float ss = 0.f;
#pragma unroll
                for (int j = 0; j < 8; ++j) ss += x[j] * x[j];
                ss = row16_sum(ss);
                const float rs = 1.0f / sqrtf(ss * (1.0f / 128.0f) + EPS); const float* gn = (head < 4 ? qn : kn) + l16 * 8;
#pragma unroll
                for (int j = 0; j < 8; ++j) x[j] = x[j] * rs * gn[j];
                if (isx) { const int grow = t >> 6, gcol = t & 63;
#pragma unroll
                    for (int jj = 0; jj < 4; ++jj) { const int i = l16 * 4 + jj, pos = i < 32 ? grow : gcol; const f32x2 cs = *(const f32x2*)(rope + (pos * 32 + (i & 31)) * 2);
                        const float x1 = x[2 * jj], x2 = x[2 * jj + 1]; x[2 * jj] = x1 * cs.x - x2 * cs.y; x[2 * jj + 1] = x1 * cs.y + x2 * cs.x; } }
                v4u o; o.x = pk2(x[0], x[1]); o.y = pk2(x[2], x[3]); o.z = pk2(x[4], x[5]); o.w = pk2(x[6], x[7]); *(v4u*)ptr = o; } }
        { const int half = 1 << (lane >> 4); const int lo = (t - half) > 0 ? (t - half) : 0, hi = (t + half - 1) < (seqlen - 1) ? (t + half - 1) : (seqlen - 1);
            float s[8] = {0.f, 0.f, 0.f, 0.f, 0.f, 0.f, 0.f, 0.f};
            for (int tt = lo; tt <= hi; ++tt) { const v4u w = *(const v4u*)(Z + (size_t)(seq0 + tt) * ZW + ZP + lane * 8);
                s[0] += bflo(w.x); s[1] += bfhi(w.x); s[2] += bflo(w.y); s[3] += bfhi(w.y); s[4] += bflo(w.z); s[5] += bfhi(w.z); s[6] += bflo(w.w); s[7] += bfhi(w.w); }
            const v4u w = *(const v4u*)(zr + ZP + lane * 8); const float inv = 1.0f / (float)(hi - lo + 1);
            const float u[8] = {bflo(w.x), bfhi(w.x), bflo(w.y), bfhi(w.y), bflo(w.z), bfhi(w.z), bflo(w.w), bfhi(w.w)};
            v4u o; o.x = pk2(s[0] * inv - u[0], s[1] * inv - u[1]); o.y = pk2(s[2] * inv - u[2], s[3] * inv - u[3]); o.z = pk2(s[4] * inv - u[4], s[5] * inv - u[5]); o.w = pk2(s[6] * inv - u[6], s[7] * inv - u[7]);
            *(v4u*)(CC + (size_t)row * DM + lane * 8) = o; }
    }
}

namespace fa {
using bf16x8 = __attribute__((ext_vector_type(8))) short;
using s16x4  = __attribute__((ext_vector_type(4))) short;
using f32x16 = __attribute__((ext_vector_type(16))) float;
using u32x4  = __attribute__((ext_vector_type(4))) unsigned;
constexpr int D = 128, NW = 8, QBLK = 32, KVBLK = 64;
constexpr float SCALE = 0.088388347648318440f, THR = 8.f;
constexpr int SHM_V = KVBLK * D * 2, SHM_K = KVBLK * D * 2, SHM_ATTN = 2 * SHM_V + 2 * SHM_K + NW * 64 * 4;
constexpr int TAB_OFF = 68 * 1024, TAB_ORG = 512, TAB_N = 2048;
constexpr float NEGBIG = -1e30f;
#define KSWZ(row, colB) ((row) * 256 + ((colB) ^ (((row) & 7) << 4)))
#define SBAR() __builtin_amdgcn_sched_barrier(0)
__device__ __forceinline__ int crow(int r, int hi) { return (r & 3) + 8 * (r >> 2) + 4 * hi; }
__device__ __forceinline__ unsigned cvtpk(float lo, float hi) { unsigned r; asm volatile("v_cvt_pk_bf16_f32 %0, %1, %2" : "=v"(r) : "v"(lo), "v"(hi)); return r; }
__device__ __forceinline__ void partialSM(f32x16& p0, f32x16& p1, float& m_reg, float& mn, float& alpha) {
  constexpr float C = SCALE * 1.4426950408889634f;
  float pmax = p0[0];
#pragma unroll
  for (int r = 1; r < 16; ++r) pmax = fmaxf(pmax, p0[r]);
#pragma unroll
  for (int r = 0; r < 16; ++r) pmax = fmaxf(pmax, p1[r]);
  { auto rr = __builtin_amdgcn_permlane32_swap(__float_as_uint(pmax), __float_as_uint(pmax), false, false);
    pmax = fmaxf(__uint_as_float(rr[0]), __uint_as_float(rr[1])); }
  if (__builtin_expect(__all(pmax - m_reg <= THR / SCALE), 1)) { mn = m_reg; alpha = 1.f; }
  else { mn = fmaxf(m_reg, pmax); alpha = __builtin_amdgcn_exp2f((m_reg - mn) * C); m_reg = mn; }
  float mnC = -mn * C;
#pragma unroll
  for (int r = 0; r < 16; ++r) p0[r] = fmaf(p0[r], C, mnC);
#pragma unroll
  for (int r = 0; r < 16; ++r) p1[r] = fmaf(p1[r], C, mnC);
#pragma unroll
  for (int r = 0; r < 16; ++r) p0[r] = __builtin_amdgcn_exp2f(p0[r]);
}
__device__ __forceinline__ void finishSM(f32x16& p0, f32x16& p1, float alpha, float& l_reg, bf16x8& pa0, bf16x8& pa1, bf16x8& pa2, bf16x8& pa3) {
#pragma unroll
  for (int r = 0; r < 16; ++r) p1[r] = __builtin_amdgcn_exp2f(p1[r]);
  float ps = 0;
#pragma unroll
  for (int r = 0; r < 16; ++r) ps += p0[r];
#pragma unroll
  for (int r = 0; r < 16; ++r) ps += p1[r];
  { auto rr = __builtin_amdgcn_permlane32_swap(__float_as_uint(ps), __float_as_uint(ps), false, false);
    ps = __uint_as_float(rr[0]) + __uint_as_float(rr[1]); }
  l_reg = l_reg * alpha + ps;
#define PK4(P, BASE, OUT) do { unsigned a0 = cvtpk(P[BASE + 0], P[BASE + 1]), a1 = cvtpk(P[BASE + 2], P[BASE + 3]);   \
    unsigned b0 = cvtpk(P[BASE + 4], P[BASE + 5]), b1 = cvtpk(P[BASE + 6], P[BASE + 7]);                              \
    auto r0 = __builtin_amdgcn_permlane32_swap(a0, b0, false, false); auto r1 = __builtin_amdgcn_permlane32_swap(a1, b1, false, false); \
    u32x4 w = {r0[0], r1[0], r0[1], r1[1]}; OUT = *reinterpret_cast<bf16x8*>(&w); } while (0)
  PK4(p0, 0, pa0); PK4(p0, 8, pa1); PK4(p1, 0, pa2); PK4(p1, 8, pa3);
#undef PK4
}
__device__ __forceinline__ void qkt(f32x16& p0, f32x16& p1, const char* Ks, const bf16x8* qr, int r32, int hi) {
  p0 = f32x16{}; p1 = f32x16{};
#pragma unroll
  for (int d0 = 0; d0 < 8; ++d0) { int cb = (d0 * 16 + hi * 8) * 2;
    bf16x8 b0 = *reinterpret_cast<const bf16x8*>(Ks + KSWZ(r32, cb));
    bf16x8 b1 = *reinterpret_cast<const bf16x8*>(Ks + KSWZ(32 + r32, cb));
    p0 = __builtin_amdgcn_mfma_f32_32x32x16_bf16(b0, qr[d0], p0, 0, 0, 0);
    p1 = __builtin_amdgcn_mfma_f32_32x32x16_bf16(b1, qr[d0], p1, 0, 0, 0); }
}
__device__ __forceinline__ int v_st(int k, int c) { const int kk = (k & ~0xC) | ((k & 4) << 1) | ((k & 8) >> 1); return ((kk >> 3) * 4 + (c >> 5)) * 512 + ((kk & 7) * 32 + (c & 31)) * 2; }
__device__ __forceinline__ int v_rd_base(int lane) { return ((lane & 3) << 3) | (((lane >> 2) & 3) << 6) | (((lane >> 4) & 1) << 5) | (((lane >> 5) & 1) << 8); }
constexpr int v_rd_off(int d0, int ks, int half) { return d0 * 512 + ks * 4096 + half * 2048; }
template <int OFF> __device__ __forceinline__ s16x4 tr_read(int vb) {
  s16x4 r; asm volatile("ds_read_b64_tr_b16 %0, %1 offset:%2" : "=&v"(r) : "v"(vb), "i"(OFF) : "memory"); return r;
}
template <int D0> __device__ __forceinline__ void pv_one(f32x16& od, int vb, bf16x8 pa0, bf16x8 pa1, bf16x8 pa2, bf16x8 pa3) {
  const s16x4 l0 = tr_read<v_rd_off(D0, 0, 0)>(vb), h0 = tr_read<v_rd_off(D0, 0, 1)>(vb), l1 = tr_read<v_rd_off(D0, 1, 0)>(vb), h1 = tr_read<v_rd_off(D0, 1, 1)>(vb);
  const s16x4 l2 = tr_read<v_rd_off(D0, 2, 0)>(vb), h2 = tr_read<v_rd_off(D0, 2, 1)>(vb), l3 = tr_read<v_rd_off(D0, 3, 0)>(vb), h3 = tr_read<v_rd_off(D0, 3, 1)>(vb);
  asm volatile("s_waitcnt lgkmcnt(0)" ::: "memory"); SBAR();
#define PK(L, H) (bf16x8){L[0], L[1], L[2], L[3], H[0], H[1], H[2], H[3]}
  od = __builtin_amdgcn_mfma_f32_32x32x16_bf16(pa0, PK(l0, h0), od, 0, 0, 0);
  od = __builtin_amdgcn_mfma_f32_32x32x16_bf16(pa1, PK(l1, h1), od, 0, 0, 0);
  od = __builtin_amdgcn_mfma_f32_32x32x16_bf16(pa2, PK(l2, h2), od, 0, 0, 0);
  od = __builtin_amdgcn_mfma_f32_32x32x16_bf16(pa3, PK(l3, h3), od, 0, 0, 0);
#undef PK
}
__device__ __forceinline__ void pv_d0(f32x16* o, int vb, bf16x8 pa0, bf16x8 pa1, bf16x8 pa2, bf16x8 pa3) {
  pv_one<0>(o[0], vb, pa0, pa1, pa2, pa3); pv_one<1>(o[1], vb, pa0, pa1, pa2, pa3); pv_one<2>(o[2], vb, pa0, pa1, pa2, pa3); pv_one<3>(o[3], vb, pa0, pa1, pa2, pa3);
}
struct TileDense { int lat0, nlat, ctx0;
  __device__ __forceinline__ void operator()(int j, int& base, int& hoff) const { base = j < nlat ? lat0 + 64 * j : ctx0 + 64 * (j - nlat); hoff = 32; } };
struct TileNa { int ctx0, loc0;
  __device__ __forceinline__ void operator()(int j, int& base, int& hoff) const { if (j < 4) { base = ctx0 + 64 * j; hoff = 32; } else { base = loc0 + (j - 4) * 128; hoff = 64; } } };
__device__ __forceinline__ void na_bias(f32x16& p0, f32x16& p1, int krow, int kc0, int qr, int qc, int rs, int cs, const float* tab, int hi) {
  const bool rv0 = (unsigned)(krow - rs) < 8u, rv1 = (unsigned)(krow + 1 - rs) < 8u;
  const int cb = kc0 + 4 * hi - cs, ib = (krow - qr + 7) * 31 + (kc0 + 4 * hi - qc + 15);
  const float* t0 = tab + ib;
#pragma unroll
  for (int r = 0; r < 16; ++r) { const int co = (r & 3) + 8 * (r >> 2); const bool cv = (unsigned)(cb + co) < 16u;
    const float b0 = t0[co], b1 = t0[31 + co];
    p0[r] = (rv0 && cv) ? p0[r] + b0 : NEGBIG; p1[r] = (rv1 && cv) ? p1[r] + b1 : NEGBIG; }
}
template <bool NA, class TileF>
__device__ __forceinline__ void attn_unit(const bf16* __restrict__ Z, bf16* __restrict__ CC, int qcol, int kcol, int vcol, int outcol, int NT, const TileF& TF,
                                          int q0, int nb, int R0, int C0, int kr0, int kc0, char* lds) {
  const int tid = fresh_tid(), wid = tid >> 6, lane = tid & 63, r32 = lane & 31, hi = lane >> 5;
  char* V_lds = lds; char* K_lds = lds + 2 * SHM_V;
  float* ws = (float*)(lds + 2 * SHM_V + 2 * SHM_K) + wid * 64; float* li_l = ws; float* al_l = ws + 32;
  const float* tab = (const float*)(lds + TAB_OFF) + TAB_ORG;
  float m_reg = -1e30f, l_reg = 0; f32x16 o[4] = {}; bf16x8 qr[8];
  const int qg_r = R0 + 2 * wid + (r32 >> 4), qg_c = C0 + (r32 & 15);
  int rs = qg_r - 4; rs = rs < 0 ? 0 : (rs > 56 ? 56 : rs); int cs = qg_c - 8; cs = cs < 0 ? 0 : (cs > 48 ? 48 : cs);
  const int myrow = NA ? nb * SEQ + qg_r * 64 + qg_c : q0 + wid * 32 + r32;
  { const bf16* Qw = Z + (size_t)myrow * ZW + qcol + hi * 8;
#pragma unroll
    for (int d0 = 0; d0 < 8; ++d0) qr[d0] = *reinterpret_cast<const bf16x8*>(Qw + d0 * 16); }
  const int sr = tid >> 4, sc = (tid & 15) * 8, vst0 = v_st(sr, sc), vst1 = v_st(32 + sr, sc);
  const int vb0 = (int)(uintptr_t)V_lds + v_rd_base(lane);
  struct { bf16x8 vs0, vs1, ks0, ks1; } sr_[2];
#define SLOAD(i, j) do { int _b, _h; TF((j), _b, _h); const bf16* _p0 = Z + (size_t)(_b + sr) * ZW + sc; const bf16* _p1 = Z + (size_t)(_b + _h + sr) * ZW + sc; \
    sr_[i].vs0 = *reinterpret_cast<const bf16x8*>(_p0 + vcol); sr_[i].vs1 = *reinterpret_cast<const bf16x8*>(_p1 + vcol); \
    sr_[i].ks0 = *reinterpret_cast<const bf16x8*>(_p0 + kcol); sr_[i].ks1 = *reinterpret_cast<const bf16x8*>(_p1 + kcol); } while (0)
#define SWRITE(b, i) do { *(bf16x8*)(V_lds + (b) * SHM_V + vst0) = sr_[i].vs0; *(bf16x8*)(V_lds + (b) * SHM_V + vst1) = sr_[i].vs1; int kc = sc * 2; \
    *(bf16x8*)(K_lds + (b) * SHM_K + KSWZ(sr, kc)) = sr_[i].ks0; *(bf16x8*)(K_lds + (b) * SHM_K + KSWZ(32 + sr, kc)) = sr_[i].ks1; } while (0)
#define SWAIT() asm volatile("s_waitcnt vmcnt(4)" ::: "memory")
#define RESC(a) do { if (__any((a) < 1.f)) { if (hi == 0) al_l[r32] = (a); asm volatile("s_waitcnt lgkmcnt(0)" ::: "memory"); \
    _Pragma("unroll") for (int d = 0; d < 4; ++d) _Pragma("unroll") for (int r = 0; r < 16; ++r) o[d][r] *= al_l[crow(r, hi)]; } } while (0)
#define BIAS(P0, P1, j) do { if (NA) { if ((j) >= 4) na_bias(P0, P1, kr0 + 2 * ((j) - 4), kc0, qg_r, qg_c, rs, cs, tab, hi); } } while (0)
  f32x16 pA0, pA1, pB0, pB1; float mnA, mnB, alA, alB; bf16x8 pa0, pa1, pa2, pa3;
  constexpr int SE = 0, SO = 1;
  SLOAD(SE, 0); asm volatile("s_waitcnt vmcnt(0)" ::: "memory"); SWRITE(0, SE); __syncthreads();
  qkt(pA0, pA1, K_lds, qr, r32, hi); BIAS(pA0, pA1, 0); partialSM(pA0, pA1, m_reg, mnA, alA);
  SLOAD(SO, 1); if (2 < NT) SLOAD(SE, 2);
  SWAIT(); SWRITE(1, SO); __syncthreads();
  for (int j = 1; j + 1 < NT; j += 2) {
    SBAR(); qkt(pB0, pB1, K_lds + SHM_K, qr, r32, hi); BIAS(pB0, pB1, j);
    finishSM(pA0, pA1, alA, l_reg, pa0, pa1, pa2, pa3); SBAR();
    SLOAD(SO, j + 2); SBAR();
    pv_d0(o, vb0, pa0, pa1, pa2, pa3); partialSM(pB0, pB1, m_reg, mnB, alB);
    __syncthreads(); SWAIT(); SWRITE(0, SE);
    RESC(alB); __syncthreads();
    SBAR(); qkt(pA0, pA1, K_lds, qr, r32, hi); BIAS(pA0, pA1, j + 1);
    finishSM(pB0, pB1, alB, l_reg, pa0, pa1, pa2, pa3); SBAR();
    if (j + 3 < NT) SLOAD(SE, j + 3); SBAR();
    pv_d0(o, vb0 + SHM_V, pa0, pa1, pa2, pa3); partialSM(pA0, pA1, m_reg, mnA, alA);
    __syncthreads(); SWAIT(); SWRITE(1, SO);
    RESC(alA); __syncthreads();
  }
  SBAR(); qkt(pB0, pB1, K_lds + SHM_K, qr, r32, hi); BIAS(pB0, pB1, NT - 1);
  finishSM(pA0, pA1, alA, l_reg, pa0, pa1, pa2, pa3); SBAR();
  pv_d0(o, vb0, pa0, pa1, pa2, pa3); partialSM(pB0, pB1, m_reg, mnB, alB);
  __syncthreads(); RESC(alB);
  finishSM(pB0, pB1, alB, l_reg, pa0, pa1, pa2, pa3); SBAR();
  pv_d0(o, vb0 + SHM_V, pa0, pa1, pa2, pa3);
  if (hi == 0) li_l[r32] = l_reg; asm volatile("s_waitcnt lgkmcnt(0)" ::: "memory");
  float rli[16];
#pragma unroll
  for (int r = 0; r < 16; ++r) rli[r] = __builtin_amdgcn_rcpf(li_l[crow(r, hi)]);
  __syncthreads();
  char* stg = lds + wid * 8192;
#pragma unroll
  for (int r = 0; r < 16; ++r) { const int orow = crow(r, hi);
#pragma unroll
    for (int d0 = 0; d0 < 4; ++d0) *(unsigned short*)(stg + orow * 256 + (d0 * 32 + r32) * 2) = (unsigned short)f2bf(o[d0][r] * rli[r]); }
  asm volatile("s_waitcnt lgkmcnt(0)" ::: "memory");
#pragma unroll
  for (int i = 0; i < 8; ++i) { const int row = (lane >> 4) + 4 * i, ch = lane & 15; const v4u w = *(const v4u*)(stg + row * 256 + ch * 16);
    const int orow = NA ? nb * SEQ + (R0 + 2 * wid + (row >> 4)) * 64 + C0 + (row & 15) : q0 + wid * 32 + row;
    *(v4u*)(CC + (size_t)orow * DM + outcol + ch * 8) = w; }
  __syncthreads();
#undef SLOAD
#undef SWRITE
#undef SWAIT
#undef RESC
#undef BIAS
}
}

__device__ __forceinline__ void dense_attn_units(const Ctx& C, const bf16* Z, bf16* CC, bool with_ctx, char* lds) {
    const int half = C.G >> 1; const bool upper = C.wg >= half;
    const int uend = upper ? 256 : (with_ctx ? 288 : 256), ustep = upper ? (C.G - half) : half;
    for (int u = upper ? C.wg - half : 256 + C.wg; u < uend; u += ustep) {
        int b, qcol, kcol, vcol, outcol, NT, q0; fa::TileDense TF;
        if (u < 256) { const int bk = u & 7, idx = u >> 3, kvh = bk & 1, hq = 2 * kvh + (idx >> 4); b = bk >> 1;
            qcol = ZGQ + hq * 128; kcol = ZGK + kvh * 128; vcol = ZGV + kvh * 128; outcol = 512 + hq * 128; NT = 68; q0 = b * SEQ + (idx & 15) * 256; TF = fa::TileDense{b * SEQ, 64, TX + b * CTXL}; }
        else if (u < 272) { const int v = u - 256, hq = v & 3; b = v >> 2;
            qcol = ZGQ + hq * 128; kcol = ZGK + (hq >> 1) * 128; vcol = ZGV + (hq >> 1) * 128; outcol = 512 + hq * 128; NT = 4; q0 = TX + b * CTXL; TF = fa::TileDense{0, 0, TX + b * CTXL}; }
        else { const int v = u - 272, h = v & 3; b = v >> 2;
            qcol = ZNQ + h * 128; kcol = ZNK + h * 128; vcol = ZNV + h * 128; outcol = 1536 + h * 128; NT = 4; q0 = TX + b * CTXL; TF = fa::TileDense{0, 0, TX + b * CTXL}; }
        fa::attn_unit<false, fa::TileDense>(Z, CC, qcol, kcol, vcol, outcol, NT, TF, q0, 0, 0, 0, 0, 0, lds);
    }
}
__device__ __forceinline__ void na_units(const Ctx& C, const bf16* Z, bf16* CC, const float* rpb_l, char* lds) {
    const int half = C.G >> 1; if (C.wg >= half) return;
    float* tabz = (float*)(lds + fa::TAB_OFF);
    for (int u = C.wg; u < 256; u += half) {
        const int patch = u & 15, bh = u >> 4, h = bh & 3, b = bh >> 2, R0 = (patch >> 2) * 16, C0 = (patch & 3) * 16;
        int kr0 = R0 - 4; kr0 = kr0 < 0 ? 0 : (kr0 > 40 ? 40 : kr0); int kc0 = C0 - 8; kc0 = kc0 < 0 ? 0 : (kc0 > 32 ? 32 : kc0);
        { const int tid = fresh_tid();
            for (int i = tid; i < fa::TAB_N; i += NTHR) { const int k = i - fa::TAB_ORG; tabz[i] = (k >= 0 && k < 15 * 31) ? rpb_l[h * (15 * 31) + k] * (1.0f / fa::SCALE) : 0.f; } }
        __syncthreads();
        fa::TileNa TF{TX + b * CTXL, b * SEQ + kr0 * 64 + kc0};
        fa::attn_unit<true, fa::TileNa>(Z, CC, ZNQ + h * 128, ZNK + h * 128, ZNV + h * 128, 1536 + h * 128, 16, TF, 0, b, R0, C0, kr0, kc0, lds);
    }
}

__device__ __forceinline__ void ph_ffn_norm(const Ctx& C, int step) {
    ArgsP a = fresh_args(); unsigned char* ws = a->ws; const int l = step >> 1, second = step & 1; const bool last = (l == NL - 1);
    float* XS = (float*)(ws + WS_XS); const float* modl = (const float*)(ws + WS_MODV) + (size_t)l * 5 * NMOD;
    const float* sx = step == 0 ? a->x : XS; const float* scx = step == 0 ? a->ctx : XS + (size_t)TX * DM;
    norm_phase(C, sx, scx, (second ? a->ffn2_norm : a->ffn1_norm) + (size_t)l * DM, modl, second ? 6 : 0, second ? 7 : 1, (second && last) ? TX : T, (bf16*)(ws + WS_H));
}
__device__ __forceinline__ void ph_gu(const Ctx& C, int step) {
    ArgsP a = fresh_args(); unsigned char* ws = a->ws; const int l = step >> 1, second = step & 1; const bool last = (l == NL - 1);
    const unsigned char* wl = ws + WS_W + (size_t)l * W_LAYER;
    pg8::Dims g{DM, DM, DM}; pg8::StaticOrder S; S.init((second && last) ? TX : T, NGU, C.G, C.wg);
    ProbPlain P{(const char*)(ws + WS_H), (const char*)(wl + (second ? WO_GU2 : WO_GU1)), (size_t)256 * DM * 2, (size_t)256 * DM * 2}; EpiSwiglu E{(bf16*)(ws + WS_GU)};
    pg8::gemm_phase<EpiSwiglu, pg8::StaticOrder, ProbPlain>(C.lds, g, P, S, E);
}
__device__ __forceinline__ void ph_down(const Ctx& C, int step) {
    ArgsP a = fresh_args(); unsigned char* ws = a->ws; const int l = step >> 1, second = step & 1; const bool last = (l == NL - 1);
    const unsigned char* wl = ws + WS_W + (size_t)l * W_LAYER; float* XS = (float*)(ws + WS_XS); const float* modl = (const float*)(ws + WS_MODV) + (size_t)l * 5 * NMOD;
    const float* sx = step == 0 ? a->x : XS; const float* scx = step == 0 ? a->ctx : XS + (size_t)TX * DM;
    pg8::Dims g{FF, FF, FF}; pg8::StaticOrder S; S.init((second && last) ? TX : T, DM, C.G, C.wg);
    ProbPlain P{(const char*)(ws + WS_GU), (const char*)(wl + (second ? WO_D2 : WO_D1)), (size_t)256 * FF * 2, (size_t)256 * FF * 2};
    EpiResid E{sx, scx, XS, modl + (second ? 8 : 2) * DM, 0.5f};
    pg8::gemm_phase<EpiResid, pg8::StaticOrder, ProbPlain>(C.lds, g, P, S, E);
}
__device__ __forceinline__ void ph_mix_norm(const Ctx& C, int l) {
    ArgsP a = fresh_args(); unsigned char* ws = a->ws; float* XS = (float*)(ws + WS_XS);
    norm_phase(C, XS, XS + (size_t)TX * DM, a->mix_norm + (size_t)l * DM, (const float*)(ws + WS_MODV) + (size_t)l * 5 * NMOD, 3, 4, T, (bf16*)(ws + WS_H));
}
__device__ __forceinline__ void ph_inft(const Ctx& C, int l) {
    ArgsP a = fresh_args(); unsigned char* ws = a->ws; const unsigned char* wl = ws + WS_W + (size_t)l * W_LAYER;
    pg8::Dims g{DM, DM, DM}; pg8::StaticOrder S; S.init(T, NIN, C.G, C.wg);
    ProbInFt P{(const char*)(ws + WS_H), (const char*)(wl + WO_IN)}; EpiZ E{(bf16*)(ws + WS_Z), (bf16*)(ws + WS_ABT), (bf16*)(ws + WS_ABTC)};
    pg8::gemm_phase<EpiZ, pg8::StaticOrder, ProbInFt>(C.lds, g, P, S, E);
}
__device__ __forceinline__ void ph_prep(const Ctx& C, int l) {
    ArgsP a = fresh_args(); unsigned char* ws = a->ws;
    prep_phase(C, (bf16*)(ws + WS_Z), (bf16*)(ws + WS_CC), a->q_norm + (size_t)l * 128, a->k_norm + (size_t)l * 128, (const float*)(ws + WS_ROPE));
}
__device__ __forceinline__ void ph_dft(const Ctx& C, int l) {
    ArgsP a = fresh_args(); unsigned char* ws = a->ws; const bool last = (l == NL - 1);
    bf16* CC = (bf16*)(ws + WS_CC);
    for (int pass = 0; pass < (last ? 1 : 2); ++pass) {
        pg8::Dims g = pass ? pg8::Dims{2 * CTXL, 2 * CTXL, LDTC} : pg8::Dims{2 * SEQ, 2 * SEQ, LDT};
        pg8::StaticOrder S; if (pass) S.init(TC, 512, C.G, C.wg); else S.init(TX, 512, C.G, C.wg);
        ProbDft P = pass ? ProbDft{(const char*)(ws + WS_DFTC), 0, 0, (const char*)(ws + WS_ABTC), 0, (size_t)2 * CTXL * 2, (size_t)256 * LDTC * 2}
                         : ProbDft{(const char*)(ws + WS_DFTM), 15, (size_t)256 * 2 * SEQ * 2, (const char*)(ws + WS_ABT), 4, (size_t)2 * SEQ * 2, (size_t)256 * LDT * 2};
        EpiBf16Plain E{CC + (pass ? (size_t)TX * DM : 0) + 1024, DM};
        pg8::gemm_phase<EpiBf16Plain, pg8::StaticOrder, ProbDft>(C.lds, g, P, S, E);
    }
}
__device__ __forceinline__ void ph_attn(const Ctx& C, int l, char* lds) {
    ArgsP a = fresh_args(); unsigned char* ws = a->ws; const bool last = (l == NL - 1);
    dense_attn_units(C, (const bf16*)(ws + WS_Z), (bf16*)(ws + WS_CC), !last, lds);
}
__device__ __forceinline__ void ph_na(const Ctx& C, int l, char* lds) {
    ArgsP a = fresh_args(); unsigned char* ws = a->ws;
    na_units(C, (const bf16*)(ws + WS_Z), (bf16*)(ws + WS_CC), a->na_rpb + (size_t)l * 4 * 15 * 31, lds);
}
__device__ __forceinline__ void ph_out(const Ctx& C, int l) {
    ArgsP a = fresh_args(); unsigned char* ws = a->ws; const bool last = (l == NL - 1);
    const unsigned char* wl = ws + WS_W + (size_t)l * W_LAYER; float* XS = (float*)(ws + WS_XS); const float* modl = (const float*)(ws + WS_MODV) + (size_t)l * 5 * NMOD;
    pg8::Dims g{DM, DM, DM}; pg8::StaticOrder S; S.init(last ? TX : T, DM, C.G, C.wg);
    ProbPlain P{(const char*)(ws + WS_CC), (const char*)(wl + WO_OUT), (size_t)256 * DM * 2, (size_t)256 * DM * 2};
    EpiResid E{XS, XS + (size_t)TX * DM, XS, modl + 5 * DM, 1.0f};
    pg8::gemm_phase<EpiResid, pg8::StaticOrder, ProbPlain>(C.lds, g, P, S, E);
}

__global__ void __launch_bounds__(NTHR, 2) dit_fwd(Args a_unused) {
    extern __shared__ __attribute__((aligned(16))) unsigned char lds_raw[];
    Ctx C; C.lds = (LAS unsigned char*)lds_raw; C.wave = __builtin_amdgcn_readfirstlane((int)threadIdx.x >> 6); C.wg = blockIdx.x; C.G = gridDim.x;
    volatile LAS unsigned* MISC = (volatile LAS unsigned*)(C.lds + MISC_OFF);
    for (int u = threadIdx.x; u < (LDS_BYTES - LDSCTL_OFF) / 4; u += NTHR) ((LAS unsigned*)(C.lds + LDSCTL_OFF))[u] = 0u;
    __syncthreads();
    XcdBarrier bar = xcd_barrier_post((unsigned*)(fresh_args()->ws + WS_CTL) + CW_BAR, MISC + 8);

    prologue_phase(C, fresh_args());
    xcd_barrier(bar);

    for (int step = 0; step < 2 * NL; ++step) {
        const int l = step >> 1;
        ph_ffn_norm(C, step); xcd_barrier(bar);
        ph_gu(C, step);       xcd_barrier(bar);
        ph_down(C, step);     xcd_barrier(bar);
        if (!(step & 1)) {
            ph_mix_norm(C, l); xcd_barrier(bar);
            ph_inft(C, l);     xcd_barrier(bar);
            ph_prep(C, l);     xcd_barrier(bar);
            ph_dft(C, l); ph_attn(C, l, (char*)lds_raw); ph_na(C, l, (char*)lds_raw); xcd_barrier(bar);
            ph_out(C, l);      xcd_barrier(bar);
        }
    }
    { ArgsP a = fresh_args(); final_phase(C, (const float*)(a->ws + WS_XS), a->final_norm, a->out); }
}

extern "C" void kernel_launch(void* const* d_in, const int* in_sizes, int n_in, void* d_out, int out_size, void* d_ws, size_t ws_size, hipStream_t stream) {
    static int grid = 0;
    if (grid == 0) {
        if (n_in != 24 || in_sizes[0] != TX * DM || out_size != TX * DM || ws_size < WS_END) { fprintf(stderr, "kernel_launch: shape/workspace mismatch (n_in %d, in0 %d, out %d, ws %zu < %zu)\n", n_in, n_in > 0 ? in_sizes[0] : -1, out_size, ws_size, (size_t)WS_END); grid = -1; return; }
        int dev = 0, cus = 0, per_cu = 0;
        if (hipGetDevice(&dev) != hipSuccess || hipDeviceGetAttribute(&cus, hipDeviceAttributeMultiprocessorCount, dev) != hipSuccess) { grid = -1; return; }
        if (hipFuncSetAttribute((const void*)dit_fwd, hipFuncAttributeMaxDynamicSharedMemorySize, LDS_BYTES) != hipSuccess) { fprintf(stderr, "kernel_launch: hipFuncSetAttribute failed\n"); grid = -1; return; }
        if (hipOccupancyMaxActiveBlocksPerMultiprocessor(&per_cu, (const void*)dit_fwd, NTHR, LDS_BYTES) != hipSuccess || per_cu < 1) fprintf(stderr, "kernel_launch: occupancy query reports %d\n", per_cu);
        (void)hipGetLastError();
        grid = cus;
    }
    if (grid < 0) return;
    if (hipMemsetAsync((char*)d_ws + WS_CTL, 0, CTL_ZERO_BYTES, stream) != hipSuccess) return;
    Args a{};
    const float* const* in = (const float* const*)d_in;
    a.x = in[0]; a.c = in[1]; a.ctx = in[2]; a.c_ctx = in[3]; a.w_mod = in[4]; a.b_mod = in[5]; a.ffn1_norm = in[6]; a.ffn1_gate = in[7]; a.ffn1_up = in[8]; a.ffn1_down = in[9];
    a.mix_norm = in[10]; a.w_in = in[11]; a.w_out = in[12]; a.pool_w = in[13]; a.pool_scale = in[14]; a.q_norm = in[15]; a.k_norm = in[16]; a.fnet_w = in[17]; a.na_rpb = in[18];
    a.ffn2_norm = in[19]; a.ffn2_gate = in[20]; a.ffn2_up = in[21]; a.ffn2_down = in[22]; a.final_norm = in[23];
    a.out = (float*)d_out; a.ws = (unsigned char*)d_ws;
    hipLaunchKernelGGL(dit_fwd, dim3(grid), dim3(NTHR), LDS_BYTES, stream, a);
    const hipError_t le = hipPeekAtLastError();
    if (le != hipSuccess) fprintf(stderr, "kernel_launch: launch failed: %s\n", hipGetErrorName(le));
}
```

```cpp
#include <hip/hip_runtime.h>
#include <cstdio>
#include <cstdint>

namespace pg8 {
#define PG8_LAS __attribute__((address_space(3)))
typedef unsigned short bf16_t;
typedef short bf16x8 __attribute__((ext_vector_type(8)));
typedef float f32x4 __attribute__((ext_vector_type(4)));
typedef unsigned u32x4 __attribute__((ext_vector_type(4)));
constexpr int BM = 256, BK = 64, HALF = 128, HTB = HALF * BK * 2, STAGE_BYTES = 8 * HTB, NXCD = 8, WGM = 8;

__host__ __device__ __forceinline__ int lds_byte(int r, int c) { const int st = (r >> 4) * 2 + (c >> 5), rr = r & 15, cc = c & 31, ob = rr * 64 + cc * 2; return st * 1024 + (ob ^ (((ob >> 9) & 1) << 5)); }
__host__ __device__ __forceinline__ void stage_rc(int b, int& R, int& C) { const int st = b / 1024, sb = b % 1024, swz = sb ^ (((sb >> 9) & 1) << 5); R = (st >> 1) * 16 + swz / 64; C = (st & 1) * 32 + (swz % 64) / 2; }
__host__ __device__ __forceinline__ int perm32(int rho) { const int n = rho >> 4, i = rho & 15; return 8 * (i >> 2) + 4 * n + (i & 3); }

struct Unit { int pm, pn; };
struct Dims { int K, lda, ldb; };
__device__ __forceinline__ int fresh_tid_pg8() { int t = threadIdx.x; asm volatile("" : "+v"(t)); return t; }

struct StaticOrder {
    int nM, nN, nwg, G, c;
    __host__ __device__ void init(int M, int N, int G_, int c_) { nM = M / BM; nN = N / BM; nwg = nM * nN; G = G_; c = c_; }
    __host__ __device__ bool next(int i, Unit& u) const { return at((long)i * G + c, u); }
    __host__ __device__ bool at(long L, Unit& u) const {
        if (L >= nwg) return false;
        int wgid = (int)L; { const int q = nwg / NXCD, r = nwg % NXCD, xcd = wgid % NXCD, off = wgid / NXCD; wgid = (xcd < r ? xcd * (q + 1) : r * (q + 1) + (xcd - r) * q) + off; }
        const int nig = WGM * nN, gid = wgid / nig, fm = gid * WGM, gsz = (nM - fm) < WGM ? (nM - fm) : WGM;
        u.pm = fm + ((wgid % nig) % gsz); u.pn = (wgid % nig) / gsz; return true;
    }
};

struct DynOrder {
    StaticOrder so; int nstat; unsigned* heads; volatile PG8_LAS unsigned* slot; int ncls = 1;
    __device__ __forceinline__ bool next(int i, Unit& u) const {
        if (i < nstat || (so.G & 7)) return so.at((long)i * so.G + so.c, u);
        if (threadIdx.x == 0) {
            const unsigned one = 1u; const long lsplit = (long)(nstat + ncls) * so.G;
            bool ex = (ncls == 0) || ((i > nstat) && slot[1] != 0u); if (i == nstat) slot[1] = 0u;
            long L = so.nwg;
            if (!ex) { unsigned m_; unsigned* hp = heads + 64 * (so.c & 7);
                asm volatile("global_atomic_add %0, %1, %2, off sc0\n\ts_waitcnt vmcnt(0)" : "=&v"(m_) : "v"(hp), "v"(one) : "memory");
                L = (long)nstat * so.G + 8l * m_ + (so.c & 7); if (L >= lsplit) { slot[1] = 1u; ex = true; L = so.nwg; } }
            if (ex && lsplit < so.nwg) { unsigned g_; unsigned* hp = heads + 768;
                asm volatile("global_atomic_add %0, %1, %2, off sc0\n\ts_waitcnt vmcnt(0)" : "=&v"(g_) : "v"(hp), "v"(one) : "memory");
                L = lsplit + g_; }
            *slot = (unsigned)(L < so.nwg ? L : so.nwg); asm volatile("s_waitcnt lgkmcnt(0)" ::: "memory"); }
        asm volatile("" ::: "memory"); __builtin_amdgcn_s_barrier(); asm volatile("" ::: "memory");
        const unsigned Lc = *slot;
        return so.at((long)Lc, u);
    }
};
__device__ __forceinline__ unsigned cvt_pk_bf16(float lo, float hi) { unsigned r; asm volatile("v_cvt_pk_bf16_f32 %0, %1, %2" : "=v"(r) : "v"(lo), "v"(hi)); return r; }

template <class Epi, class Sched, class Prob, bool ALIGN_EPI = true, bool SP2 = true>
__device__ __forceinline__ void gemm_phase(PG8_LAS unsigned char* lds, const Dims g, const Prob& P, const Sched& S, const Epi& E) {
    const int tid = fresh_tid_pg8(), wid = __builtin_amdgcn_readfirstlane(tid >> 6), lane = tid & 63, wr = wid >> 2, wc = wid & 3, fr = lane & 15, fq = lane >> 4;
    const int K = g.K, nt = K / BK;
    unsigned voffA[2], voffB[2];
#pragma unroll
    for (int i = 0; i < 2; ++i) { int R, C; stage_rc(tid * 16 + i * 8192, R, C); const int Rb = Epi::PERM ? ((R & ~31) + perm32(R & 31)) : R;
        voffA[i] = (unsigned)(R * g.lda + C) * 2u; voffB[i] = (unsigned)(Rb * g.ldb + C) * 2u; }
    const size_t kstep = (size_t)(BK * 2);
    const size_t hstepA = (size_t)HALF * g.lda * 2, hstepB = (size_t)HALF * g.ldb * 2;
    const unsigned ldsw = (unsigned)wid * 1024u;
    const int aoff = lds_byte(wr * 64 + fr, fq * 8), boff = lds_byte(wc * 32 + fr, fq * 8);
#define PG8_SA(b, h) (((b) * 2 + (h)) * HTB)
#define PG8_SB(b, h) ((4 + (b) * 2 + (h)) * HTB)
#define PG8_STAGE(bufoff, gbase, voff) do { _Pragma("unroll") for (int _i = 0; _i < 2; ++_i) \
        __builtin_amdgcn_global_load_lds((const unsigned*)((const char*)(gbase) + (voff)[_i]), (PG8_LAS unsigned*)(lds + (bufoff) + ldsw + _i * 8192), 16, 0, 0); } while (0)
#define PG8_LDA(dst, b, h) do { _Pragma("unroll") for (int m = 0; m < 4; ++m) _Pragma("unroll") for (int k = 0; k < 2; ++k) dst[m][k] = *(const PG8_LAS bf16x8*)(lds + PG8_SA(b, h) + aoff + m * 2048 + k * 1024); } while (0)
#define PG8_LDB(dst, b, h) do { _Pragma("unroll") for (int n = 0; n < 2; ++n) _Pragma("unroll") for (int k = 0; k < 2; ++k) dst[n][k] = *(const PG8_LAS bf16x8*)(lds + PG8_SB(b, h) + boff + n * 2048 + k * 1024); } while (0)
#define PG8_MMA(ai, bj, At, Bt) do { __builtin_amdgcn_s_setprio(1); _Pragma("unroll") for (int m = 0; m < 4; ++m) _Pragma("unroll") for (int n = 0; n < 2; ++n) _Pragma("unroll") for (int k = 0; k < 2; ++k) \
        acc[ai][bj][m][n] = __builtin_amdgcn_mfma_f32_16x16x32_bf16(Bt[n][k], At[m][k], acc[ai][bj][m][n], 0, 0, 0); __builtin_amdgcn_s_setprio(0); } while (0)
#define PG8_WAIT_V(n) asm volatile("s_waitcnt vmcnt(" #n ")" ::: "memory")
#define PG8_WAIT_L(n) asm volatile("s_waitcnt lgkmcnt(" #n ")" ::: "memory")
#define PG8_BAR __builtin_amdgcn_s_barrier()
#define PG8_SCHED __builtin_amdgcn_sched_barrier(0)
    Unit cur, nxt; int ui = 0;
    if (!S.next(0, cur)) return;
    f32x4 acc[2][2][4][2];
#pragma unroll
    for (int a = 0; a < 2; ++a)
#pragma unroll
        for (int b = 0; b < 2; ++b)
#pragma unroll
            for (int m = 0; m < 4; ++m)
#pragma unroll
                for (int n = 0; n < 2; ++n) acc[a][b][m][n] = (f32x4){0.f, 0.f, 0.f, 0.f};
    bf16x8 At[4][2], B0[2][2], B1[2][2];
    const char* cA = P.a_panel(cur); const char* cB = P.b_panel(cur);
    if constexpr (SP2) {
        PG8_STAGE(PG8_SB(0, 0), cB, voffB); PG8_STAGE(PG8_SB(0, 1), cB + hstepB, voffB); PG8_STAGE(PG8_SA(0, 0), cA, voffA); PG8_STAGE(PG8_SA(0, 1), cA + hstepA, voffA);
        if (wr == 1) PG8_BAR;
        PG8_WAIT_V(2); PG8_BAR;
        PG8_STAGE(PG8_SB(1, 0), cB + kstep, voffB); PG8_STAGE(PG8_SA(1, 0), cA + kstep, voffA); PG8_STAGE(PG8_SB(1, 1), cB + hstepB + kstep, voffB);
        PG8_WAIT_V(6); PG8_BAR;
    } else {
        PG8_STAGE(PG8_SB(0, 0), cB, voffB); PG8_STAGE(PG8_SA(0, 0), cA, voffA); PG8_STAGE(PG8_SB(0, 1), cB + hstepB, voffB); PG8_STAGE(PG8_SA(0, 1), cA + hstepA, voffA);
        if (wr == 1) PG8_BAR;
        PG8_WAIT_V(4); PG8_BAR;
        PG8_STAGE(PG8_SB(1, 0), cB + kstep, voffB); PG8_STAGE(PG8_SA(1, 0), cA + kstep, voffA); PG8_STAGE(PG8_SB(1, 1), cB + hstepB + kstep, voffB);
        PG8_WAIT_V(6); PG8_BAR;
    }
    for (;;) {
        const bool has_next = S.next(ui + 1, nxt);
        const char* nA = has_next ? P.a_panel(nxt) : cA; const char* nB = has_next ? P.b_panel(nxt) : cB;
        for (int t = 0; t < nt; t += 2) {
            const bool last = (t == nt - 2);
            const char* a1 = cA + (size_t)(t + 1) * kstep;
            const char* a2 = last ? nA : cA + (size_t)(t + 2) * kstep; const char* b2 = last ? nB : cB + (size_t)(t + 2) * kstep;
            const char* a3 = a2 + kstep; const char* b3 = b2 + kstep;
            if constexpr (SP2) {
            PG8_LDB(B0, 0, 0); PG8_LDB(B1, 0, 1); PG8_SCHED; PG8_LDA(At, 0, 0); PG8_STAGE(PG8_SA(1, 1), a1 + hstepA, voffA);
            PG8_WAIT_V(8); PG8_WAIT_L(0); PG8_BAR; PG8_MMA(0, 0, At, B0); PG8_MMA(0, 1, At, B1); PG8_BAR; PG8_SCHED;
            PG8_LDA(At, 0, 1); PG8_STAGE(PG8_SB(0, 0), b2, voffB); PG8_STAGE(PG8_SB(0, 1), b2 + hstepB, voffB); PG8_STAGE(PG8_SA(0, 0), a2, voffA);
            PG8_WAIT_V(8); PG8_WAIT_L(0); PG8_BAR; PG8_MMA(1, 0, At, B0); PG8_MMA(1, 1, At, B1); PG8_BAR; PG8_SCHED;
            PG8_LDB(B0, 1, 0); PG8_LDB(B1, 1, 1); PG8_SCHED; PG8_LDA(At, 1, 0); PG8_STAGE(PG8_SA(0, 1), a2 + hstepA, voffA);
            PG8_WAIT_V(8); PG8_WAIT_L(0); PG8_BAR; PG8_MMA(0, 0, At, B0); PG8_MMA(0, 1, At, B1); PG8_BAR; PG8_SCHED;
            PG8_LDA(At, 1, 1); PG8_STAGE(PG8_SB(1, 0), b3, voffB); PG8_STAGE(PG8_SB(1, 1), b3 + hstepB, voffB); PG8_STAGE(PG8_SA(1, 0), a3, voffA);
            PG8_WAIT_V(8); PG8_WAIT_L(0); PG8_BAR; PG8_MMA(1, 0, At, B0); PG8_MMA(1, 1, At, B1); PG8_BAR; PG8_SCHED;
            } else {
            PG8_LDB(B0, 0, 0); PG8_SCHED; PG8_LDA(At, 0, 0); PG8_STAGE(PG8_SA(1, 1), a1 + hstepA, voffA);
            PG8_WAIT_L(8); PG8_BAR; PG8_WAIT_L(0); PG8_MMA(0, 0, At, B0); PG8_BAR; PG8_SCHED;
            PG8_LDB(B1, 0, 1); PG8_STAGE(PG8_SB(0, 0), b2, voffB);
            PG8_BAR; PG8_WAIT_L(0); PG8_MMA(0, 1, At, B1); PG8_BAR;
            PG8_LDA(At, 0, 1); PG8_STAGE(PG8_SA(0, 0), a2, voffA);
            PG8_BAR; PG8_WAIT_L(0); PG8_MMA(1, 0, At, B0); PG8_BAR; PG8_SCHED;
            PG8_STAGE(PG8_SB(0, 1), b2 + hstepB, voffB);
            PG8_WAIT_V(6); PG8_BAR; PG8_MMA(1, 1, At, B1); PG8_BAR;
            PG8_LDB(B0, 1, 0); PG8_SCHED; PG8_LDA(At, 1, 0); PG8_STAGE(PG8_SA(0, 1), a2 + hstepA, voffA);
            PG8_WAIT_L(8); PG8_BAR; PG8_WAIT_L(0); PG8_MMA(0, 0, At, B0); PG8_BAR; PG8_SCHED;
            PG8_LDB(B1, 1, 1); PG8_STAGE(PG8_SB(1, 0), b3, voffB);
            PG8_BAR; PG8_WAIT_L(0); PG8_MMA(0, 1, At, B1); PG8_BAR;
            PG8_LDA(At, 1, 1); PG8_STAGE(PG8_SA(1, 0), a3, voffA);
            PG8_BAR; PG8_WAIT_L(0); PG8_MMA(1, 0, At, B0); PG8_BAR; PG8_SCHED;
            PG8_STAGE(PG8_SB(1, 1), b3 + hstepB, voffB);
            PG8_WAIT_V(6); PG8_BAR; PG8_MMA(1, 1, At, B1); PG8_BAR;
            }
        }
        if constexpr (ALIGN_EPI) { if (wr == 0) PG8_BAR; }
        E(acc, cur, wr, wc, fr, fq);
        if (!has_next) break;
#pragma unroll
        for (int a = 0; a < 2; ++a)
#pragma unroll
            for (int b = 0; b < 2; ++b)
#pragma unroll
                for (int m = 0; m < 4; ++m)
#pragma unroll
                    for (int n = 0; n < 2; ++n) acc[a][b][m][n] = (f32x4){0.f, 0.f, 0.f, 0.f};
        cur = nxt; cA = nA; cB = nB; ++ui;
        if constexpr (ALIGN_EPI) { if (wr == 1) PG8_BAR; }
    }
    PG8_WAIT_V(0);
    if constexpr (!ALIGN_EPI) { if (wr == 0) PG8_BAR; }
    PG8_BAR;
#undef PG8_SA
#undef PG8_SB
#undef PG8_STAGE
#undef PG8_LDA
#undef PG8_LDB
#undef PG8_MMA
#undef PG8_WAIT_V
#undef PG8_WAIT_L
#undef PG8_BAR
#undef PG8_SCHED
}
}

constexpr int NWAVES = 8, NTHR = 512;
constexpr int NB = 4, SEQ = 4096, CTXL = 256, DM = 2048, FF = 5632, NGU = 2 * FF, NL = 2;
constexpr int FFP = FF + 64;
constexpr int TX = NB * SEQ, TC = NB * CTXL, T = TX + TC;
constexpr int ZW = 3072;
constexpr int ZP = 0, ZGQ = 512, ZGK = 1024, ZGV = 1280, ZNQ = 1536, ZNK = 2048, ZNV = 2560;
constexpr int NIN = 4096;
constexpr int LDT = 2 * NB * SEQ + 64, LDTC = 2 * NB * CTXL + 64;
constexpr int NMOD = 9 * DM;
constexpr float EPS = 1e-6f;
constexpr int IN_DIM = 3584;

constexpr size_t MiB = 1u << 20;
constexpr size_t WS_CTL = 0, CTL_ZERO_BYTES = 1 * MiB;
constexpr size_t WS_MODV = 1 * MiB;
constexpr size_t WS_ROPE = 1 * MiB + 768 * 1024;
constexpr size_t WS_DFTC = 2 * MiB;
constexpr size_t WS_ABTC = 3 * MiB;
constexpr size_t WS_W = 8 * MiB, W_LAYER = 158 * MiB;
constexpr size_t WO_GU1 = 0, WO_D1 = 44 * MiB, WO_IN = 67 * MiB, WO_OUT = 83 * MiB, WO_GU2 = 91 * MiB, WO_D2 = 135 * MiB;
constexpr size_t WS_DFTM = 324 * MiB;
constexpr size_t WS_XS = 388 * MiB;
constexpr size_t WS_H = 524 * MiB;
constexpr size_t WS_GU = 592 * MiB;
constexpr size_t WS_Z = 592 * MiB;
constexpr size_t WS_CC = 694 * MiB;
constexpr size_t WS_ABT = 782 * MiB;
constexpr size_t WS_SLAB = 815 * MiB;
constexpr size_t WS_END = 847 * MiB;
static_assert(WS_Z + (size_t)T * ZW * 2 <= WS_CC && WS_CC + (size_t)T * DM * 2 <= WS_GU + (size_t)T * FFP * 2 && WS_GU + (size_t)T * FFP * 2 <= WS_ABT && WS_ABT + (size_t)512 * LDT * 2 <= WS_SLAB && WS_SLAB + (size_t)4 * TC * DM * 4 <= WS_END, "ws map");
static_assert(WS_XS + (size_t)T * DM * 4 <= WS_H && WS_H + (size_t)T * DM * 2 <= WS_GU && WS_DFTM + (size_t)4096 * 8192 * 2 <= WS_XS && WS_W + NL * W_LAYER <= WS_DFTM, "ws map 2");
static_assert((size_t)DM * FFP * 2 <= 23 * MiB && (size_t)NGU * DM * 2 <= 44 * MiB, "weight regions");
constexpr int CW_BAR = 4096;

constexpr int RING_BYTES = 131072, CONV_SCR = 17408  , LDSCTL_OFF = 143360, MISC_OFF = LDSCTL_OFF + 320, LDS_BYTES = 147456;
static_assert(8 * CONV_SCR <= LDSCTL_OFF && 64 * 65 * 4 <= CONV_SCR, "LDS map");

#define GAS __attribute__((address_space(1)))
#define LAS __attribute__((address_space(3)))
typedef unsigned short bf16;
typedef unsigned v4u __attribute__((ext_vector_type(4)));
typedef unsigned v2u __attribute__((ext_vector_type(2)));
typedef float f32x4 __attribute__((ext_vector_type(4)));
typedef float f32x2 __attribute__((ext_vector_type(2)));
#define LDS_WAIT() asm volatile("s_waitcnt lgkmcnt(0)" ::: "memory")
__device__ __forceinline__ unsigned f2bf(float f) { unsigned u = __builtin_bit_cast(unsigned, f); return (u + 0x7fffu + ((u >> 16) & 1u)) >> 16; }
__device__ __forceinline__ unsigned pk2(float lo, float hi) { return f2bf(lo) | (f2bf(hi) << 16); }
typedef _Float16 h16;
typedef _Float16 h4 __attribute__((ext_vector_type(4)));
__device__ __forceinline__ f32x4 ld_h4(const h16* p) { return __builtin_convertvector(*(const h4*)p, f32x4); }
__device__ __forceinline__ void st_h4(h16* p, f32x4 v) { *(h4*)p = __builtin_convertvector(v, h4); }
__device__ __forceinline__ f32x4 ld_h4_reg(f32x4 v) { return __builtin_convertvector(__builtin_convertvector(v, h4), f32x4); }
__device__ __forceinline__ float bflo(unsigned w) { return __builtin_bit_cast(float, w << 16); }
__device__ __forceinline__ float bfhi(unsigned w) { return __builtin_bit_cast(float, w & 0xffff0000u); }

#define XB_TMO      128
#define XB_XCNT(j)  (256  + 64 * (j))
#define XB_XSUB(j)  (1280 + 64 * (j))
#define XB_XGEN(j)  (2304 + 64 * (j))
#define XB_TOP      3328
#define XB_TOPGEN   3392
#define XCD_BAR_WORDS 3456
#define XB_SPIN_CAP (1u << 18)
__device__ __forceinline__ unsigned xb_ld(unsigned* p)              { return __hip_atomic_load(p, __ATOMIC_RELAXED, __HIP_MEMORY_SCOPE_AGENT); }
__device__ __forceinline__ unsigned xb_add(unsigned* p, unsigned v) { return __hip_atomic_fetch_add(p, v, __ATOMIC_RELAXED, __HIP_MEMORY_SCOPE_AGENT); }
__device__ __forceinline__ unsigned xb_xcc_id() { return (unsigned)__builtin_amdgcn_s_getreg((3 << 11) | 20) & 0xFu; }
#define XB_SPIN(cond, bar) do { unsigned _sp = 0; while (cond) { __builtin_amdgcn_s_sleep(1); \
    if ((++_sp & 255u) == 0u) { if (xb_ld(&(bar)[XB_TMO])) break; if (_sp > XB_SPIN_CAP) { atomicAdd(&(bar)[XB_TMO], 1u); break; } } } } while (0)
struct XcdBarrier { unsigned* bar; unsigned x; volatile LAS unsigned* st; };
__device__ __forceinline__ unsigned* xb_bar_ptr();
__device__ __forceinline__ XcdBarrier xcd_barrier_post(unsigned* bar, volatile LAS unsigned* st) {
    XcdBarrier b; b.bar = bar; b.x = xb_xcc_id(); b.st = st;
    if (threadIdx.x == 0) (void)xb_add(&bar[XB_XCNT(b.x)], 1u);
    return b;
}
__device__ __forceinline__ void xcd_barrier_complete(unsigned* bar, unsigned x, unsigned& nloc, unsigned& nx) {
    const unsigned G = gridDim.x * gridDim.y * gridDim.z;
    unsigned sum, cnt, mine, sp = 0u;
    for (;;) {
        sum = 0u; cnt = 0u; mine = 0u;
#pragma unroll
        for (unsigned j = 0; j < 16; ++j) { const unsigned c = xb_ld(&bar[XB_XCNT(j)]); sum += c; cnt += (c > 0u) ? 1u : 0u; mine = (j == x) ? c : mine; }
        if (sum == G) break;
        __builtin_amdgcn_s_sleep(1);
        if ((++sp & 255u) == 0u) { if (xb_ld(&bar[XB_TMO])) break; if (sp > XB_SPIN_CAP) { atomicAdd(&bar[XB_TMO], 1u); break; } }
    }
    nloc = mine > 0u ? mine : 1u; nx = cnt > 0u ? cnt : 1u;
}
__device__ __forceinline__ void xcd_barrier(const XcdBarrier& b_in) {
    XcdBarrier b; b.st = b_in.st; b.bar = xb_bar_ptr(); b.x = (unsigned)__builtin_amdgcn_readfirstlane((int)xb_xcc_id());
    asm volatile("s_waitcnt vmcnt(0)" ::: "memory");
    __syncthreads();
    if (threadIdx.x == 0) {
        unsigned* bar = b.bar;
        __builtin_amdgcn_s_waitcnt(0);
        unsigned nloc = b.st[0], nx = b.st[1];
        if (nloc == 0u) { xcd_barrier_complete(bar, b.x, nloc, nx); b.st[0] = nloc; b.st[1] = nx; }
        const unsigned old = xb_add(&bar[XB_XSUB(b.x)], 1u);
        const unsigned gen = old / nloc;
        if (old + 1u == (gen + 1u) * nloc) {
            __builtin_amdgcn_fence(__ATOMIC_RELEASE, "agent");
            asm volatile("s_waitcnt vmcnt(0)" ::: "memory");
            const unsigned og = xb_add(&bar[XB_TOP], 1u);
            const unsigned tg = og / nx;
            if (og + 1u == (tg + 1u) * nx) xb_add(&bar[XB_TOPGEN], 1u);
            else XB_SPIN(xb_ld(&bar[XB_TOPGEN]) == tg, bar);
            __builtin_amdgcn_fence(__ATOMIC_ACQUIRE, "agent");
            xb_add(&bar[XB_XGEN(b.x)], 1u);
            asm volatile("s_waitcnt vmcnt(0)" ::: "memory");
        } else {
            XB_SPIN(xb_ld(&bar[XB_XGEN(b.x)]) == gen, bar);
            __builtin_amdgcn_fence(__ATOMIC_ACQUIRE, "agent");
            asm volatile("s_waitcnt vmcnt(0)" ::: "memory");
        }
    }
    __syncthreads();
}

struct Args {
    const float *x, *c, *ctx, *c_ctx, *w_mod, *b_mod, *ffn1_norm, *ffn1_gate, *ffn1_up, *ffn1_down, *mix_norm, *w_in, *w_out, *pool_w, *pool_scale,
                *q_norm, *k_norm, *fnet_w, *na_rpb, *ffn2_norm, *ffn2_gate, *ffn2_up, *ffn2_down, *final_norm;
    float* out; unsigned char* ws;
};
struct Ctx {
    LAS unsigned char* lds; int wave, wg, G;
};
__device__ __forceinline__ Ctx fresh_ctx(const Ctx& C) { Ctx L = C; asm volatile("" : "+s"(L.wave), "+s"(L.wg), "+s"(L.G)); return L; }
__device__ __forceinline__ int fresh_tid() { int t = threadIdx.x; asm volatile("" : "+v"(t)); return t; }
typedef const Args __attribute__((address_space(4))) * ArgsP;
__device__ __forceinline__ ArgsP fresh_args() { ArgsP p = (ArgsP)__builtin_amdgcn_kernarg_segment_ptr(); asm volatile("" : "+s"(p)); return p; }
struct EpiResid {
    static constexpr bool PERM = false;
    int gate_off;
    float coef;
    int flags;
    __device__ __forceinline__ void operator()(const pg8::f32x4 (&acc)[2][2][4][2], const pg8::Unit& u, int wr, int wc, int fr, int fq) const {
        ArgsP a_ = fresh_args(); unsigned char* ws_ = a_->ws;
        const float* base_f32 = (flags & 1) ? a_->x : nullptr; h16* XS = (h16*)(ws_ + WS_XS); const float* gate = (const float*)(ws_ + WS_MODV) + gate_off;
        h16* slab = (flags & 2) ? (h16*)(ws_ + WS_SLAB) : nullptr;
        const int s = slab ? 4 : (u.pm >> 4);
        int fr_ = fr, fq_ = fq; asm volatile("" : "+v"(fr_), "+v"(fq_));
        const int r0 = wr * 64 + fr_, col0 = u.pn * 256 + wc * 32 + 4 * fq_;
        f32x4 gv[2][2];
        { const float* gp = gate + (size_t)s * NMOD + col0;
          const f32x4 g00 = *(const f32x4*)(gp), g01 = *(const f32x4*)(gp + 16), g10 = *(const f32x4*)(gp + 128), g11 = *(const f32x4*)(gp + 144);
          gv[0][0] = g00; gv[0][1] = g01; gv[1][0] = g10; gv[1][1] = g11; }
#define GV_SCALE() do { _Pragma("unroll") for (int bj = 0; bj < 2; ++bj) _Pragma("unroll") for (int n = 0; n < 2; ++n) gv[bj][n] = gv[bj][n] * coef; } while (0)
        if (slab) {
            GV_SCALE();
            h16* op = slab + ((size_t)(u.pm >> 2) * TC + (size_t)(u.pm & 3) * 256) * DM;
#pragma unroll
            for (int ai = 0; ai < 2; ++ai)
#pragma unroll
                for (int m = 0; m < 4; ++m) { const size_t off = (size_t)(r0 + ai * 128 + m * 16) * DM + col0;
#pragma unroll
                    for (int bj = 0; bj < 2; ++bj)
#pragma unroll
                        for (int n = 0; n < 2; ++n) st_h4(op + off + bj * 128 + n * 16, gv[bj][n] * acc[ai][bj][m][n]); }
        } else {
            h16* op = XS + (size_t)u.pm * 256 * DM;
#define RESID_BATCH(LOADEXPR) _Pragma("unroll") for (int ai = 0; ai < 2; ++ai) _Pragma("unroll") for (int mp = 0; mp < 2; ++mp) { \
                f32x4 b000, b001, b010, b011, b100, b101, b110, b111; \
                { const size_t off = (size_t)(r0 + ai * 128 + (2 * mp) * 16) * DM + col0; b000 = LOADEXPR(off); b001 = LOADEXPR(off + 16); b010 = LOADEXPR(off + 128); b011 = LOADEXPR(off + 144); } \
                { const size_t off = (size_t)(r0 + ai * 128 + (2 * mp + 1) * 16) * DM + col0; b100 = LOADEXPR(off); b101 = LOADEXPR(off + 16); b110 = LOADEXPR(off + 128); b111 = LOADEXPR(off + 144); } \
                asm volatile("" ::: "memory"); \
                { const size_t off = (size_t)(r0 + ai * 128 + (2 * mp) * 16) * DM + col0; \
                  st_h4(op + off, b000 + gv[0][0] * acc[ai][0][2 * mp][0]); st_h4(op + off + 16, b001 + gv[0][1] * acc[ai][0][2 * mp][1]); \
                  st_h4(op + off + 128, b010 + gv[1][0] * acc[ai][1][2 * mp][0]); st_h4(op + off + 144, b011 + gv[1][1] * acc[ai][1][2 * mp][1]); } \
                { const size_t off = (size_t)(r0 + ai * 128 + (2 * mp + 1) * 16) * DM + col0; \
                  st_h4(op + off, b100 + gv[0][0] * acc[ai][0][2 * mp + 1][0]); st_h4(op + off + 16, b101 + gv[0][1] * acc[ai][0][2 * mp + 1][1]); \
                  st_h4(op + off + 128, b110 + gv[1][0] * acc[ai][1][2 * mp + 1][0]); st_h4(op + off + 144, b111 + gv[1][1] * acc[ai][1][2 * mp + 1][1]); } \
                asm volatile("" ::: "memory"); }
            if (base_f32) { const float* bp = base_f32 + (size_t)u.pm * 256 * DM; GV_SCALE();
#define LD32(o) (*(const f32x4*)(bp + (o)))
                RESID_BATCH(LD32)
#undef LD32
            } else {
                const __amdgpu_buffer_rsrc_t rx = __builtin_amdgcn_make_buffer_rsrc((void*)op, 0, 256 * DM * 2, 0x00020000);
                const unsigned vo = (unsigned)(r0 * DM + col0) * 2u;
#define ROFF(AI, M, BJ, N) ((((AI) * 128 + (M) * 16) * DM + (BJ) * 128 + (N) * 16) * 2)
                v2u raw[2][4][2][2];
#pragma unroll
                for (int ai = 0; ai < 2; ++ai)
#pragma unroll
                    for (int m = 0; m < 4; ++m)
#pragma unroll
                        for (int bj = 0; bj < 2; ++bj)
#pragma unroll
                            for (int n = 0; n < 2; ++n) raw[ai][m][bj][n] = __builtin_amdgcn_raw_buffer_load_b64(rx, vo, ROFF(ai, m, bj, n), 0);
                asm volatile("" ::: "memory");
                { float cf = coef; asm volatile("" : "+v"(cf));
#pragma unroll
                  for (int bj = 0; bj < 2; ++bj)
#pragma unroll
                      for (int n = 0; n < 2; ++n) gv[bj][n] = gv[bj][n] * cf; }
#pragma unroll
                for (int ai = 0; ai < 2; ++ai)
#pragma unroll
                    for (int m = 0; m < 4; ++m)
#pragma unroll
                        for (int bj = 0; bj < 2; ++bj)
#pragma unroll
                            for (int n = 0; n < 2; ++n) { const f32x4 v_ = __builtin_convertvector(__builtin_bit_cast(h4, raw[ai][m][bj][n]), f32x4) + gv[bj][n] * acc[ai][bj][m][n];
                                __builtin_amdgcn_raw_buffer_store_b64(__builtin_bit_cast(v2u, __builtin_convertvector(v_, h4)), rx, vo, ROFF(ai, m, bj, n), 0); }
#undef ROFF
            }
#undef RESID_BATCH
#undef GV_SCALE
        }
    }
};
template <int CTRL> __device__ __forceinline__ float dpp_f(float v) { return __builtin_bit_cast(float, __builtin_amdgcn_update_dpp(0, __builtin_bit_cast(int, v), CTRL, 0xf, 0xf, false)); }
__device__ __forceinline__ float row16_sum(float v) {
    v += dpp_f<0xB1>(v); v += dpp_f<0x4E>(v); v += dpp_f<0x141>(v); v += dpp_f<0x140>(v); return v;
}
__device__ __forceinline__ unsigned* xb_bar_ptr() { return (unsigned*)(fresh_args()->ws + WS_CTL) + CW_BAR; }
__device__ __forceinline__ float row16_sum_bp(float v, int lane) {
#pragma unroll
    for (int m = 1; m < 16; m <<= 1) v += __builtin_bit_cast(float, __builtin_amdgcn_ds_bpermute((lane ^ m) << 2, __builtin_bit_cast(int, v)));
    return v;
}
__device__ __forceinline__ float wave_sum(float v) {
    v = row16_sum(v);
    const float r0 = __builtin_bit_cast(float, __builtin_amdgcn_readlane(__builtin_bit_cast(int, v), 0)), r1 = __builtin_bit_cast(float, __builtin_amdgcn_readlane(__builtin_bit_cast(int, v), 16));
    const float r2 = __builtin_bit_cast(float, __builtin_amdgcn_readlane(__builtin_bit_cast(int, v), 32)), r3 = __builtin_bit_cast(float, __builtin_amdgcn_readlane(__builtin_bit_cast(int, v), 48));
    return (r0 + r1) + (r2 + r3);
}

struct EpiSwiglu {
    static constexpr bool PERM = true;
    bf16* GU;
    __device__ __forceinline__ void operator()(const pg8::f32x4 (&acc)[2][2][4][2], const pg8::Unit& u, int wr, int wc, int fr, int fq) const {
        const int row0 = u.pm * 256 + wr * 64 + fr, col0 = u.pn * 128 + wc * 32 + 8 * fq;
#pragma unroll
        for (int ai = 0; ai < 2; ++ai)
#pragma unroll
            for (int m = 0; m < 4; ++m) {
                unsigned wv[4];
#pragma unroll
                for (int q = 0; q < 4; ++q) { const int n = q >> 1, j = (q & 1) * 2;
                    const f32x2 g = {acc[ai][0][m][n][j], acc[ai][0][m][n][j + 1]}, up = {acc[ai][1][m][n][j], acc[ai][1][m][n][j + 1]};
                    const f32x2 t = g * -1.4426950408889634f, gu = g * up;
                    f32x2 d = {__builtin_amdgcn_exp2f(t.x), __builtin_amdgcn_exp2f(t.y)}; d = d + 1.0f;
                    const f32x2 rr = {__builtin_amdgcn_rcpf(d.x), __builtin_amdgcn_rcpf(d.y)}, o = gu * rr;
                    unsigned pk; asm("v_cvt_pk_bf16_f32 %0, %1, %2" : "=v"(pk) : "v"(o.x), "v"(o.y)); wv[q] = pk; }
                v4u w; w.x = wv[0]; w.y = wv[1]; w.z = wv[2]; w.w = wv[3];
                *(v4u*)(GU + (size_t)(row0 + ai * 128 + m * 16) * FFP + col0) = w; }
    }
};
struct EpiZ {
    static constexpr bool PERM = true;
    bf16* Z; bf16* ABT; bf16* ABTC;
    __device__ __forceinline__ void operator()(const pg8::f32x4 (&acc)[2][2][4][2], const pg8::Unit& u, int wr, int wc, int fr, int fq) const {
        bf16* base; size_t ld;
        if (u.pn < 12) { base = Z + (size_t)u.pm * 256 * ZW + u.pn * 256; ld = ZW; }
        else { const int cc = (u.pn - 12) * 256, trig = cc >> 9, c0 = cc & 511;
            if (u.pm < 64) { const int b = u.pm >> 4, n0 = (u.pm & 15) * 256; base = ABT + (size_t)c0 * LDT + b * (2 * SEQ) + trig * SEQ + n0; ld = LDT; }
            else { const int b = u.pm - 64; base = ABTC + (size_t)c0 * LDTC + b * (2 * CTXL) + trig * CTXL; ld = LDTC; } }
        const int r0 = wr * 64 + fr, col0 = wc * 32 + 8 * fq;
#pragma unroll
        for (int ai = 0; ai < 2; ++ai)
#pragma unroll
            for (int m = 0; m < 4; ++m) { bf16* rowp = base + (size_t)(r0 + ai * 128 + m * 16) * ld + col0;
#pragma unroll
                for (int bj = 0; bj < 2; ++bj) { const pg8::f32x4 v0 = acc[ai][bj][m][0], v1 = acc[ai][bj][m][1];
                    v4u w; w.x = pg8::cvt_pk_bf16(v0[0], v0[1]); w.y = pg8::cvt_pk_bf16(v0[2], v0[3]); w.z = pg8::cvt_pk_bf16(v1[0], v1[1]); w.w = pg8::cvt_pk_bf16(v1[2], v1[3]);
                    *(v4u*)(rowp + bj * 128) = w; } }
    }
};
struct ProbPlain { const char* A; const char* B; size_t ta, tb;
    __device__ __forceinline__ const char* a_panel(const pg8::Unit& u) const { return A + (size_t)u.pm * ta; }
    __device__ __forceinline__ const char* b_panel(const pg8::Unit& u) const { return B + (size_t)u.pn * tb; } };
struct ProbSplit { const char* A; const char* B; size_t ta, tb; int pmask, kshift; size_t kbytes;
    __device__ __forceinline__ const char* a_panel(const pg8::Unit& u) const { return A + (size_t)(u.pm & pmask) * ta + (size_t)(u.pm >> kshift) * kbytes; }
    __device__ __forceinline__ const char* b_panel(const pg8::Unit& u) const { return B + (size_t)u.pn * tb + (size_t)(u.pm >> kshift) * kbytes; } };
struct ProbInFt { const char* H; const char* W;
    __device__ __forceinline__ const char* a_panel(const pg8::Unit& u) const { return u.pn < 12 ? H + (size_t)u.pm * (256 * DM * 2) : W + (size_t)u.pn * (256 * DM * 2); }
    __device__ __forceinline__ const char* b_panel(const pg8::Unit& u) const { return u.pn < 12 ? W + (size_t)u.pn * (256 * DM * 2) : H + (size_t)u.pm * (256 * DM * 2); } };
struct ProbDft { const char* A; const char* B; int bshift, bmask; size_t bbatch, bsub, bpanel;
    __device__ __forceinline__ const char* a_panel(const pg8::Unit& u) const { return A; }
    __device__ __forceinline__ const char* b_panel(const pg8::Unit& u) const { return B + (size_t)(u.pm >> bshift) * bbatch + (size_t)(u.pm & bmask) * bsub + (size_t)u.pn * bpanel; } };
struct EpiDft {
    static constexpr bool PERM = true;
    bf16* O; int ldc, row0, rshift, rmask, rbatch, rstride;
    __device__ __forceinline__ void operator()(const pg8::f32x4 (&acc)[2][2][4][2], const pg8::Unit& u, int wr, int wc, int fr, int fq) const {
        const int rb = row0 + (u.pm >> rshift) * rbatch + (u.pm & rmask);
        bf16* base = O + u.pn * 256 + wc * 32 + 8 * fq;
        const int r0 = wr * 64 + fr;
#pragma unroll
        for (int ai = 0; ai < 2; ++ai)
#pragma unroll
            for (int m = 0; m < 4; ++m) { bf16* rowp = base + (size_t)(rb + rstride * (r0 + ai * 128 + m * 16)) * ldc;
#pragma unroll
                for (int bj = 0; bj < 2; ++bj) { const pg8::f32x4 v0 = acc[ai][bj][m][0], v1 = acc[ai][bj][m][1];
                    v4u w; w.x = pg8::cvt_pk_bf16(v0[0], v0[1]); w.y = pg8::cvt_pk_bf16(v0[2], v0[3]); w.z = pg8::cvt_pk_bf16(v1[0], v1[1]); w.w = pg8::cvt_pk_bf16(v1[2], v1[3]);
                    *(v4u*)(rowp + bj * 128) = w; } }
    }
};

__device__ __forceinline__ void transpose_tile(const float* W, int ldw, int k0, int n0, bf16* WT, int ldt, int drow0, LAS float* scr, int lane) {
    const int lr = lane >> 4, lc = (lane & 15) * 4;
    f32x4 v[16];
#pragma unroll
    for (int i = 0; i < 16; ++i) v[i] = __builtin_nontemporal_load((const f32x4*)(W + (size_t)(k0 + 4 * i + lr) * ldw + n0 + lc));
#pragma unroll
    for (int i = 0; i < 16; ++i) { LAS float* d = scr + (4 * i + lr) * 65 + lc; d[0] = v[i].x; d[1] = v[i].y; d[2] = v[i].z; d[3] = v[i].w; }
    LDS_WAIT(); asm volatile("" ::: "memory");
    const int c = lane & 7;
#pragma unroll
    for (int j = 0; j < 8; ++j) { const int n = (lane >> 3) + 8 * j; const LAS float* s = scr + (8 * c) * 65 + n;
        v4u o; o.x = pk2(s[0 * 65], s[1 * 65]); o.y = pk2(s[2 * 65], s[3 * 65]); o.z = pk2(s[4 * 65], s[5 * 65]); o.w = pk2(s[6 * 65], s[7 * 65]);
        *(GAS v4u*)(WT + (size_t)(drow0 + n) * ldt + k0 + 8 * c) = o; }
    LDS_WAIT(); asm volatile("" ::: "memory");
}
constexpr int CV_GU = (DM / 64) * (FF / 512), CV_D = (FF / 64) * (DM / 512), CV_IN = (DM / 64) * 5, CV_OUT = (DM / 64) * (DM / 512);
constexpr int CONV_PER_LAYER = 4 * CV_GU + 2 * CV_D + CV_IN + CV_OUT;
constexpr int CI_GU1 = 0, CI_GU2 = 2 * CV_GU, CI_D1 = 4 * CV_GU, CI_D2 = CI_D1 + CV_D, CI_IN = CI_D2 + CV_D, CI_OUT = CI_IN + CV_IN;
__device__ __forceinline__ void conv_item(const Ctx& C, ArgsP a, int l, int r) {
    const int lane = fresh_tid() & 63;
    unsigned char* wl = a->ws + WS_W + (size_t)l * W_LAYER;
    LAS float* scr = (LAS float*)(C.lds + C.wave * CONV_SCR);
    const float* W; int ldw, kb, nb, ldt; bf16* WT; int mode;
    if (r < 4 * CV_GU) { const int which = r / CV_GU; r %= CV_GU;
        W = ((which == 0) ? a->ffn1_gate : (which == 1) ? a->ffn1_up : (which == 2) ? a->ffn2_gate : a->ffn2_up) + (size_t)l * DM * FF;
        ldw = FF; kb = r / (FF / 512); nb = r % (FF / 512); WT = (bf16*)(wl + ((which < 2) ? WO_GU1 : WO_GU2)); ldt = DM; mode = which & 1; }
    else if ((r -= 4 * CV_GU) < 2 * CV_D) { const int which = r / CV_D; r %= CV_D;
        W = (which ? a->ffn2_down : a->ffn1_down) + (size_t)l * FF * DM; ldw = DM; kb = r / (DM / 512); nb = r % (DM / 512); WT = (bf16*)(wl + (which ? WO_D2 : WO_D1)); ldt = FFP; mode = 2; }
    else if ((r -= 2 * CV_D) < CV_IN) { W = a->w_in + (size_t)l * DM * IN_DIM; ldw = IN_DIM; kb = r / 5; nb = r % 5; WT = (bf16*)(wl + WO_IN); ldt = DM; mode = 3; }
    else { r -= CV_IN; W = a->w_out + (size_t)l * DM * DM; ldw = DM; kb = r / (DM / 512); nb = r % (DM / 512); WT = (bf16*)(wl + WO_OUT); ldt = DM; mode = 2; }
    int n0 = nb * 512 + C.wave * 64, drow0;
    if (mode == 3) { n0 = (nb < 2 ? 512 + nb * 512 : 2048 + (nb - 2) * 512) + C.wave * 64; drow0 = n0 < 2048 ? n0 : n0 - 512; }
    else if (mode == 2) drow0 = n0;
    else drow0 = (n0 >> 7) * 256 + mode * 128 + (n0 & 127);
    transpose_tile(W, ldw, kb * 64, n0, WT, ldt, drow0, scr, lane);
}
constexpr int CW_DYN = 12288;
__device__ __forceinline__ unsigned* dyn_heads(ArgsP a, int k) { return (unsigned*)(a->ws + WS_CTL) + CW_DYN + 1024 * k; }
__device__ __forceinline__ void fold_item(const Ctx& C, ArgsP a, int it) {
    const int khalf = it & 1, dblk = (it >> 1) & 3, g = (it >> 3) & 3, kind = (it >> 5) % 3, l = it / 96;
    LAS float* Mb = (LAS float*)C.lds;
    LAS float* Wl = (LAS float*)(C.lds + 16384);
    LAS float* tab = (LAS float*)(C.lds + 16384 + 64 * 129 * 4);
    const int tid = fresh_tid(), d0 = dblk * 32;
    __syncthreads();
    if (tid < 128) tab[tid] = cospif((float)tid * (1.0f / 64.0f));
    __syncthreads();
    if (kind == 0) {
        const float* pw = a->pool_w + ((size_t)(l * 4 + g) * 128) * 128; const float* ps = a->pool_scale + (size_t)l * 512 + g * 128;
        { float pv[8]; const float psv = ps[d0 + (tid & 31)];
#pragma unroll
          for (int u = 0; u < 8; ++u) { const int i = tid + u * NTHR; pv[u] = pw[(i >> 5) * 128 + d0 + (i & 31)]; }
          asm volatile("" ::: "memory");
#pragma unroll
          for (int u = 0; u < 8; ++u) Mb[tid + u * NTHR] = pv[u] * psv; }
    } else {
        const float* fw = a->fnet_w + ((size_t)(l * 4 + g) * 128) * 128;
        LAS float* Fl = (LAS float*)(C.lds + 65536);
#pragma unroll
        for (int j = 0; j < 2; ++j) { const int i = tid + j * NTHR, e = i >> 3, q = (i & 7) * 4; *(LAS f32x4*)(Fl + e * 32 + q) = *(const f32x4*)(fw + e * 128 + d0 + q); }
        __syncthreads();
        const int c = tid >> 2, dq = (tid & 3) * 8, sh = (kind == 2) ? 96 : 0;
        float acc[8];
#pragma unroll
        for (int j = 0; j < 8; ++j) acc[j] = 0.f;
#pragma unroll 8
        for (int e = 0; e < 128; ++e) { const float t = tab[(c * e + sh) & 127]; const f32x4 w0 = *(const LAS f32x4*)(Fl + e * 32 + dq), w1 = *(const LAS f32x4*)(Fl + e * 32 + dq + 4);
#pragma unroll
            for (int j = 0; j < 4; ++j) { acc[j] += t * w0[j]; acc[4 + j] += t * w1[j]; } }
#pragma unroll
        for (int j = 0; j < 8; ++j) Mb[c * 32 + dq + j] = acc[j];
    }
    __syncthreads();
    const int colbase = (kind == 0 ? 0 : 1536) + g * 128, rowbase = (kind == 0 ? 0 : (kind == 1 ? 3072 : 3584)) + g * 128 + d0;
    const float* Wi = a->w_in + (size_t)l * DM * IN_DIM;
    bf16* WT = (bf16*)(a->ws + WS_W + (size_t)l * W_LAYER + WO_IN);
    { typedef float f32x16v __attribute__((ext_vector_type(16)));
      const int lane = tid & 63, n = lane & 31, hf = lane >> 5;
      float am[64];
#pragma unroll
      for (int j = 0; j < 64; ++j) am[j] = Mb[(hf * 64 + j) * 32 + n];
      const int kw = khalf * 1024 + C.wave * 128;
      f32x4 w[16];
#pragma unroll
      for (int t = 0; t < 4; ++t) {
#pragma unroll
          for (int q = 0; q < 16; ++q) w[q] = *(const f32x4*)(Wi + (size_t)(kw + t * 32 + n) * IN_DIM + colbase + hf * 64 + 4 * q);
          asm volatile("" ::: "memory");
          f32x16v acc = {0.f, 0.f, 0.f, 0.f, 0.f, 0.f, 0.f, 0.f, 0.f, 0.f, 0.f, 0.f, 0.f, 0.f, 0.f, 0.f};
#pragma unroll
          for (int j = 0; j < 64; ++j) acc = __builtin_amdgcn_mfma_f32_32x32x2f32(am[j], w[j >> 2][j & 3], acc, 0, 0, 0);
          bf16* op = WT + (size_t)rowbase * DM + kw + t * 32 + n;
#pragma unroll
          for (int r = 0; r < 16; ++r) op[(size_t)((r & 3) + 8 * (r >> 2) + 4 * hf) * DM] = (bf16)f2bf(acc[r]);
          asm volatile("" ::: "memory");
      }
    }
    __syncthreads();
}
__device__ __forceinline__ void mod_item(const Ctx& C, ArgsP a, int it) {
    const int tid = fresh_tid(), lane = tid & 63;
    const int l = it / 144, ch = it % 144;
    LAS float* sc = (LAS float*)C.lds;
    LAS float* red = (LAS float*)(C.lds + 5 * 2048 * 4);
    __syncthreads();
    { float vv[5 * DM / NTHR];
#pragma unroll
      for (int u = 0; u < 5 * DM / NTHR; ++u) { const int i = tid + u * NTHR, s = i / DM, k = i % DM; vv[u] = s < 4 ? a->c[s * DM + k] : a->c_ctx[k]; }
      asm volatile("" ::: "memory");
#pragma unroll
      for (int u = 0; u < 5 * DM / NTHR; ++u) { const float v = vv[u]; sc[tid + u * NTHR] = v / (1.0f + __expf(-v)); } }
    __syncthreads();
    const float* wm = a->w_mod + (size_t)l * DM * NMOD + ch * 128 + 2 * lane;
    float acc[5][2];
#pragma unroll
    for (int s = 0; s < 5; ++s) { acc[s][0] = 0.f; acc[s][1] = 0.f; }
    const int kbeg = C.wave * 256;
    for (int k = kbeg; k < kbeg + 256; k += 16) {
        f32x2 w[16];
#pragma unroll
        for (int j = 0; j < 16; ++j) w[j] = __builtin_nontemporal_load((const f32x2*)(wm + (size_t)(k + j) * NMOD));
#pragma unroll
        for (int s = 0; s < 5; ++s)
#pragma unroll
            for (int q = 0; q < 4; ++q) { const f32x4 sv = *(const LAS f32x4*)(sc + s * DM + k + 4 * q);
#pragma unroll
                for (int j = 0; j < 4; ++j) { acc[s][0] += sv[j] * w[4 * q + j].x; acc[s][1] += sv[j] * w[4 * q + j].y; } }
    }
#pragma unroll
    for (int s = 0; s < 5; ++s) { red[(C.wave * 5 + s) * 128 + 2 * lane] = acc[s][0]; red[(C.wave * 5 + s) * 128 + 2 * lane + 1] = acc[s][1]; }
    __syncthreads();
    float* mv = (float*)(a->ws + WS_MODV) + (size_t)l * 5 * NMOD;
    for (int i = tid; i < 5 * 128; i += NTHR) { const int s = i >> 7, col = i & 127; float v = 0.f;
#pragma unroll
        for (int w = 0; w < 8; ++w) v += red[(w * 5 + s) * 128 + col];
        mv[(size_t)s * NMOD + ch * 128 + col] = v + a->b_mod[(size_t)l * NMOD + ch * 128 + col]; }
    __syncthreads();
}
__device__ __forceinline__ void gen_item(const Ctx& C, ArgsP a, int it) {
    const int tid = fresh_tid();
    bf16* M = (bf16*)(a->ws + WS_DFTC); const float sc = 0.00552427173f;
    for (int i = tid; i < 256 * 512; i += NTHR) { const int k = i >> 9, kk = i & 511, n = kk & 255; const int ph = (k * n) & 255; const float x = (float)ph * (1.0f / 128.0f);
        M[i] = (bf16)f2bf(kk >= 256 ? -sinpif(x) * sc : cospif(x) * sc); }
    float* R = (float*)(a->ws + WS_ROPE);
    for (int i = tid; i < 64 * 32; i += NTHR) { const int p = i >> 5, j = i & 31; const float inv = exp2f(-(float)j * (13.287712379549449f / 32.0f));
        const float ang = (float)p * inv; R[2 * i] = cosf(ang); R[2 * i + 1] = sinf(ang); }
}
struct TSeg { int type, l, first, count; };
__device__ __forceinline__ void run_item(const Ctx& C, ArgsP a, const TSeg& s, int i) {
    if (s.type == 0) conv_item(C, a, s.l, s.first + i);
    else if (s.type == 1) mod_item(C, a, s.first + i);
    else fold_item(C, a, s.first + i);
}
__device__ __forceinline__ void tail_items(const Ctx& C, unsigned* head, const TSeg s0, const TSeg s1) {
    ArgsP a = fresh_args();
    volatile LAS unsigned* slot = (volatile LAS unsigned*)(C.lds + MISC_OFF) + 24;
    for (;;) {
        __syncthreads();
        if (threadIdx.x == 0) *slot = __hip_atomic_fetch_add(head, 1u, __ATOMIC_RELAXED, __HIP_MEMORY_SCOPE_AGENT);
        __syncthreads();
        const int i = (int)*slot;
        if (i >= s0.count + s1.count) break;
        if (i < s0.count) run_item(C, a, s0, i); else run_item(C, a, s1, i - s0.count);
    }
}
constexpr int CW_P0Q = 8192;
__device__ __forceinline__ void prologue_phase(const Ctx& C, ArgsP a) {
    if (C.wg == C.G - 1) gen_item(C, a, 0);
    tail_items(C, (unsigned*)(a->ws + WS_CTL) + CW_P0Q, TSeg{1, 0, 0, 48}, TSeg{0, 0, CI_GU1, 2 * CV_GU});
}

__device__ __forceinline__ void norm_row(const float* src32, const h16* src16, const h16* slabrow, h16* xo, bf16* o, const f32x4 (&A)[8], const f32x4 (&Bv)[8], int lane) {
    f32x4 v[8]; float ss = 0.f;
    if (src32) {
#pragma unroll
        for (int j = 0; j < 8; ++j) v[j] = *(const f32x4*)(src32 + 4 * lane + 256 * j);
    } else {
#pragma unroll
        for (int j = 0; j < 8; ++j) v[j] = ld_h4(src16 + 4 * lane + 256 * j);
    }
    if (slabrow != nullptr) {
        v2u sl[4][8];
#pragma unroll
        for (int ks = 0; ks < 4; ++ks)
#pragma unroll
            for (int j = 0; j < 8; ++j) sl[ks][j] = *(const v2u*)(slabrow + (size_t)ks * TC * DM + 4 * lane + 256 * j);
        asm volatile("" ::: "memory");
#pragma unroll
        for (int ks = 0; ks < 4; ++ks)
#pragma unroll
            for (int j = 0; j < 8; ++j) v[j] += __builtin_convertvector(__builtin_bit_cast(h4, sl[ks][j]), f32x4);
#pragma unroll
        for (int j = 0; j < 8; ++j) { st_h4(xo + 4 * lane + 256 * j, v[j]); v[j] = ld_h4_reg(v[j]); }
    }
#pragma unroll
    for (int j = 0; j < 8; ++j) ss += (v[j].x * v[j].x + v[j].y * v[j].y) + (v[j].z * v[j].z + v[j].w * v[j].w);
    const float rs = 1.0f / sqrtf(wave_sum(ss) * (1.0f / DM) + EPS);
#pragma unroll
    for (int j = 0; j < 8; ++j) { const f32x4 y = v[j] * rs * A[j] + Bv[j]; v2u w; w.x = pk2(y.x, y.y); w.y = pk2(y.z, y.w); *(v2u*)(o + 4 * lane + 256 * j) = w; }
}
template <int NR>
__device__ __forceinline__ void norm_rows_h(__amdgpu_buffer_rsrc_t rx, __amdgpu_buffer_rsrc_t rh, int row0, int rstep, const f32x4 (&A)[8], const f32x4 (&Bv)[8], int lane) {
    f32x4 v[NR][8];
#pragma unroll
    for (int r = 0; r < NR; ++r) { const unsigned off = (unsigned)(row0 + r * rstep) * (DM * 2) + lane * 8;
#pragma unroll
        for (int j = 0; j < 8; ++j) { const v2u w = __builtin_amdgcn_raw_buffer_load_b64(rx, off + 512 * j, 0, 0); v[r][j] = __builtin_convertvector(__builtin_bit_cast(h4, w), f32x4); } }
#pragma unroll
    for (int r = 0; r < NR; ++r) { float ss = 0.f;
#pragma unroll
        for (int j = 0; j < 8; ++j) ss += (v[r][j].x * v[r][j].x + v[r][j].y * v[r][j].y) + (v[r][j].z * v[r][j].z + v[r][j].w * v[r][j].w);
        const float rs = 1.0f / sqrtf(wave_sum(ss) * (1.0f / DM) + EPS); const unsigned off = (unsigned)(row0 + r * rstep) * (DM * 2) + lane * 8;
#pragma unroll
        for (int j = 0; j < 8; ++j) { const f32x4 y = v[r][j] * rs * A[j] + Bv[j]; v2u w; w.x = pk2(y.x, y.y); w.y = pk2(y.z, y.w); __builtin_amdgcn_raw_buffer_store_b64(w, rh, off + 512 * j, 0, 0); } }
}
__device__ __forceinline__ void norm_phase(const Ctx& C, const float* sx32, const float* scx32, h16* XS, const float* gain, const float* modl, int ish, int isc, int nrows, bf16* H, const h16* slab) {
    const int lane = fresh_tid() & 63;
    int G = C.G; asm volatile("" : "+s"(G));
    const int ng = TX / 8; int g0 = (int)((unsigned)(ng * C.wg) / (unsigned)G), g1 = (int)((unsigned)(ng * (C.wg + 1)) / (unsigned)G);
    if (nrows > TX && ng == 8 * G && 2 * (TC / 8) == G) { if (C.wg < TC / 8) { g0 = 7 * C.wg; g1 = g0 + 7; } else { g0 = 7 * (TC / 8) + 9 * (C.wg - TC / 8); g1 = g0 + 9; } }
    int cur = -1; f32x4 A[8], Bv[8];
#define NORM_COEF(s_) do { if ((s_) != cur) { cur = (s_); _Pragma("unroll") for (int j = 0; j < 8; ++j) { const int col = 4 * lane + 256 * j; \
        const f32x4 gn = *(const f32x4*)(gain + col), scv = *(const f32x4*)(modl + (size_t)cur * NMOD + isc * DM + col); \
        A[j] = gn * (scv + 1.0f); Bv[j] = *(const f32x4*)(modl + (size_t)cur * NMOD + ish * DM + col); } } } while (0)
    int g = g0;
    if (!sx32) {
        const __amdgpu_buffer_rsrc_t rx = __builtin_amdgcn_make_buffer_rsrc((void*)XS, 0, TX * DM * 2, 0x00020000), rh = __builtin_amdgcn_make_buffer_rsrc((void*)H, 0, TX * DM * 2, 0x00020000);
        for (; g + 3 < g1 && ((g * 8) >> 12) == (((g + 3) * 8 + 7) >> 12); g += 4) { NORM_COEF((g * 8) >> 12); norm_rows_h<4>(rx, rh, g * 8 + C.wave, 8, A, Bv, lane); }
        for (; g + 1 < g1 && ((g * 8) >> 12) == (((g + 1) * 8 + 7) >> 12); g += 2) { NORM_COEF((g * 8) >> 12); norm_rows_h<2>(rx, rh, g * 8 + C.wave, 8, A, Bv, lane); }
    }
    for (; g < g1; ++g) {
        const int row = g * 8 + C.wave; NORM_COEF(row >> 12);
        norm_row(sx32 ? sx32 + (size_t)row * DM : nullptr, XS + (size_t)row * DM, nullptr, nullptr, H + (size_t)row * DM, A, Bv, lane);
    }
    if (nrows > TX) {
        for (int r = C.wg * NWAVES + C.wave; r < TC; r += G * NWAVES) { NORM_COEF(4);
            norm_row(scx32 ? scx32 + (size_t)r * DM : nullptr, XS + (size_t)(TX + r) * DM, slab ? slab + (size_t)r * DM : nullptr, XS + (size_t)(TX + r) * DM, H + (size_t)(TX + r) * DM, A, Bv, lane); }
    }
#undef NORM_COEF
}
__device__ __forceinline__ void final_phase(const Ctx& C, const h16* XS, const float* gain, float* out) {
    const int lane = fresh_tid() & 63;
    const int gw = C.wg * NWAVES + C.wave, NGW = C.G * NWAVES;
    f32x4 A[8];
#pragma unroll
    for (int j = 0; j < 8; ++j) A[j] = *(const f32x4*)(gain + 4 * lane + 256 * j);
    const __amdgpu_buffer_rsrc_t rx = __builtin_amdgcn_make_buffer_rsrc((void*)XS, 0, TX * DM * 2, 0x00020000), ro = __builtin_amdgcn_make_buffer_rsrc((void*)out, 0, TX * DM * 4, 0x00020000);
    for (int row = gw; row < TX; row += 2 * NGW) {
        const bool two = row + NGW < TX; f32x4 v[2][8];
#pragma unroll
        for (int r = 0; r < 2; ++r) if (r == 0 || two) { const unsigned off = (unsigned)(row + r * NGW) * (DM * 2) + lane * 8;
#pragma unroll
            for (int j = 0; j < 8; ++j) { const v2u w = __builtin_amdgcn_raw_buffer_load_b64(rx, off + 512 * j, 0, 0); v[r][j] = __builtin_convertvector(__builtin_bit_cast(h4, w), f32x4); } }
#pragma unroll
        for (int r = 0; r < 2; ++r) if (r == 0 || two) { float ss = 0.f;
#pragma unroll
            for (int j = 0; j < 8; ++j) ss += (v[r][j].x * v[r][j].x + v[r][j].y * v[r][j].y) + (v[r][j].z * v[r][j].z + v[r][j].w * v[r][j].w);
            const float rs = 1.0f / sqrtf(wave_sum(ss) * (1.0f / DM) + EPS); const unsigned off = (unsigned)(row + r * NGW) * (DM * 4) + lane * 16;
#pragma unroll
            for (int j = 0; j < 4; ++j) { __builtin_amdgcn_raw_buffer_store_b128(__builtin_bit_cast(v4u, v[r][j] * rs * A[j]), ro, off + 1024 * j, 0, 0);
                __builtin_amdgcn_raw_buffer_store_b128(__builtin_bit_cast(v4u, v[r][j + 4] * rs * A[j + 4]), ro, off + 4096 + 1024 * j, 0, 0); } }
    }
}

__device__ __forceinline__ void prep_phase(const Ctx& C, bf16* Z, bf16* CC, const float* qn, const float* kn, const float* rope) {
    const int gw = C.wg * NWAVES + C.wave, NGW = C.G * NWAVES, lane = fresh_tid() & 63, l16 = lane & 15, hq = lane >> 4;
    const bool has1 = hq < 2;
    for (int row = gw; row < T; row += NGW) {
        const bool isx = row < TX; const int t = isx ? (row & (SEQ - 1)) : ((row - TX) & (CTXL - 1)), seqlen = isx ? SEQ : CTXL, seq0 = row - t;
        bf16* zr = Z + (size_t)row * ZW;
        bf16* p0 = zr + ZGQ + hq * 128 + l16 * 8; bf16* p1 = p0 + 512;
        const v4u w0 = *(const v4u*)p0; v4u w1 = (v4u){0u, 0u, 0u, 0u}; if (has1) w1 = *(const v4u*)p1;
        f32x2 cs[4];
#pragma unroll
        for (int jj = 0; jj < 4; ++jj) { const int i = l16 * 4 + jj, pos = isx ? (i < 32 ? (t >> 6) : (t & 63)) : 0;
            cs[jj] = *(const f32x2*)(rope + (pos * 32 + (i & 31)) * 2); }
        const int half = 1 << hq; const int lo = (t - half) > 0 ? (t - half) : 0, hi = (t + half - 1) < (seqlen - 1) ? (t + half - 1) : (seqlen - 1);
        v4u wv[16];
#pragma unroll
        for (int d = 0; d < 16; ++d) { const int tt = t + d - 8; const bool ok = tt >= lo && tt <= hi; wv[d] = *(const v4u*)(Z + (size_t)(seq0 + (ok ? tt : t)) * ZW + ZP + lane * 8); }
        const float* gq = qn + l16 * 8; const float* gk = kn + l16 * 8;
        f32x4 g0a = *(const f32x4*)gq, g0b = *(const f32x4*)(gq + 4), g1a = *(const f32x4*)gk, g1b = *(const f32x4*)(gk + 4);
        asm volatile("" ::: "memory");
#pragma unroll
        for (int jj = 0; jj < 4; ++jj) { cs[jj].x = isx ? cs[jj].x : 1.f; cs[jj].y = isx ? cs[jj].y : 0.f; }
#pragma unroll
        for (int p = 0; p < 2; ++p) {
            if (p == 0 || has1) { const v4u w = p ? w1 : w0; const f32x4 ga = p ? g1a : g0a, gb = p ? g1b : g0b;
                float x[8] = {bflo(w.x), bfhi(w.x), bflo(w.y), bfhi(w.y), bflo(w.z), bfhi(w.z), bflo(w.w), bfhi(w.w)};
                float ss = 0.f;
#pragma unroll
                for (int j = 0; j < 8; ++j) ss += x[j] * x[j];
                ss = row16_sum(ss);
                const float rs = 1.0f / sqrtf(ss * (1.0f / 128.0f) + EPS);
#pragma unroll
                for (int j = 0; j < 4; ++j) { x[j] = x[j] * rs * ga[j]; x[4 + j] = x[4 + j] * rs * gb[j]; }
#pragma unroll
                for (int jj = 0; jj < 4; ++jj) { const float x1 = x[2 * jj], x2 = x[2 * jj + 1]; x[2 * jj] = x1 * cs[jj].x - x2 * cs[jj].y; x[2 * jj + 1] = x1 * cs[jj].y + x2 * cs[jj].x; }
                v4u o; o.x = pk2(x[0], x[1]); o.y = pk2(x[2], x[3]); o.z = pk2(x[4], x[5]); o.w = pk2(x[6], x[7]); *(v4u*)(p ? p1 : p0) = o; } }
        { float sm[8] = {0.f, 0.f, 0.f, 0.f, 0.f, 0.f, 0.f, 0.f};
#pragma unroll
            for (int d = 0; d < 16; ++d) { const int tt = t + d - 8; const float m = (tt >= lo && tt <= hi) ? 1.0f : 0.0f; const v4u w = wv[d];
                sm[0] += m * bflo(w.x); sm[1] += m * bfhi(w.x); sm[2] += m * bflo(w.y); sm[3] += m * bfhi(w.y); sm[4] += m * bflo(w.z); sm[5] += m * bfhi(w.z); sm[6] += m * bflo(w.w); sm[7] += m * bfhi(w.w); }
            const v4u w = wv[8]; const float inv = 1.0f / (float)(hi - lo + 1);
            const float u[8] = {bflo(w.x), bfhi(w.x), bflo(w.y), bfhi(w.y), bflo(w.z), bfhi(w.z), bflo(w.w), bfhi(w.w)};
            v4u o; o.x = pk2(sm[0] * inv - u[0], sm[1] * inv - u[1]); o.y = pk2(sm[2] * inv - u[2], sm[3] * inv - u[3]); o.z = pk2(sm[4] * inv - u[4], sm[5] * inv - u[5]); o.w = pk2(sm[6] * inv - u[6], sm[7] * inv - u[7]);
            *(v4u*)(CC + (size_t)row * DM + lane * 8) = o; }
    }
}

namespace fa {
using bf16x8 = __attribute__((ext_vector_type(8))) short;
using s16x4  = __attribute__((ext_vector_type(4))) short;
using f32x16 = __attribute__((ext_vector_type(16))) float;
using u32x4  = __attribute__((ext_vector_type(4))) unsigned;
constexpr int D = 128, NW = 8, QBLK = 32, KVBLK = 64;
constexpr float SCALE = 0.088388347648318440f, THR = 8.f;
constexpr int SHM_V = KVBLK * D * 2, SHM_K = KVBLK * D * 2, SHM_ATTN = 2 * SHM_V + 2 * SHM_K + NW * 64 * 4;
constexpr int TAB_OFF = 68 * 1024, TAB_ORG = 512, TAB_N = 2048;
constexpr float NEGBIG = -1e30f;
#define KSWZ(row, colB) ((row) * 256 + ((colB) ^ (((row) & 7) << 4)))
#define SBAR() __builtin_amdgcn_sched_barrier(0)
__device__ __forceinline__ int crow(int r, int hi) { return (r & 3) + 8 * (r >> 2) + 4 * hi; }
__device__ __forceinline__ unsigned cvtpk(float lo, float hi) { unsigned r; asm volatile("v_cvt_pk_bf16_f32 %0, %1, %2" : "=v"(r) : "v"(lo), "v"(hi)); return r; }
__device__ __forceinline__ void partialSM(f32x16& p0, f32x16& p1, float& m_reg, float& mn, float& alpha) {
  constexpr float C = SCALE * 1.4426950408889634f;
  float pmax = p0[0];
#pragma unroll
  for (int r = 1; r < 16; ++r) pmax = fmaxf(pmax, p0[r]);
#pragma unroll
  for (int r = 0; r < 16; ++r) pmax = fmaxf(pmax, p1[r]);
  { auto rr = __builtin_amdgcn_permlane32_swap(__float_as_uint(pmax), __float_as_uint(pmax), false, false);
    pmax = fmaxf(__uint_as_float(rr[0]), __uint_as_float(rr[1])); }
  if (__builtin_expect(__all(pmax - m_reg <= THR / SCALE), 1)) { mn = m_reg; alpha = 1.f; }
  else { mn = fmaxf(m_reg, pmax); alpha = __builtin_amdgcn_exp2f((m_reg - mn) * C); m_reg = mn; }
  float mnC = -mn * C;
#pragma unroll
  for (int r = 0; r < 16; ++r) p0[r] = fmaf(p0[r], C, mnC);
#pragma unroll
  for (int r = 0; r < 16; ++r) p1[r] = fmaf(p1[r], C, mnC);
#pragma unroll
  for (int r = 0; r < 16; ++r) p0[r] = __builtin_amdgcn_exp2f(p0[r]);
}
__device__ __forceinline__ void finishSM(f32x16& p0, f32x16& p1, float alpha, float& l_reg, bf16x8& pa0, bf16x8& pa1, bf16x8& pa2, bf16x8& pa3) {
#pragma unroll
  for (int r = 0; r < 16; ++r) p1[r] = __builtin_amdgcn_exp2f(p1[r]);
  float ps = 0;
#pragma unroll
  for (int r = 0; r < 16; ++r) ps += p0[r];
#pragma unroll
  for (int r = 0; r < 16; ++r) ps += p1[r];
  { auto rr = __builtin_amdgcn_permlane32_swap(__float_as_uint(ps), __float_as_uint(ps), false, false);
    ps = __uint_as_float(rr[0]) + __uint_as_float(rr[1]); }
  l_reg = l_reg * alpha + ps;
#define PK4(P, BASE, OUT) do { unsigned a0 = cvtpk(P[BASE + 0], P[BASE + 1]), a1 = cvtpk(P[BASE + 2], P[BASE + 3]);   \
    unsigned b0 = cvtpk(P[BASE + 4], P[BASE + 5]), b1 = cvtpk(P[BASE + 6], P[BASE + 7]);                              \
    auto r0 = __builtin_amdgcn_permlane32_swap(a0, b0, false, false); auto r1 = __builtin_amdgcn_permlane32_swap(a1, b1, false, false); \
    u32x4 w = {r0[0], r1[0], r0[1], r1[1]}; OUT = *reinterpret_cast<bf16x8*>(&w); } while (0)
  PK4(p0, 0, pa0); PK4(p0, 8, pa1); PK4(p1, 0, pa2); PK4(p1, 8, pa3);
#undef PK4
}
__device__ __forceinline__ void qkt(f32x16& p0, f32x16& p1, const char* Ks, const bf16x8* qr, int r32, int hi) {
  p0 = f32x16{}; p1 = f32x16{};
#pragma unroll
  for (int d0 = 0; d0 < 8; ++d0) { int cb = (d0 * 16 + hi * 8) * 2;
    bf16x8 b0 = *reinterpret_cast<const bf16x8*>(Ks + KSWZ(r32, cb));
    bf16x8 b1 = *reinterpret_cast<const bf16x8*>(Ks + KSWZ(32 + r32, cb));
    p0 = __builtin_amdgcn_mfma_f32_32x32x16_bf16(b0, qr[d0], p0, 0, 0, 0);
    p1 = __builtin_amdgcn_mfma_f32_32x32x16_bf16(b1, qr[d0], p1, 0, 0, 0); }
}
__device__ __forceinline__ int v_st(int k, int c) { const int kk = (k & ~0xC) | ((k & 4) << 1) | ((k & 8) >> 1); return ((kk >> 3) * 4 + (c >> 5)) * 512 + ((kk & 7) * 32 + (c & 31)) * 2; }
__device__ __forceinline__ int v_rd_base(int lane) { return ((lane & 3) << 3) | (((lane >> 2) & 3) << 6) | (((lane >> 4) & 1) << 5) | (((lane >> 5) & 1) << 8); }
constexpr int v_rd_off(int d0, int ks, int half) { return d0 * 512 + ks * 4096 + half * 2048; }
template <int OFF> __device__ __forceinline__ s16x4 tr_read(int vb) {
  s16x4 r; asm volatile("ds_read_b64_tr_b16 %0, %1 offset:%2" : "=&v"(r) : "v"(vb), "i"(OFF) : "memory"); return r;
}
template <int D0> __device__ __forceinline__ void pv_one(f32x16& od, int vb, bf16x8 pa0, bf16x8 pa1, bf16x8 pa2, bf16x8 pa3) {
  const s16x4 l0 = tr_read<v_rd_off(D0, 0, 0)>(vb), h0 = tr_read<v_rd_off(D0, 0, 1)>(vb), l1 = tr_read<v_rd_off(D0, 1, 0)>(vb), h1 = tr_read<v_rd_off(D0, 1, 1)>(vb);
  const s16x4 l2 = tr_read<v_rd_off(D0, 2, 0)>(vb), h2 = tr_read<v_rd_off(D0, 2, 1)>(vb), l3 = tr_read<v_rd_off(D0, 3, 0)>(vb), h3 = tr_read<v_rd_off(D0, 3, 1)>(vb);
  asm volatile("s_waitcnt lgkmcnt(0)" ::: "memory"); SBAR();
#define PK(L, H) (bf16x8){L[0], L[1], L[2], L[3], H[0], H[1], H[2], H[3]}
  od = __builtin_amdgcn_mfma_f32_32x32x16_bf16(pa0, PK(l0, h0), od, 0, 0, 0);
  od = __builtin_amdgcn_mfma_f32_32x32x16_bf16(pa1, PK(l1, h1), od, 0, 0, 0);
  od = __builtin_amdgcn_mfma_f32_32x32x16_bf16(pa2, PK(l2, h2), od, 0, 0, 0);
  od = __builtin_amdgcn_mfma_f32_32x32x16_bf16(pa3, PK(l3, h3), od, 0, 0, 0);
#undef PK
}
__device__ __forceinline__ void pv_d0(f32x16* o, int vb, bf16x8 pa0, bf16x8 pa1, bf16x8 pa2, bf16x8 pa3) {
  pv_one<0>(o[0], vb, pa0, pa1, pa2, pa3); pv_one<1>(o[1], vb, pa0, pa1, pa2, pa3); pv_one<2>(o[2], vb, pa0, pa1, pa2, pa3); pv_one<3>(o[3], vb, pa0, pa1, pa2, pa3);
}
struct TileDense { int lat0, nlat, ctx0;
  __device__ __forceinline__ void operator()(int j, int& base, int& hoff) const { base = j < nlat ? lat0 + 64 * j : ctx0 + 64 * (j - nlat); hoff = 32; } };
struct TileNa { int ctx0, loc0;
  __device__ __forceinline__ void operator()(int j, int& base, int& hoff) const { if (j < 4) { base = ctx0 + 64 * j; hoff = 32; } else { base = loc0 + (j - 4) * 128; hoff = 64; } } };
__device__ __forceinline__ void na_bias(f32x16& p0, f32x16& p1, int krow, int kc0, int qr, int qc, int rs, int cs, const float* tab, int hi) {
  const bool rv0 = (unsigned)(krow - rs) < 8u, rv1 = (unsigned)(krow + 1 - rs) < 8u;
  const int cb = kc0 + 4 * hi - cs, ib = (krow - qr + 7) * 31 + (kc0 + 4 * hi - qc + 15);
  const float* t0 = tab + ib;
#pragma unroll
  for (int r = 0; r < 16; ++r) { const int co = (r & 3) + 8 * (r >> 2); const bool cv = (unsigned)(cb + co) < 16u;
    const float b0 = t0[co], b1 = t0[31 + co];
    p0[r] = (rv0 && cv) ? p0[r] + b0 : NEGBIG; p1[r] = (rv1 && cv) ? p1[r] + b1 : NEGBIG; }
}
template <bool NA, class TileF, int SD>
__device__ __forceinline__ void attn_unit(const bf16* __restrict__ Z, bf16* __restrict__ CC, int qcol, int kcol, int vcol, int outcol, int NT, const TileF& TF,
                                          int q0, int nb, int R0, int C0, int kr0, int kc0, char* lds) {
  const int tid = fresh_tid(), wid = tid >> 6, lane = tid & 63, r32 = lane & 31, hi = lane >> 5;
  char* V_lds = lds; char* K_lds = lds + 2 * SHM_V;
  float* ws = (float*)(lds + 2 * SHM_V + 2 * SHM_K) + wid * 64; float* li_l = ws; float* al_l = ws + 32;
  const float* tab = (const float*)(lds + TAB_OFF) + TAB_ORG;
  float m_reg = -1e30f, l_reg = 0; f32x16 o[4] = {}; bf16x8 qr[8];
  const int qg_r = R0 + 2 * wid + (r32 >> 4), qg_c = C0 + (r32 & 15);
  const int myrow = NA ? nb * SEQ + qg_r * 64 + qg_c : q0 + wid * 32 + r32;
  { const bf16* Qw = Z + (size_t)myrow * ZW + qcol + hi * 8;
#pragma unroll
    for (int d0 = 0; d0 < 8; ++d0) qr[d0] = *reinterpret_cast<const bf16x8*>(Qw + d0 * 16); }
  const int sr = tid >> 4, sc = (tid & 15) * 8, vst0 = v_st(sr, sc), vst1 = v_st(32 + sr, sc);
  const int vb0 = (int)(uintptr_t)V_lds + v_rd_base(lane);
  struct { bf16x8 vs0, vs1, ks0, ks1; } sr_[SD];
#define SLOAD(i, j) do { int _b, _h; TF((j), _b, _h); const bf16* _p0 = Z + (size_t)(_b + sr) * ZW + sc; const bf16* _p1 = Z + (size_t)(_b + _h + sr) * ZW + sc; \
    sr_[i].vs0 = *reinterpret_cast<const bf16x8*>(_p0 + vcol); sr_[i].vs1 = *reinterpret_cast<const bf16x8*>(_p1 + vcol); \
    sr_[i].ks0 = *reinterpret_cast<const bf16x8*>(_p0 + kcol); sr_[i].ks1 = *reinterpret_cast<const bf16x8*>(_p1 + kcol); } while (0)
#define SWRITE(b, i) do { *(bf16x8*)(V_lds + (b) * SHM_V + vst0) = sr_[i].vs0; *(bf16x8*)(V_lds + (b) * SHM_V + vst1) = sr_[i].vs1; int kc = sc * 2; \
    *(bf16x8*)(K_lds + (b) * SHM_K + KSWZ(sr, kc)) = sr_[i].ks0; *(bf16x8*)(K_lds + (b) * SHM_K + KSWZ(32 + sr, kc)) = sr_[i].ks1; } while (0)
#define SWAIT() do { if constexpr (SD == 2) asm volatile("s_waitcnt vmcnt(4)" ::: "memory"); else asm volatile("s_waitcnt vmcnt(0)" ::: "memory"); } while (0)
#define RESC(a) do { if (__any((a) < 1.f)) { if (hi == 0) al_l[r32] = (a); asm volatile("s_waitcnt lgkmcnt(0)" ::: "memory"); \
    _Pragma("unroll") for (int d = 0; d < 4; ++d) _Pragma("unroll") for (int r = 0; r < 16; ++r) o[d][r] *= al_l[crow(r, hi)]; } } while (0)
#define BIAS(P0, P1, j) do { if (NA) { if ((j) >= 4) { const int t_ = fresh_tid(), qr_ = R0 + 2 * (t_ >> 6) + ((t_ & 31) >> 4), qc_ = C0 + (t_ & 15); \
    int rs_ = qr_ - 4; rs_ = rs_ < 0 ? 0 : (rs_ > 56 ? 56 : rs_); int cs_ = qc_ - 8; cs_ = cs_ < 0 ? 0 : (cs_ > 48 ? 48 : cs_); \
    na_bias(P0, P1, kr0 + 2 * ((j) - 4), kc0, qr_, qc_, rs_, cs_, tab, (t_ >> 5) & 1); } } } while (0)
  f32x16 pA0, pA1, pB0, pB1; float mnA, mnB, alA = 1.f, alB = 1.f; bf16x8 pa0, pa1, pa2, pa3;
  const int wq_ = R0 + 2 * __builtin_amdgcn_readfirstlane(tid >> 6);
  const int rsl_ = (wq_ - 4) < 0 ? 0 : ((wq_ - 4) > 56 ? 56 : (wq_ - 4)), rsh_ = ((wq_ - 3) < 0 ? 0 : ((wq_ - 3) > 56 ? 56 : (wq_ - 3))) + 7;
#define ACT(j) (!NA || (j) < 4 || ((kr0 + 2 * ((j) - 4) + 1 >= rsl_) && (kr0 + 2 * ((j) - 4) <= rsh_)))
  constexpr int SE = 0, SO = SD - 1;
  SLOAD(SE, 0); asm volatile("s_waitcnt vmcnt(0)" ::: "memory"); SWRITE(0, SE); __syncthreads();
  qkt(pA0, pA1, K_lds, qr, r32, hi); BIAS(pA0, pA1, 0); partialSM(pA0, pA1, m_reg, mnA, alA);
  SLOAD(SO, 1); if constexpr (SD == 2) { if (2 < NT) SLOAD(SE, 2); }
  SWAIT(); SWRITE(1, SO); __syncthreads();
  bool aA = true, aB;
  for (int j = 1; j + 1 < NT; j += 2) {
    aB = ACT(j);
    SBAR(); if (aB) { qkt(pB0, pB1, K_lds + SHM_K, qr, r32, hi); BIAS(pB0, pB1, j); }
    if (aA) finishSM(pA0, pA1, alA, l_reg, pa0, pa1, pa2, pa3); SBAR();
    SLOAD(SO, j + SD); SBAR();
    if (aA) pv_d0(o, vb0, pa0, pa1, pa2, pa3); if (aB) partialSM(pB0, pB1, m_reg, mnB, alB);
    __syncthreads(); SWAIT(); SWRITE(0, SE);
    if (aB) RESC(alB); __syncthreads();
    aA = ACT(j + 1);
    SBAR(); if (aA) { qkt(pA0, pA1, K_lds, qr, r32, hi); BIAS(pA0, pA1, j + 1); }
    if (aB) finishSM(pB0, pB1, alB, l_reg, pa0, pa1, pa2, pa3); SBAR();
    if (SD == 1 || j + 3 < NT) SLOAD(SE, j + 1 + SD); SBAR();
    if (aB) pv_d0(o, vb0 + SHM_V, pa0, pa1, pa2, pa3); if (aA) partialSM(pA0, pA1, m_reg, mnA, alA);
    __syncthreads(); SWAIT(); SWRITE(1, SO);
    if (aA) RESC(alA); __syncthreads();
  }
  aB = ACT(NT - 1);
  SBAR(); if (aB) { qkt(pB0, pB1, K_lds + SHM_K, qr, r32, hi); BIAS(pB0, pB1, NT - 1); }
  if (aA) finishSM(pA0, pA1, alA, l_reg, pa0, pa1, pa2, pa3); SBAR();
  if (aA) pv_d0(o, vb0, pa0, pa1, pa2, pa3); if (aB) partialSM(pB0, pB1, m_reg, mnB, alB);
  __syncthreads(); if (aB) RESC(alB);
  if (aB) { finishSM(pB0, pB1, alB, l_reg, pa0, pa1, pa2, pa3); SBAR();
    pv_d0(o, vb0 + SHM_V, pa0, pa1, pa2, pa3); }
#undef ACT
  if (hi == 0) li_l[r32] = l_reg; asm volatile("s_waitcnt lgkmcnt(0)" ::: "memory");
  float rli[16];
#pragma unroll
  for (int r = 0; r < 16; ++r) rli[r] = __builtin_amdgcn_rcpf(li_l[crow(r, hi)]);
  __syncthreads();
  char* stg = lds + wid * 8192;
#pragma unroll
  for (int r = 0; r < 16; ++r) { const int orow = crow(r, hi);
#pragma unroll
    for (int d0 = 0; d0 < 4; ++d0) *(unsigned short*)(stg + orow * 256 + (d0 * 32 + r32) * 2) = (unsigned short)f2bf(o[d0][r] * rli[r]); }
  asm volatile("s_waitcnt lgkmcnt(0)" ::: "memory");
#pragma unroll
  for (int i = 0; i < 8; ++i) { const int row = (lane >> 4) + 4 * i, ch = lane & 15; const v4u w = *(const v4u*)(stg + row * 256 + ch * 16);
    const int orow = NA ? nb * SEQ + (R0 + 2 * wid + (row >> 4)) * 64 + C0 + (row & 15) : q0 + wid * 32 + row;
    *(v4u*)(CC + (size_t)orow * DM + outcol + ch * 8) = w; }
  __syncthreads();
#undef SLOAD
#undef SWRITE
#undef SWAIT
#undef RESC
#undef BIAS
}
}

__device__ __forceinline__ void dense_attn_units(const Ctx& C, const bf16* Z, bf16* CC, bool with_ctx, char* lds) {
    for (int k = C.wg; k < 256 + 32 * C.G; k += C.G) {
        int u;
        if (k < 256) u = k;
        else { const int v = (k - 256) / C.G; if (!with_ctx || v >= 32) break; if ((144 + v) % C.G != C.wg) continue; u = 256 + v; }
        int b, qcol, kcol, vcol, outcol, NT, q0; fa::TileDense TF;
        if (u < 256) { const int bk = u & 7, idx = u >> 3, kvh = bk & 1, hq = 2 * kvh + (idx >> 4); b = bk >> 1;
            qcol = ZGQ + hq * 128; kcol = ZGK + kvh * 128; vcol = ZGV + kvh * 128; outcol = 512 + hq * 128; NT = 68; q0 = b * SEQ + (idx & 15) * 256; TF = fa::TileDense{b * SEQ, 64, TX + b * CTXL}; }
        else if (u < 272) { const int v = u - 256, hq = v & 3; b = v >> 2;
            qcol = ZGQ + hq * 128; kcol = ZGK + (hq >> 1) * 128; vcol = ZGV + (hq >> 1) * 128; outcol = 512 + hq * 128; NT = 4; q0 = TX + b * CTXL; TF = fa::TileDense{0, 0, TX + b * CTXL}; }
        else { const int v = u - 272, h = v & 3; b = v >> 2;
            qcol = ZNQ + h * 128; kcol = ZNK + h * 128; vcol = ZNV + h * 128; outcol = 1536 + h * 128; NT = 4; q0 = TX + b * CTXL; TF = fa::TileDense{0, 0, TX + b * CTXL}; }
        fa::attn_unit<false, fa::TileDense, 2>(Z, CC, qcol, kcol, vcol, outcol, NT, TF, q0, 0, 0, 0, 0, 0, lds);
    }
}
__device__ __forceinline__ void na_units(const Ctx& C, const bf16* Z, bf16* CC, const float* rpb_l, char* lds) {
    float* tabz = (float*)(lds + fa::TAB_OFF);
    for (int u = C.wg; u < 256; u += C.G) {
        const int patch = u & 15, bh = u >> 4, h = bh & 3, b = bh >> 2, R0 = (patch >> 2) * 16, C0 = (patch & 3) * 16;
        int kr0 = R0 - 4; kr0 = kr0 < 0 ? 0 : (kr0 > 40 ? 40 : kr0); int kc0 = C0 - 8; kc0 = kc0 < 0 ? 0 : (kc0 > 32 ? 32 : kc0);
        { const int tid = fresh_tid();
            float tv[fa::TAB_N / NTHR];
#pragma unroll
            for (int j = 0; j < fa::TAB_N / NTHR; ++j) { const int k = tid + j * NTHR - fa::TAB_ORG; const int kc = k < 0 ? 0 : (k > 15 * 31 - 1 ? 15 * 31 - 1 : k); tv[j] = rpb_l[h * (15 * 31) + kc]; }
            asm volatile("" ::: "memory");
#pragma unroll
            for (int j = 0; j < fa::TAB_N / NTHR; ++j) { const int k = tid + j * NTHR - fa::TAB_ORG; tabz[tid + j * NTHR] = (k >= 0 && k < 15 * 31) ? tv[j] * (1.0f / fa::SCALE) : 0.f; } }
        __syncthreads();
        fa::TileNa TF{TX + b * CTXL, b * SEQ + kr0 * 64 + kc0};
        fa::attn_unit<true, fa::TileNa, 1>(Z, CC, ZNQ + h * 128, ZNK + h * 128, ZNV + h * 128, 1536 + h * 128, 16, TF, 0, b, R0, C0, kr0, kc0, lds);
    }
}

__device__ __forceinline__ void ph_gu(const Ctx& C0_, int step) {
    const Ctx C = fresh_ctx(C0_);
    ArgsP a = fresh_args(); unsigned char* ws = a->ws; const int l = step >> 1, second = step & 1; const bool last = (l == NL - 1);
    const unsigned char* wl = ws + WS_W + (size_t)l * W_LAYER;
    pg8::Dims g{DM, DM, DM}; pg8::DynOrder S; S.so.init((second && last) ? TX : T, NGU, C.G, C.wg); S.nstat = S.so.nwg / C.G - 1; S.ncls = 0; S.heads = dyn_heads(a, step); S.slot = (volatile LAS unsigned*)(C.lds + MISC_OFF) + 26;
    ProbPlain P{(const char*)(ws + WS_H), (const char*)(wl + (second ? WO_GU2 : WO_GU1)), (size_t)256 * DM * 2, (size_t)256 * DM * 2}; EpiSwiglu E{(bf16*)(ws + WS_GU)};
    pg8::gemm_phase<EpiSwiglu, pg8::DynOrder, ProbPlain>(C.lds, g, P, S, E);
    if (step < 3) tail_items(C, dyn_heads(a, step) + 512, TSeg{1, 0, step == 0 ? 48 : (step == 1 ? 144 : 192), step == 1 ? 48 : 32}, TSeg{0, step == 0 ? 0 : 1, step == 1 ? CI_GU1 : CI_D1, step == 1 ? CV_GU : CV_D});
}
__device__ __forceinline__ void resid_gemm(const Ctx& C, int kq, const char* A, const char* B, int K, int ld, bool base_in, int gate_off, float coef, bool with_ctx) {
    for (int pass = 0; pass < (with_ctx ? 2 : 1); ++pass) {
        pg8::Dims g{pass ? K / 4 : K, ld, ld}; pg8::DynOrder S; S.so.init(pass ? 16 * 256 : TX, DM, C.G, C.wg); S.nstat = pass ? 0 : 1; S.ncls = pass ? 0 : 1; S.heads = dyn_heads(fresh_args(), kq) + (pass ? 32 : 0);
        S.slot = (volatile LAS unsigned*)(C.lds + MISC_OFF) + 26;
        ProbSplit P{pass ? A + (size_t)TX * ld * 2 : A, B, (size_t)256 * ld * 2, (size_t)256 * ld * 2, pass ? 3 : 0xFFFF, pass ? 2 : 16, (size_t)(K / 4) * 2};
        EpiResid E{gate_off, coef, (base_in ? 1 : 0) | (pass ? 2 : 0)};
        pg8::gemm_phase<EpiResid, pg8::DynOrder, ProbSplit>(C.lds, g, P, S, E);
    }
}
__device__ __forceinline__ void ph_inft(const Ctx& C0_, int l) {
    const Ctx C = fresh_ctx(C0_);
    ArgsP a = fresh_args(); unsigned char* ws = a->ws; const unsigned char* wl = ws + WS_W + (size_t)l * W_LAYER;
    pg8::Dims g{DM, DM, DM}; pg8::DynOrder S; S.so.init(T, NIN, C.G, C.wg); S.nstat = S.so.nwg / C.G - 1; S.ncls = 0; S.heads = dyn_heads(a, 8 + l); S.slot = (volatile LAS unsigned*)(C.lds + MISC_OFF) + 26;
    ProbInFt P{(const char*)(ws + WS_H), (const char*)(wl + WO_IN)}; EpiZ E{(bf16*)(ws + WS_Z), (bf16*)(ws + WS_ABT), (bf16*)(ws + WS_ABTC)};
    pg8::gemm_phase<EpiZ, pg8::DynOrder, ProbInFt>(C.lds, g, P, S, E);
    if (l == 0) tail_items(C, dyn_heads(a, 8 + l) + 512, TSeg{1, 0, 80, 64}, TSeg{0, 0, CI_GU2, 2 * CV_GU});
    else tail_items(C, dyn_heads(a, 8 + l) + 512, TSeg{0, 1, CI_GU2, 2 * CV_GU}, TSeg{0, 1, CI_D2, CV_D});
}
struct cpx { float r, i; };
__device__ __forceinline__ cpx cadd(cpx a, cpx b) { return cpx{a.r + b.r, a.i + b.i}; }
__device__ __forceinline__ cpx csub(cpx a, cpx b) { return cpx{a.r - b.r, a.i - b.i}; }
__device__ __forceinline__ cpx cmul(cpx a, cpx w) { return cpx{a.r * w.r - a.i * w.i, a.r * w.i + a.i * w.r}; }
__device__ __forceinline__ void dft4(cpx x0, cpx x1, cpx x2, cpx x3, cpx& y0, cpx& y1, cpx& y2, cpx& y3) {
    const cpx t0 = cadd(x0, x2), t1 = csub(x0, x2), t2 = cadd(x1, x3), t3 = csub(x1, x3);
    y0 = cadd(t0, t2); y2 = csub(t0, t2); y1 = cpx{t1.r + t3.i, t1.i - t3.r}; y3 = cpx{t1.r - t3.i, t1.i + t3.r};
}
__device__ __forceinline__ constexpr float cos16(int m) {
    return m == 0 ? 1.f : m == 1 ? 0.92387953251128674f : m == 2 ? 0.70710678118654752f : m == 3 ? 0.38268343236508977f : m == 4 ? 0.f : m == 5 ? -0.38268343236508977f : m == 6 ? -0.70710678118654752f :
           m == 7 ? -0.92387953251128674f : m == 8 ? -1.f : m == 9 ? -0.92387953251128674f : m == 10 ? -0.70710678118654752f : m == 11 ? -0.38268343236508977f : m == 12 ? 0.f : m == 13 ? 0.38268343236508977f :
           m == 14 ? 0.70710678118654752f : 0.92387953251128674f;
}
__device__ __forceinline__ void fft16(const cpx (&z)[16], int n2, float (&oP)[16], float (&oQ)[16]) {
    cpx V[4][4];
#pragma unroll
    for (int bb = 0; bb < 4; ++bb) { dft4(z[bb], z[4 + bb], z[8 + bb], z[12 + bb], V[bb][0], V[bb][1], V[bb][2], V[bb][3]);
#pragma unroll
        for (int cc = 1; cc < 4; ++cc) if (bb) V[bb][cc] = cmul(V[bb][cc], cpx{cos16((bb * cc) & 15), -cos16((bb * cc + 12) & 15)}); }
    cpx Y[16];
#pragma unroll
    for (int cc = 0; cc < 4; ++cc) dft4(V[0][cc], V[1][cc], V[2][cc], V[3][cc], Y[cc], Y[cc + 4], Y[cc + 8], Y[cc + 12]);
    float s1, c1; sincospif((float)n2 * (1.0f / 2048.0f), &s1, &c1);
    const cpx t1{c1, -s1}; cpx tk{0.25f, 0.f};
#pragma unroll
    for (int k1 = 0; k1 < 16; ++k1) { const cpx y = cmul(Y[k1], tk); oP[k1] = y.r; oQ[k1] = -y.i; tk = cmul(tk, t1); }
}
__device__ __forceinline__ void fft_stage1(const Ctx& C, bf16* ABT) {
    const int tid = fresh_tid();
    for (int it = C.wg * NTHR + tid; it < 512 * NB * 128; it += C.G * NTHR) {
        const int n2 = (it & 127) * 2, b = (it >> 7) & 3, c = it >> 9;
        bf16* base = ABT + (size_t)c * LDT + b * (2 * SEQ) + n2;
        unsigned rp[16], rq[16];
#pragma unroll
        for (int n1 = 0; n1 < 16; ++n1) { rp[n1] = *(const unsigned*)(base + 256 * n1); rq[n1] = *(const unsigned*)(base + SEQ + 256 * n1); }
        asm volatile("" ::: "memory");
        cpx z[16]; float aP[16], aQ[16], bP[16], bQ[16];
#pragma unroll
        for (int n1 = 0; n1 < 16; ++n1) { z[n1].r = bflo(rp[n1]); z[n1].i = -bflo(rq[n1]); }
        fft16(z, n2, aP, aQ);
#pragma unroll
        for (int n1 = 0; n1 < 16; ++n1) { z[n1].r = bfhi(rp[n1]); z[n1].i = -bfhi(rq[n1]); }
        fft16(z, n2 + 1, bP, bQ);
#pragma unroll
        for (int k1 = 0; k1 < 16; ++k1) { *(unsigned*)(base + 512 * k1) = pk2(aP[k1], bP[k1]); *(unsigned*)(base + 512 * k1 + 256) = pk2(aQ[k1], bQ[k1]); }
    }
}
__device__ __forceinline__ void ph_prep(const Ctx& C0_, int l) {
    const Ctx C = fresh_ctx(C0_);
    ArgsP a = fresh_args(); unsigned char* ws = a->ws;
    prep_phase(C, (bf16*)(ws + WS_Z), (bf16*)(ws + WS_CC), a->q_norm + (size_t)l * 128, a->k_norm + (size_t)l * 128, (const float*)(ws + WS_ROPE));
}
__device__ __forceinline__ void ph_prep_fft(const Ctx& C0_, int l) {
    const Ctx C = fresh_ctx(C0_);
    ArgsP a = fresh_args(); unsigned char* ws = a->ws;
    fft_stage1(C, (bf16*)(ws + WS_ABT));
}
__device__ __forceinline__ void ph_dft(const Ctx& C0_, int l) {
    const Ctx C = fresh_ctx(C0_);
    ArgsP a = fresh_args(); unsigned char* ws = a->ws; const bool last = (l == NL - 1);
    bf16* CC = (bf16*)(ws + WS_CC);
    for (int pass = 0; pass < (last ? 1 : 2); ++pass) {
        pg8::Dims g{2 * CTXL, 2 * CTXL, pass ? LDTC : LDT};
        pg8::StaticOrder S; S.init(pass ? TC : 64 * 256, 512, C.G, pass ? (C.wg + C.G - 136 % C.G) % C.G : C.wg);
        ProbDft P = pass ? ProbDft{(const char*)(ws + WS_DFTC), (const char*)(ws + WS_ABTC), 0, 0, (size_t)2 * CTXL * 2, 0, (size_t)256 * LDTC * 2}
                         : ProbDft{(const char*)(ws + WS_DFTC), (const char*)(ws + WS_ABT), 4, 15, (size_t)2 * SEQ * 2, (size_t)512 * 2, (size_t)256 * LDT * 2};
        EpiDft E = pass ? EpiDft{CC + 1024, DM, TX, 0, 0, CTXL, 1} : EpiDft{CC + 1024, DM, 0, 4, 15, SEQ, 16};
        pg8::gemm_phase<EpiDft, pg8::StaticOrder, ProbDft>(C.lds, g, P, S, E);
    }
}
__device__ __forceinline__ void ph_attn(const Ctx& C0_, int l, char* lds) {
    const Ctx C = fresh_ctx(C0_);
    ArgsP a = fresh_args(); unsigned char* ws = a->ws; const bool last = (l == NL - 1);
    dense_attn_units(C, (const bf16*)(ws + WS_Z), (bf16*)(ws + WS_CC), !last, lds);
}
__device__ __forceinline__ void ph_na(const Ctx& C0_, int l, char* lds) {
    const Ctx C = fresh_ctx(C0_);
    ArgsP a = fresh_args(); unsigned char* ws = a->ws;
    na_units(C, (const bf16*)(ws + WS_Z), (bf16*)(ws + WS_CC), a->na_rpb + (size_t)l * 4 * 15 * 31, lds);
}
__device__ __forceinline__ void ph_norm(const Ctx& C0_, int blk) {
    const Ctx C = fresh_ctx(C0_);
    ArgsP a = fresh_args(); unsigned char* ws = a->ws; const int l = blk / 3, kind = blk % 3; const bool last = (l == NL - 1);
    h16* XS = (h16*)(ws + WS_XS); const float* modl = (const float*)(ws + WS_MODV) + (size_t)l * 5 * NMOD;
    const bool from_in = (blk == 0), ctx_in = (blk <= 1);
    const float* sx = from_in ? a->x : nullptr; const float* scx = ctx_in ? a->ctx : nullptr;
    const bool fold = (blk != 0) && !(kind == 2 && last);
    const float* gain = (kind == 0 ? a->ffn1_norm : (kind == 1 ? a->mix_norm : a->ffn2_norm)) + (size_t)l * DM;
    norm_phase(C, sx, scx, XS, gain, modl, 3 * kind, 3 * kind + 1, (kind == 2 && last) ? TX : T, (bf16*)(ws + WS_H), fold ? (const h16*)(ws + WS_SLAB) : nullptr);
}
__device__ __forceinline__ void ph_resid(const Ctx& C0_, int blk) {
    const Ctx C = fresh_ctx(C0_);
    ArgsP a = fresh_args(); unsigned char* ws = a->ws; const int l = blk / 3, kind = blk % 3; const bool last = (l == NL - 1);
    const unsigned char* wl = ws + WS_W + (size_t)l * W_LAYER;
    const bool mix = (kind == 1);
    const char* A = (const char*)(ws + (mix ? WS_CC : WS_GU)); const char* B = (const char*)(wl + (mix ? WO_OUT : (kind == 0 ? WO_D1 : WO_D2)));
    const bool with_ctx = mix ? !last : !(kind == 2 && last);
    resid_gemm(C, 10 + blk, A, B, mix ? DM : FF, mix ? DM : FFP, blk == 0, l * 5 * NMOD + (3 * kind + 2) * DM, mix ? 1.0f : 0.5f, with_ctx);
    unsigned* th = dyn_heads(a, 10 + blk) + 512;
    if (blk == 0) tail_items(C, th, TSeg{2, 0, 0, 96}, TSeg{0, 0, CI_IN, CV_IN + CV_OUT});
    else if (blk == 1) tail_items(C, th, TSeg{0, 0, CI_D2, CV_D}, TSeg{0, 0, 0, 0});
    else if (blk == 2) tail_items(C, th, TSeg{2, 1, 96, 96}, TSeg{0, 1, CI_GU1 + CV_GU, CV_GU});
    else if (blk == 3) tail_items(C, th, TSeg{1, 1, 144 + 80, 64}, TSeg{0, 1, CI_IN, CV_IN + CV_OUT});
}

#ifndef PROBE_MASK
#define PROBE_MASK 0
#endif
#define TP_BEGIN(id) do { if ((PROBE_MASK >> (id)) & 1) { if (blockIdx.x == 0 && threadIdx.x == 0) { const unsigned long long t = __builtin_amdgcn_s_memrealtime(); MISC[16] = (unsigned)t; MISC[17] = (unsigned)(t >> 32); } } } while (0)
#define TP_END(id) do { if ((PROBE_MASK >> (id)) & 1) { if (blockIdx.x == 0 && threadIdx.x == 0) { const unsigned long long t0 = ((unsigned long long)MISC[17] << 32) | MISC[16]; \
    const unsigned long long acc = (((unsigned long long)MISC[19] << 32) | MISC[18]) + (__builtin_amdgcn_s_memrealtime() - t0); MISC[18] = (unsigned)acc; MISC[19] = (unsigned)(acc >> 32); } } } while (0)
__global__ void __launch_bounds__(NTHR, 2) dit_fwd(Args a_unused) {
    extern __shared__ __attribute__((aligned(16))) unsigned char lds_raw[];
    Ctx C; C.lds = (LAS unsigned char*)lds_raw; C.wave = __builtin_amdgcn_readfirstlane((int)threadIdx.x >> 6); C.wg = blockIdx.x; C.G = gridDim.x;
    volatile LAS unsigned* MISC = (volatile LAS unsigned*)(C.lds + MISC_OFF);
    for (int u = threadIdx.x; u < (LDS_BYTES - LDSCTL_OFF) / 4; u += NTHR) ((LAS unsigned*)(C.lds + LDSCTL_OFF))[u] = 0u;
    __syncthreads();
    XcdBarrier bar = xcd_barrier_post((unsigned*)(fresh_args()->ws + WS_CTL) + CW_BAR, MISC + 8);

    TP_BEGIN(0); prologue_phase(C, fresh_args()); xcd_barrier(bar); TP_END(0);

    for (int blk = 0; blk < 3 * NL; ++blk) {
        const int l = blk / 3, kind = blk % 3;
        TP_BEGIN(1); ph_norm(C, blk); xcd_barrier(bar); TP_END(1);
        if (kind != 1) { TP_BEGIN(2); ph_gu(C, 2 * l + (kind == 2)); xcd_barrier(bar); TP_END(2); }
        else {
            TP_BEGIN(5); ph_inft(C, l);     xcd_barrier(bar); TP_END(5);
            TP_BEGIN(6); TP_BEGIN(8); ph_prep(C, l); TP_END(8); TP_BEGIN(9); ph_prep_fft(C, l); TP_END(9); xcd_barrier(bar); TP_END(6);
            TP_BEGIN(7); ph_dft(C, l); ph_attn(C, l, (char*)lds_raw); ph_na(C, l, (char*)lds_raw); xcd_barrier(bar); TP_END(7);
        }
        TP_BEGIN(3); ph_resid(C, blk); xcd_barrier(bar); TP_END(3);
    }
    { ArgsP a = fresh_args(); final_phase(C, (const h16*)(a->ws + WS_XS), a->final_norm, a->out); }
    if (PROBE_MASK) { if (blockIdx.x == 0 && threadIdx.x == 0) { const unsigned long long acc = ((unsigned long long)MISC[19] << 32) | MISC[18], t0 = __builtin_amdgcn_s_memrealtime();
        while (__builtin_amdgcn_s_memrealtime() - t0 < acc) __builtin_amdgcn_s_sleep(8); } }
}

extern "C" void kernel_launch(void* const* d_in, const int* in_sizes, int n_in, void* d_out, int out_size, void* d_ws, size_t ws_size, hipStream_t stream) {
    static int grid = 0;
    if (grid == 0) {
        if (n_in != 24 || in_sizes[0] != TX * DM || out_size != TX * DM || ws_size < WS_END) { fprintf(stderr, "kernel_launch: shape/workspace mismatch (n_in %d, in0 %d, out %d, ws %zu < %zu)\n", n_in, n_in > 0 ? in_sizes[0] : -1, out_size, ws_size, (size_t)WS_END); grid = -1; return; }
        int dev = 0, cus = 0, per_cu = 0;
        if (hipGetDevice(&dev) != hipSuccess || hipDeviceGetAttribute(&cus, hipDeviceAttributeMultiprocessorCount, dev) != hipSuccess) { grid = -1; return; }
        if (hipFuncSetAttribute((const void*)dit_fwd, hipFuncAttributeMaxDynamicSharedMemorySize, LDS_BYTES) != hipSuccess) { fprintf(stderr, "kernel_launch: hipFuncSetAttribute failed\n"); grid = -1; return; }
        if (hipOccupancyMaxActiveBlocksPerMultiprocessor(&per_cu, (const void*)dit_fwd, NTHR, LDS_BYTES) != hipSuccess || per_cu < 1) fprintf(stderr, "kernel_launch: occupancy query reports %d\n", per_cu);
        (void)hipGetLastError();
        grid = cus;
    }
    if (grid < 0) return;
    if (hipMemsetAsync((char*)d_ws + WS_CTL, 0, CTL_ZERO_BYTES, stream) != hipSuccess) return;
    Args a{};
    const float* const* in = (const float* const*)d_in;
    a.x = in[0]; a.c = in[1]; a.ctx = in[2]; a.c_ctx = in[3]; a.w_mod = in[4]; a.b_mod = in[5]; a.ffn1_norm = in[6]; a.ffn1_gate = in[7]; a.ffn1_up = in[8]; a.ffn1_down = in[9];
    a.mix_norm = in[10]; a.w_in = in[11]; a.w_out = in[12]; a.pool_w = in[13]; a.pool_scale = in[14]; a.q_norm = in[15]; a.k_norm = in[16]; a.fnet_w = in[17]; a.na_rpb = in[18];
    a.ffn2_norm = in[19]; a.ffn2_gate = in[20]; a.ffn2_up = in[21]; a.ffn2_down = in[22]; a.final_norm = in[23];
    a.out = (float*)d_out; a.ws = (unsigned char*)d_ws;
    hipLaunchKernelGGL(dit_fwd, dim3(grid), dim3(NTHR), LDS_BYTES, stream, a);
    const hipError_t le = hipPeekAtLastError();
    if (le != hipSuccess) fprintf(stderr, "kernel_launch: launch failed: %s\n", hipGetErrorName(le));
}
```

```cpp
#include <hip/hip_runtime.h>
#include <cstdio>
#include <cstdint>

namespace pg8 {
#define PG8_LAS __attribute__((address_space(3)))
typedef unsigned short bf16_t;
typedef short bf16x8 __attribute__((ext_vector_type(8)));
typedef float f32x4 __attribute__((ext_vector_type(4)));
typedef unsigned u32x4 __attribute__((ext_vector_type(4)));
constexpr int BM = 256, BK = 64, HALF = 128, HTB = HALF * BK * 2, STAGE_BYTES = 8 * HTB, NXCD = 8, WGM = 8;

__host__ __device__ __forceinline__ int lds_byte(int r, int c) { const int st = (r >> 4) * 2 + (c >> 5), rr = r & 15, cc = c & 31, ob = rr * 64 + cc * 2; return st * 1024 + (ob ^ (((ob >> 9) & 1) << 5)); }
__host__ __device__ __forceinline__ void stage_rc(int b, int& R, int& C) { const int st = b / 1024, sb = b % 1024, swz = sb ^ (((sb >> 9) & 1) << 5); R = (st >> 1) * 16 + swz / 64; C = (st & 1) * 32 + (swz % 64) / 2; }
__host__ __device__ __forceinline__ int perm32(int rho) { const int n = rho >> 4, i = rho & 15; return 8 * (i >> 2) + 4 * n + (i & 3); }

struct Unit { int pm, pn; };
struct Dims { int K, lda, ldb; };
__device__ __forceinline__ int fresh_tid_pg8() { int t = threadIdx.x; asm volatile("" : "+v"(t)); return t; }

struct StaticOrder {
    int nM, nN, nwg, G, c;
    __host__ __device__ void init(int M, int N, int G_, int c_) { nM = M / BM; nN = N / BM; nwg = nM * nN; G = G_; c = c_; }
    __host__ __device__ bool next(int i, Unit& u) const { return at((long)i * G + c, u); }
    __host__ __device__ bool at(long L, Unit& u) const {
        if (L >= nwg) return false;
        int wgid = (int)L; { const int q = nwg / NXCD, r = nwg % NXCD, xcd = wgid % NXCD, off = wgid / NXCD; wgid = (xcd < r ? xcd * (q + 1) : r * (q + 1) + (xcd - r) * q) + off; }
        const int nig = WGM * nN, gid = wgid / nig, fm = gid * WGM, gsz = (nM - fm) < WGM ? (nM - fm) : WGM;
        u.pm = fm + ((wgid % nig) % gsz); u.pn = (wgid % nig) / gsz; return true;
    }
};

struct DynOrder {
    StaticOrder so; int nstat; unsigned* heads; volatile PG8_LAS unsigned* slot; int ncls = 1;
    __device__ __forceinline__ bool next(int i, Unit& u) const {
        if (i < nstat || (so.G & 7)) return so.at((long)i * so.G + so.c, u);
        if ((long)nstat * so.G >= so.nwg) return false;
        if (threadIdx.x == 0) {
            const unsigned one = 1u; const long lsplit = (long)(nstat + ncls) * so.G;
            bool ex = (ncls == 0) || ((i > nstat) && slot[1] != 0u); if (i == nstat) slot[1] = 0u;
            long L = so.nwg;
            if (!ex) { unsigned m_; unsigned* hp = heads + 64 * (so.c & 7);
                asm volatile("global_atomic_add %0, %1, %2, off sc0\n\ts_waitcnt vmcnt(0)" : "=&v"(m_) : "v"(hp), "v"(one) : "memory");
                L = (long)nstat * so.G + 8l * m_ + (so.c & 7); if (L >= lsplit) { slot[1] = 1u; ex = true; L = so.nwg; } }
            if (ex && lsplit < so.nwg) { unsigned g_; unsigned* hp = heads + 768;
                asm volatile("global_atomic_add %0, %1, %2, off sc0\n\ts_waitcnt vmcnt(0)" : "=&v"(g_) : "v"(hp), "v"(one) : "memory");
                L = lsplit + g_; }
            *slot = (unsigned)(L < so.nwg ? L : so.nwg); asm volatile("s_waitcnt lgkmcnt(0)" ::: "memory"); }
        asm volatile("" ::: "memory"); __builtin_amdgcn_s_barrier(); asm volatile("" ::: "memory");
        const unsigned Lc = *slot;
        return so.at((long)Lc, u);
    }
};
__device__ __forceinline__ unsigned cvt_pk_bf16(float lo, float hi) { unsigned r; asm volatile("v_cvt_pk_bf16_f32 %0, %1, %2" : "=v"(r) : "v"(lo), "v"(hi)); return r; }

template <class Epi, class Sched, class Prob, bool ALIGN_EPI = true, bool SP2 = true>
__device__ __forceinline__ void gemm_phase(PG8_LAS unsigned char* lds, const Dims g, const Prob& P, const Sched& S, const Epi& E) {
    const int tid = fresh_tid_pg8(), wid = __builtin_amdgcn_readfirstlane(tid >> 6), lane = tid & 63, wr = wid >> 2, wc = wid & 3, fr = lane & 15, fq = lane >> 4;
    const int K = g.K, nt = K / BK;
    unsigned voffA[2], voffB[2];
#pragma unroll
    for (int i = 0; i < 2; ++i) { int R, C; stage_rc(tid * 16 + i * 8192, R, C); const int Rb = Epi::PERM ? ((R & ~31) + perm32(R & 31)) : R;
        voffA[i] = (unsigned)(R * g.lda + C) * 2u; voffB[i] = (unsigned)(Rb * g.ldb + C) * 2u; }
    const size_t kstep = (size_t)(BK * 2);
    const size_t hstepA = (size_t)HALF * g.lda * 2, hstepB = (size_t)HALF * g.ldb * 2;
    const unsigned ldsw = (unsigned)wid * 1024u;
    const int aoff = lds_byte(wr * 64 + fr, fq * 8), boff = lds_byte(wc * 32 + fr, fq * 8);
#define PG8_SA(b, h) (((b) * 2 + (h)) * HTB)
#define PG8_SB(b, h) ((4 + (b) * 2 + (h)) * HTB)
#define PG8_STAGE(bufoff, gbase, voff) do { _Pragma("unroll") for (int _i = 0; _i < 2; ++_i) \
        __builtin_amdgcn_global_load_lds((const unsigned*)((const char*)(gbase) + (voff)[_i]), (PG8_LAS unsigned*)(lds + (bufoff) + ldsw + _i * 8192), 16, 0, 0); } while (0)
#define PG8_LDA(dst, b, h) do { _Pragma("unroll") for (int m = 0; m < 4; ++m) _Pragma("unroll") for (int k = 0; k < 2; ++k) dst[m][k] = *(const PG8_LAS bf16x8*)(lds + PG8_SA(b, h) + aoff + m * 2048 + k * 1024); } while (0)
#define PG8_LDB(dst, b, h) do { _Pragma("unroll") for (int n = 0; n < 2; ++n) _Pragma("unroll") for (int k = 0; k < 2; ++k) dst[n][k] = *(const PG8_LAS bf16x8*)(lds + PG8_SB(b, h) + boff + n * 2048 + k * 1024); } while (0)
#define PG8_MMA(ai, bj, At, Bt) do { __builtin_amdgcn_s_setprio(1); _Pragma("unroll") for (int m = 0; m < 4; ++m) _Pragma("unroll") for (int n = 0; n < 2; ++n) _Pragma("unroll") for (int k = 0; k < 2; ++k) \
        acc[ai][bj][m][n] = __builtin_amdgcn_mfma_f32_16x16x32_bf16(Bt[n][k], At[m][k], acc[ai][bj][m][n], 0, 0, 0); __builtin_amdgcn_s_setprio(0); } while (0)
#define PG8_WAIT_V(n) asm volatile("s_waitcnt vmcnt(" #n ")" ::: "memory")
#define PG8_WAIT_L(n) asm volatile("s_waitcnt lgkmcnt(" #n ")" ::: "memory")
#define PG8_BAR __builtin_amdgcn_s_barrier()
#define PG8_SCHED __builtin_amdgcn_sched_barrier(0)
    Unit cur, nxt; int ui = 0;
    if (!S.next(0, cur)) return;
    f32x4 acc[2][2][4][2];
#pragma unroll
    for (int a = 0; a < 2; ++a)
#pragma unroll
        for (int b = 0; b < 2; ++b)
#pragma unroll
            for (int m = 0; m < 4; ++m)
#pragma unroll
                for (int n = 0; n < 2; ++n) acc[a][b][m][n] = (f32x4){0.f, 0.f, 0.f, 0.f};
    bf16x8 At[4][2], B0[2][2], B1[2][2];
    const char* cA = P.a_panel(cur); const char* cB = P.b_panel(cur);
    if constexpr (SP2) {
        PG8_STAGE(PG8_SB(0, 0), cB, voffB); PG8_STAGE(PG8_SB(0, 1), cB + hstepB, voffB); PG8_STAGE(PG8_SA(0, 0), cA, voffA); PG8_STAGE(PG8_SA(0, 1), cA + hstepA, voffA);
        if (wr == 1) PG8_BAR;
        PG8_WAIT_V(2); PG8_BAR;
        PG8_STAGE(PG8_SB(1, 0), cB + kstep, voffB); PG8_STAGE(PG8_SA(1, 0), cA + kstep, voffA); PG8_STAGE(PG8_SB(1, 1), cB + hstepB + kstep, voffB);
        PG8_WAIT_V(6); PG8_BAR;
    } else {
        PG8_STAGE(PG8_SB(0, 0), cB, voffB); PG8_STAGE(PG8_SA(0, 0), cA, voffA); PG8_STAGE(PG8_SB(0, 1), cB + hstepB, voffB); PG8_STAGE(PG8_SA(0, 1), cA + hstepA, voffA);
        if (wr == 1) PG8_BAR;
        PG8_WAIT_V(4); PG8_BAR;
        PG8_STAGE(PG8_SB(1, 0), cB + kstep, voffB); PG8_STAGE(PG8_SA(1, 0), cA + kstep, voffA); PG8_STAGE(PG8_SB(1, 1), cB + hstepB + kstep, voffB);
        PG8_WAIT_V(6); PG8_BAR;
    }
    for (;;) {
        const bool has_next = S.next(ui + 1, nxt);
        const char* nA = has_next ? P.a_panel(nxt) : cA; const char* nB = has_next ? P.b_panel(nxt) : cB;
        for (int t = 0; t < nt; t += 2) {
            const bool last = (t == nt - 2);
            const char* a1 = cA + (size_t)(t + 1) * kstep;
            const char* a2 = last ? nA : cA + (size_t)(t + 2) * kstep; const char* b2 = last ? nB : cB + (size_t)(t + 2) * kstep;
            const char* a3 = a2 + kstep; const char* b3 = b2 + kstep;
            if constexpr (SP2) {
            PG8_LDB(B0, 0, 0); PG8_LDB(B1, 0, 1); PG8_SCHED; PG8_LDA(At, 0, 0); PG8_STAGE(PG8_SA(1, 1), a1 + hstepA, voffA);
            PG8_WAIT_V(8); PG8_WAIT_L(0); PG8_BAR; PG8_MMA(0, 0, At, B0); PG8_MMA(0, 1, At, B1); PG8_BAR; PG8_SCHED;
            PG8_LDA(At, 0, 1); PG8_STAGE(PG8_SB(0, 0), b2, voffB); PG8_STAGE(PG8_SB(0, 1), b2 + hstepB, voffB); PG8_STAGE(PG8_SA(0, 0), a2, voffA);
            PG8_WAIT_V(8); PG8_WAIT_L(0); PG8_BAR; PG8_MMA(1, 0, At, B0); PG8_MMA(1, 1, At, B1); PG8_BAR; PG8_SCHED;
            PG8_LDB(B0, 1, 0); PG8_LDB(B1, 1, 1); PG8_SCHED; PG8_LDA(At, 1, 0); PG8_STAGE(PG8_SA(0, 1), a2 + hstepA, voffA);
            PG8_WAIT_V(8); PG8_WAIT_L(0); PG8_BAR; PG8_MMA(0, 0, At, B0); PG8_MMA(0, 1, At, B1); PG8_BAR; PG8_SCHED;
            PG8_LDA(At, 1, 1); PG8_STAGE(PG8_SB(1, 0), b3, voffB); PG8_STAGE(PG8_SB(1, 1), b3 + hstepB, voffB); PG8_STAGE(PG8_SA(1, 0), a3, voffA);
            PG8_WAIT_V(8); PG8_WAIT_L(0); PG8_BAR; PG8_MMA(1, 0, At, B0); PG8_MMA(1, 1, At, B1); PG8_BAR; PG8_SCHED;
            } else {
            PG8_LDB(B0, 0, 0); PG8_SCHED; PG8_LDA(At, 0, 0); PG8_STAGE(PG8_SA(1, 1), a1 + hstepA, voffA);
            PG8_WAIT_L(8); PG8_BAR; PG8_WAIT_L(0); PG8_MMA(0, 0, At, B0); PG8_BAR; PG8_SCHED;
            PG8_LDB(B1, 0, 1); PG8_STAGE(PG8_SB(0, 0), b2, voffB);
            PG8_BAR; PG8_WAIT_L(0); PG8_MMA(0, 1, At, B1); PG8_BAR;
            PG8_LDA(At, 0, 1); PG8_STAGE(PG8_SA(0, 0), a2, voffA);
            PG8_BAR; PG8_WAIT_L(0); PG8_MMA(1, 0, At, B0); PG8_BAR; PG8_SCHED;
            PG8_STAGE(PG8_SB(0, 1), b2 + hstepB, voffB);
            PG8_WAIT_V(6); PG8_BAR; PG8_MMA(1, 1, At, B1); PG8_BAR;
            PG8_LDB(B0, 1, 0); PG8_SCHED; PG8_LDA(At, 1, 0); PG8_STAGE(PG8_SA(0, 1), a2 + hstepA, voffA);
            PG8_WAIT_L(8); PG8_BAR; PG8_WAIT_L(0); PG8_MMA(0, 0, At, B0); PG8_BAR; PG8_SCHED;
            PG8_LDB(B1, 1, 1); PG8_STAGE(PG8_SB(1, 0), b3, voffB);
            PG8_BAR; PG8_WAIT_L(0); PG8_MMA(0, 1, At, B1); PG8_BAR;
            PG8_LDA(At, 1, 1); PG8_STAGE(PG8_SA(1, 0), a3, voffA);
            PG8_BAR; PG8_WAIT_L(0); PG8_MMA(1, 0, At, B0); PG8_BAR; PG8_SCHED;
            PG8_STAGE(PG8_SB(1, 1), b3 + hstepB, voffB);
            PG8_WAIT_V(6); PG8_BAR; PG8_MMA(1, 1, At, B1); PG8_BAR;
            }
        }
        if constexpr (ALIGN_EPI) { if (wr == 0) PG8_BAR; }
        E(acc, cur, wr, wc, fr, fq);
        if (!has_next) break;
#pragma unroll
        for (int a = 0; a < 2; ++a)
#pragma unroll
            for (int b = 0; b < 2; ++b)
#pragma unroll
                for (int m = 0; m < 4; ++m)
#pragma unroll
                    for (int n = 0; n < 2; ++n) acc[a][b][m][n] = (f32x4){0.f, 0.f, 0.f, 0.f};
        cur = nxt; cA = nA; cB = nB; ++ui;
        if constexpr (ALIGN_EPI) { if (wr == 1) PG8_BAR; }
    }
    PG8_WAIT_V(0);
    if constexpr (!ALIGN_EPI) { if (wr == 0) PG8_BAR; }
    PG8_BAR;
#undef PG8_SA
#undef PG8_SB
#undef PG8_STAGE
#undef PG8_LDA
#undef PG8_LDB
#undef PG8_MMA
#undef PG8_WAIT_V
#undef PG8_WAIT_L
#undef PG8_BAR
#undef PG8_SCHED
}
}

constexpr int NWAVES = 8, NTHR = 512;
constexpr int NB = 4, SEQ = 4096, CTXL = 256, DM = 2048, FF = 5632, NGU = 2 * FF, NL = 2;
constexpr int FFP = FF + 64;
constexpr int TX = NB * SEQ, TC = NB * CTXL, T = TX + TC;
constexpr int ZW = 3072;
constexpr int ZP = 0, ZGQ = 512, ZGK = 1024, ZGV = 1280, ZNQ = 1536, ZNK = 2048, ZNV = 2560;
constexpr int NIN = 4096;
constexpr int LDT = 2 * NB * SEQ + 64, LDTC = 2 * NB * CTXL + 64;
constexpr int NMOD = 9 * DM;
constexpr float EPS = 1e-6f;
constexpr int IN_DIM = 3584;

constexpr size_t MiB = 1u << 20;
constexpr size_t WS_CTL = 0, CTL_ZERO_BYTES = 1 * MiB;
constexpr size_t WS_MODV = 1 * MiB;
constexpr size_t WS_ROPE = 1 * MiB + 768 * 1024;
constexpr size_t WS_DFTC = 2 * MiB;
constexpr size_t WS_ABTC = 3 * MiB;
constexpr size_t WS_W = 8 * MiB, W_LAYER = 158 * MiB;
constexpr size_t WO_GU1 = 0, WO_D1 = 44 * MiB, WO_IN = 67 * MiB, WO_OUT = 83 * MiB, WO_GU2 = 91 * MiB, WO_D2 = 135 * MiB;
constexpr size_t WS_DFTM = 324 * MiB;
constexpr size_t WS_XS = 388 * MiB;
constexpr size_t WS_H = 524 * MiB;
constexpr size_t WS_GU = 592 * MiB;
constexpr size_t WS_Z = 592 * MiB;
constexpr size_t WS_CC = 694 * MiB;
constexpr size_t WS_ABT = 782 * MiB;
constexpr size_t WS_SLAB = 815 * MiB;
constexpr size_t WS_END = 847 * MiB;
static_assert(WS_Z + (size_t)T * ZW * 2 <= WS_CC && WS_CC + (size_t)T * DM * 2 <= WS_GU + (size_t)T * FFP * 2 && WS_GU + (size_t)T * FFP * 2 <= WS_ABT && WS_ABT + (size_t)512 * LDT * 2 <= WS_SLAB && WS_SLAB + (size_t)4 * TC * DM * 4 <= WS_END, "ws map");
static_assert(WS_XS + (size_t)T * DM * 4 <= WS_H && WS_H + (size_t)T * DM * 2 <= WS_GU && WS_DFTM + (size_t)4096 * 8192 * 2 <= WS_XS && WS_W + NL * W_LAYER <= WS_DFTM, "ws map 2");
static_assert((size_t)DM * FFP * 2 <= 23 * MiB && (size_t)NGU * DM * 2 <= 44 * MiB, "weight regions");
constexpr int CW_BAR = 4096;

constexpr int RING_BYTES = 131072, CONV_SCR = 17408  , LDSCTL_OFF = 143360, MISC_OFF = LDSCTL_OFF + 320, LDS_BYTES = 147456;
static_assert(8 * CONV_SCR <= LDSCTL_OFF && 64 * 65 * 4 <= CONV_SCR, "LDS map");

#define GAS __attribute__((address_space(1)))
#define LAS __attribute__((address_space(3)))
typedef unsigned short bf16;
typedef unsigned v4u __attribute__((ext_vector_type(4)));
typedef unsigned v2u __attribute__((ext_vector_type(2)));
typedef float f32x4 __attribute__((ext_vector_type(4)));
typedef float f32x2 __attribute__((ext_vector_type(2)));
#define LDS_WAIT() asm volatile("s_waitcnt lgkmcnt(0)" ::: "memory")
__device__ __forceinline__ unsigned f2bf(float f) { unsigned u = __builtin_bit_cast(unsigned, f); return (u + 0x7fffu + ((u >> 16) & 1u)) >> 16; }
__device__ __forceinline__ unsigned pk2(float lo, float hi) { return f2bf(lo) | (f2bf(hi) << 16); }
typedef _Float16 h16;
typedef _Float16 h4 __attribute__((ext_vector_type(4)));
__device__ __forceinline__ f32x4 ld_h4(const h16* p) { return __builtin_convertvector(*(const h4*)p, f32x4); }
__device__ __forceinline__ void st_h4(h16* p, f32x4 v) { *(h4*)p = __builtin_convertvector(v, h4); }
__device__ __forceinline__ f32x4 ld_h4_reg(f32x4 v) { return __builtin_convertvector(__builtin_convertvector(v, h4), f32x4); }
__device__ __forceinline__ float bflo(unsigned w) { return __builtin_bit_cast(float, w << 16); }
__device__ __forceinline__ float bfhi(unsigned w) { return __builtin_bit_cast(float, w & 0xffff0000u); }

#define XB_TMO      128
#define XB_XCNT(j)  (256  + 64 * (j))
#define XB_XSUB(j)  (1280 + 64 * (j))
#define XB_XGEN(j)  (2304 + 64 * (j))
#define XB_TOP      3328
#define XB_TOPGEN   3392
#define XCD_BAR_WORDS 3456
#define XB_SPIN_CAP (1u << 18)
__device__ __forceinline__ unsigned xb_ld(unsigned* p)              { return __hip_atomic_load(p, __ATOMIC_RELAXED, __HIP_MEMORY_SCOPE_AGENT); }
__device__ __forceinline__ unsigned xb_add(unsigned* p, unsigned v) { return __hip_atomic_fetch_add(p, v, __ATOMIC_RELAXED, __HIP_MEMORY_SCOPE_AGENT); }
__device__ __forceinline__ unsigned xb_xcc_id() { return (unsigned)__builtin_amdgcn_s_getreg((3 << 11) | 20) & 0xFu; }
#define XB_SPIN(cond, bar) do { unsigned _sp = 0; while (cond) { __builtin_amdgcn_s_sleep(1); \
    if ((++_sp & 255u) == 0u) { if (xb_ld(&(bar)[XB_TMO])) break; if (_sp > XB_SPIN_CAP) { atomicAdd(&(bar)[XB_TMO], 1u); break; } } } } while (0)
struct XcdBarrier { unsigned* bar; unsigned x; volatile LAS unsigned* st; };
__device__ __forceinline__ unsigned* xb_bar_ptr();
__device__ __forceinline__ XcdBarrier xcd_barrier_post(unsigned* bar, volatile LAS unsigned* st) {
    XcdBarrier b; b.bar = bar; b.x = xb_xcc_id(); b.st = st;
    if (threadIdx.x == 0) (void)xb_add(&bar[XB_XCNT(b.x)], 1u);
    return b;
}
__device__ __forceinline__ void xcd_barrier_complete(unsigned* bar, unsigned x, unsigned& nloc, unsigned& nx) {
    const unsigned G = gridDim.x * gridDim.y * gridDim.z;
    unsigned sum, cnt, mine, sp = 0u;
    for (;;) {
        sum = 0u; cnt = 0u; mine = 0u;
#pragma unroll
        for (unsigned j = 0; j < 16; ++j) { const unsigned c = xb_ld(&bar[XB_XCNT(j)]); sum += c; cnt += (c > 0u) ? 1u : 0u; mine = (j == x) ? c : mine; }
        if (sum == G) break;
        __builtin_amdgcn_s_sleep(1);
        if ((++sp & 255u) == 0u) { if (xb_ld(&bar[XB_TMO])) break; if (sp > XB_SPIN_CAP) { atomicAdd(&bar[XB_TMO], 1u); break; } }
    }
    nloc = mine > 0u ? mine : 1u; nx = cnt > 0u ? cnt : 1u;
}
__device__ __forceinline__ void xcd_barrier(const XcdBarrier& b_in) {
    XcdBarrier b; b.st = b_in.st; b.bar = xb_bar_ptr(); b.x = (unsigned)__builtin_amdgcn_readfirstlane((int)xb_xcc_id());
    asm volatile("s_waitcnt vmcnt(0)" ::: "memory");
    __syncthreads();
    if (threadIdx.x == 0) {
        unsigned* bar = b.bar;
        __builtin_amdgcn_s_waitcnt(0);
        unsigned nloc = b.st[0], nx = b.st[1];
        if (nloc == 0u) { xcd_barrier_complete(bar, b.x, nloc, nx); b.st[0] = nloc; b.st[1] = nx; }
        const unsigned old = xb_add(&bar[XB_XSUB(b.x)], 1u);
        const unsigned gen = old / nloc;
        if (old + 1u == (gen + 1u) * nloc) {
            __builtin_amdgcn_fence(__ATOMIC_RELEASE, "agent");
            asm volatile("s_waitcnt vmcnt(0)" ::: "memory");
            const unsigned og = xb_add(&bar[XB_TOP], 1u);
            const unsigned tg = og / nx;
            if (og + 1u == (tg + 1u) * nx) xb_add(&bar[XB_TOPGEN], 1u);
            else XB_SPIN(xb_ld(&bar[XB_TOPGEN]) == tg, bar);
            __builtin_amdgcn_fence(__ATOMIC_ACQUIRE, "agent");
            xb_add(&bar[XB_XGEN(b.x)], 1u);
            asm volatile("s_waitcnt vmcnt(0)" ::: "memory");
        } else {
            XB_SPIN(xb_ld(&bar[XB_XGEN(b.x)]) == gen, bar);
            __builtin_amdgcn_fence(__ATOMIC_ACQUIRE, "agent");
            asm volatile("s_waitcnt vmcnt(0)" ::: "memory");
        }
    }
    __syncthreads();
}

struct Args {
    const float *x, *c, *ctx, *c_ctx, *w_mod, *b_mod, *ffn1_norm, *ffn1_gate, *ffn1_up, *ffn1_down, *mix_norm, *w_in, *w_out, *pool_w, *pool_scale,
                *q_norm, *k_norm, *fnet_w, *na_rpb, *ffn2_norm, *ffn2_gate, *ffn2_up, *ffn2_down, *final_norm;
    float* out; unsigned char* ws;
};
struct Ctx {
    LAS unsigned char* lds; int wave, wg, G;
};
__device__ __forceinline__ Ctx fresh_ctx(const Ctx& C) { Ctx L = C; asm volatile("" : "+s"(L.wave), "+s"(L.wg), "+s"(L.G)); return L; }
__device__ __forceinline__ int fresh_tid() { int t = threadIdx.x; asm volatile("" : "+v"(t)); return t; }
typedef const Args __attribute__((address_space(4))) * ArgsP;
__device__ __forceinline__ ArgsP fresh_args() { ArgsP p = (ArgsP)__builtin_amdgcn_kernarg_segment_ptr(); asm volatile("" : "+s"(p)); return p; }
struct EpiResid {
    static constexpr bool PERM = false;
    int gate_off;
    float coef;
    int flags;
    __device__ __forceinline__ void operator()(const pg8::f32x4 (&acc)[2][2][4][2], const pg8::Unit& u, int wr, int wc, int fr, int fq) const {
        ArgsP a_ = fresh_args(); unsigned char* ws_ = a_->ws;
        const float* base_f32 = (flags & 1) ? a_->x : nullptr; h16* XS = (h16*)(ws_ + WS_XS); const float* gate = (const float*)(ws_ + WS_MODV) + gate_off;
        h16* slab = (flags & 2) ? (h16*)(ws_ + WS_SLAB) : nullptr;
        const int s = slab ? 4 : (u.pm >> 4);
        int fr_ = fr, fq_ = fq; asm volatile("" : "+v"(fr_), "+v"(fq_));
        const int r0 = wr * 64 + fr_, col0 = u.pn * 256 + wc * 32 + 4 * fq_;
        f32x4 gv[2][2];
        { const float* gp = gate + (size_t)s * NMOD + col0;
          const f32x4 g00 = *(const f32x4*)(gp), g01 = *(const f32x4*)(gp + 16), g10 = *(const f32x4*)(gp + 128), g11 = *(const f32x4*)(gp + 144);
          gv[0][0] = g00; gv[0][1] = g01; gv[1][0] = g10; gv[1][1] = g11; }
#define GV_SCALE() do { _Pragma("unroll") for (int bj = 0; bj < 2; ++bj) _Pragma("unroll") for (int n = 0; n < 2; ++n) gv[bj][n] = gv[bj][n] * coef; } while (0)
        if (slab) {
            GV_SCALE();
            h16* op = slab + ((size_t)(u.pm >> 2) * TC + (size_t)(u.pm & 3) * 256) * DM;
#pragma unroll
            for (int ai = 0; ai < 2; ++ai)
#pragma unroll
                for (int m = 0; m < 4; ++m) { const size_t off = (size_t)(r0 + ai * 128 + m * 16) * DM + col0;
#pragma unroll
                    for (int bj = 0; bj < 2; ++bj)
#pragma unroll
                        for (int n = 0; n < 2; ++n) st_h4(op + off + bj * 128 + n * 16, gv[bj][n] * acc[ai][bj][m][n]); }
        } else {
            h16* op = XS + (size_t)u.pm * 256 * DM;
#define RESID_BATCH(LOADEXPR) _Pragma("unroll") for (int ai = 0; ai < 2; ++ai) _Pragma("unroll") for (int mp = 0; mp < 2; ++mp) { \
                f32x4 b000, b001, b010, b011, b100, b101, b110, b111; \
                { const size_t off = (size_t)(r0 + ai * 128 + (2 * mp) * 16) * DM + col0; b000 = LOADEXPR(off); b001 = LOADEXPR(off + 16); b010 = LOADEXPR(off + 128); b011 = LOADEXPR(off + 144); } \
                { const size_t off = (size_t)(r0 + ai * 128 + (2 * mp + 1) * 16) * DM + col0; b100 = LOADEXPR(off); b101 = LOADEXPR(off + 16); b110 = LOADEXPR(off + 128); b111 = LOADEXPR(off + 144); } \
                asm volatile("" ::: "memory"); \
                { const size_t off = (size_t)(r0 + ai * 128 + (2 * mp) * 16) * DM + col0; \
                  st_h4(op + off, b000 + gv[0][0] * acc[ai][0][2 * mp][0]); st_h4(op + off + 16, b001 + gv[0][1] * acc[ai][0][2 * mp][1]); \
                  st_h4(op + off + 128, b010 + gv[1][0] * acc[ai][1][2 * mp][0]); st_h4(op + off + 144, b011 + gv[1][1] * acc[ai][1][2 * mp][1]); } \
                { const size_t off = (size_t)(r0 + ai * 128 + (2 * mp + 1) * 16) * DM + col0; \
                  st_h4(op + off, b100 + gv[0][0] * acc[ai][0][2 * mp + 1][0]); st_h4(op + off + 16, b101 + gv[0][1] * acc[ai][0][2 * mp + 1][1]); \
                  st_h4(op + off + 128, b110 + gv[1][0] * acc[ai][1][2 * mp + 1][0]); st_h4(op + off + 144, b111 + gv[1][1] * acc[ai][1][2 * mp + 1][1]); } \
                asm volatile("" ::: "memory"); }
            if (base_f32) { const float* bp = base_f32 + (size_t)u.pm * 256 * DM; GV_SCALE();
#define LD32(o) (*(const f32x4*)(bp + (o)))
                RESID_BATCH(LD32)
#undef LD32
            } else {
                const __amdgpu_buffer_rsrc_t rx = __builtin_amdgcn_make_buffer_rsrc((void*)op, 0, 256 * DM * 2, 0x00020000);
                const unsigned vo = (unsigned)(r0 * DM + col0) * 2u;
#define ROFF(AI, M, BJ, N) ((((AI) * 128 + (M) * 16) * DM + (BJ) * 128 + (N) * 16) * 2)
                v2u raw[2][4][2][2];
#pragma unroll
                for (int ai = 0; ai < 2; ++ai)
#pragma unroll
                    for (int m = 0; m < 4; ++m)
#pragma unroll
                        for (int bj = 0; bj < 2; ++bj)
#pragma unroll
                            for (int n = 0; n < 2; ++n) raw[ai][m][bj][n] = __builtin_amdgcn_raw_buffer_load_b64(rx, vo, ROFF(ai, m, bj, n), 0);
                asm volatile("" ::: "memory");
                { float cf = coef; asm volatile("" : "+v"(cf));
#pragma unroll
                  for (int bj = 0; bj < 2; ++bj)
#pragma unroll
                      for (int n = 0; n < 2; ++n) gv[bj][n] = gv[bj][n] * cf; }
#pragma unroll
                for (int ai = 0; ai < 2; ++ai)
#pragma unroll
                    for (int m = 0; m < 4; ++m)
#pragma unroll
                        for (int bj = 0; bj < 2; ++bj)
#pragma unroll
                            for (int n = 0; n < 2; ++n) { const f32x4 v_ = __builtin_convertvector(__builtin_bit_cast(h4, raw[ai][m][bj][n]), f32x4) + gv[bj][n] * acc[ai][bj][m][n];
                                __builtin_amdgcn_raw_buffer_store_b64(__builtin_bit_cast(v2u, __builtin_convertvector(v_, h4)), rx, vo, ROFF(ai, m, bj, n), 0); }
#undef ROFF
            }
#undef RESID_BATCH
#undef GV_SCALE
        }
    }
};
template <int CTRL> __device__ __forceinline__ float dpp_f(float v) { return __builtin_bit_cast(float, __builtin_amdgcn_update_dpp(0, __builtin_bit_cast(int, v), CTRL, 0xf, 0xf, false)); }
__device__ __forceinline__ float row16_sum(float v) {
    v += dpp_f<0xB1>(v); v += dpp_f<0x4E>(v); v += dpp_f<0x141>(v); v += dpp_f<0x140>(v); return v;
}
__device__ __forceinline__ unsigned* xb_bar_ptr() { return (unsigned*)(fresh_args()->ws + WS_CTL) + CW_BAR; }
__device__ __forceinline__ float row16_sum_bp(float v, int lane) {
#pragma unroll
    for (int m = 1; m < 16; m <<= 1) v += __builtin_bit_cast(float, __builtin_amdgcn_ds_bpermute((lane ^ m) << 2, __builtin_bit_cast(int, v)));
    return v;
}
__device__ __forceinline__ float wave_sum(float v) {
    v = row16_sum(v);
    const float r0 = __builtin_bit_cast(float, __builtin_amdgcn_readlane(__builtin_bit_cast(int, v), 0)), r1 = __builtin_bit_cast(float, __builtin_amdgcn_readlane(__builtin_bit_cast(int, v), 16));
    const float r2 = __builtin_bit_cast(float, __builtin_amdgcn_readlane(__builtin_bit_cast(int, v), 32)), r3 = __builtin_bit_cast(float, __builtin_amdgcn_readlane(__builtin_bit_cast(int, v), 48));
    return (r0 + r1) + (r2 + r3);
}

struct EpiSwiglu {
    static constexpr bool PERM = true;
    bf16* GU;
    __device__ __forceinline__ void operator()(const pg8::f32x4 (&acc)[2][2][4][2], const pg8::Unit& u, int wr, int wc, int fr, int fq) const {
        const int row0 = u.pm * 256 + wr * 64 + fr, col0 = u.pn * 128 + wc * 32 + 8 * fq;
#pragma unroll
        for (int ai = 0; ai < 2; ++ai)
#pragma unroll
            for (int m = 0; m < 4; ++m) {
                unsigned wv[4];
#pragma unroll
                for (int q = 0; q < 4; ++q) { const int n = q >> 1, j = (q & 1) * 2;
                    const f32x2 g = {acc[ai][0][m][n][j], acc[ai][0][m][n][j + 1]}, up = {acc[ai][1][m][n][j], acc[ai][1][m][n][j + 1]};
                    const f32x2 t = g * -1.4426950408889634f, gu = g * up;
                    f32x2 d = {__builtin_amdgcn_exp2f(t.x), __builtin_amdgcn_exp2f(t.y)}; d = d + 1.0f;
                    const f32x2 rr = {__builtin_amdgcn_rcpf(d.x), __builtin_amdgcn_rcpf(d.y)}, o = gu * rr;
                    unsigned pk; asm("v_cvt_pk_bf16_f32 %0, %1, %2" : "=v"(pk) : "v"(o.x), "v"(o.y)); wv[q] = pk; }
                v4u w; w.x = wv[0]; w.y = wv[1]; w.z = wv[2]; w.w = wv[3];
                *(v4u*)(GU + (size_t)(row0 + ai * 128 + m * 16) * FFP + col0) = w; }
    }
};
struct EpiZ {
    static constexpr bool PERM = true;
    bf16* Z; bf16* ABT; bf16* ABTC;
    __device__ __forceinline__ void operator()(const pg8::f32x4 (&acc)[2][2][4][2], const pg8::Unit& u, int wr, int wc, int fr, int fq) const {
        bf16* base; size_t ld;
        if (u.pn < 12) { base = Z + (size_t)u.pm * 256 * ZW + u.pn * 256; ld = ZW; }
        else { const int cc = (u.pn - 12) * 256, trig = cc >> 9, c0 = cc & 511;
            if (u.pm < 64) { const int b = u.pm >> 4, n0 = (u.pm & 15) * 256; base = ABT + (size_t)c0 * LDT + b * (2 * SEQ) + trig * SEQ + n0; ld = LDT; }
            else { const int b = u.pm - 64; base = ABTC + (size_t)c0 * LDTC + b * (2 * CTXL) + trig * CTXL; ld = LDTC; } }
        const int r0 = wr * 64 + fr, col0 = wc * 32 + 8 * fq;
#pragma unroll
        for (int ai = 0; ai < 2; ++ai)
#pragma unroll
            for (int m = 0; m < 4; ++m) { bf16* rowp = base + (size_t)(r0 + ai * 128 + m * 16) * ld + col0;
#pragma unroll
                for (int bj = 0; bj < 2; ++bj) { const pg8::f32x4 v0 = acc[ai][bj][m][0], v1 = acc[ai][bj][m][1];
                    v4u w; w.x = pg8::cvt_pk_bf16(v0[0], v0[1]); w.y = pg8::cvt_pk_bf16(v0[2], v0[3]); w.z = pg8::cvt_pk_bf16(v1[0], v1[1]); w.w = pg8::cvt_pk_bf16(v1[2], v1[3]);
                    *(v4u*)(rowp + bj * 128) = w; } }
    }
};
struct ProbPlain { const char* A; const char* B; size_t ta, tb;
    __device__ __forceinline__ const char* a_panel(const pg8::Unit& u) const { return A + (size_t)u.pm * ta; }
    __device__ __forceinline__ const char* b_panel(const pg8::Unit& u) const { return B + (size_t)u.pn * tb; } };
struct ProbSplit { const char* A; const char* B; size_t ta, tb; int pmask, kshift; size_t kbytes;
    __device__ __forceinline__ const char* a_panel(const pg8::Unit& u) const { return A + (size_t)(u.pm & pmask) * ta + (size_t)(u.pm >> kshift) * kbytes; }
    __device__ __forceinline__ const char* b_panel(const pg8::Unit& u) const { return B + (size_t)u.pn * tb + (size_t)(u.pm >> kshift) * kbytes; } };
struct ProbInFt { const char* H; const char* W;
    __device__ __forceinline__ const char* a_panel(const pg8::Unit& u) const { return u.pn < 12 ? H + (size_t)u.pm * (256 * DM * 2) : W + (size_t)u.pn * (256 * DM * 2); }
    __device__ __forceinline__ const char* b_panel(const pg8::Unit& u) const { return u.pn < 12 ? W + (size_t)u.pn * (256 * DM * 2) : H + (size_t)u.pm * (256 * DM * 2); } };
struct ProbDft { const char* A; const char* B; int bshift, bmask; size_t bbatch, bsub, bpanel;
    __device__ __forceinline__ const char* a_panel(const pg8::Unit& u) const { return A; }
    __device__ __forceinline__ const char* b_panel(const pg8::Unit& u) const { return B + (size_t)(u.pm >> bshift) * bbatch + (size_t)(u.pm & bmask) * bsub + (size_t)u.pn * bpanel; } };
struct EpiDft {
    static constexpr bool PERM = true;
    bf16* O; int ldc, row0, rshift, rmask, rbatch, rstride;
    __device__ __forceinline__ void operator()(const pg8::f32x4 (&acc)[2][2][4][2], const pg8::Unit& u, int wr, int wc, int fr, int fq) const {
        const int rb = row0 + (u.pm >> rshift) * rbatch + (u.pm & rmask);
        bf16* base = O + u.pn * 256 + wc * 32 + 8 * fq;
        const int r0 = wr * 64 + fr;
#pragma unroll
        for (int ai = 0; ai < 2; ++ai)
#pragma unroll
            for (int m = 0; m < 4; ++m) { bf16* rowp = base + (size_t)(rb + rstride * (r0 + ai * 128 + m * 16)) * ldc;
#pragma unroll
                for (int bj = 0; bj < 2; ++bj) { const pg8::f32x4 v0 = acc[ai][bj][m][0], v1 = acc[ai][bj][m][1];
                    v4u w; w.x = pg8::cvt_pk_bf16(v0[0], v0[1]); w.y = pg8::cvt_pk_bf16(v0[2], v0[3]); w.z = pg8::cvt_pk_bf16(v1[0], v1[1]); w.w = pg8::cvt_pk_bf16(v1[2], v1[3]);
                    *(v4u*)(rowp + bj * 128) = w; } }
    }
};

__device__ __forceinline__ void transpose_tile(const float* W, int ldw, int k0, int n0, bf16* WT, int ldt, int drow0, LAS float* scr, int lane) {
    const int lr = lane >> 4, lc = (lane & 15) * 4;
    f32x4 v[16];
#pragma unroll
    for (int i = 0; i < 16; ++i) v[i] = __builtin_nontemporal_load((const f32x4*)(W + (size_t)(k0 + 4 * i + lr) * ldw + n0 + lc));
#pragma unroll
    for (int i = 0; i < 16; ++i) { LAS float* d = scr + (4 * i + lr) * 65 + lc; d[0] = v[i].x; d[1] = v[i].y; d[2] = v[i].z; d[3] = v[i].w; }
    LDS_WAIT(); asm volatile("" ::: "memory");
    const int c = lane & 7;
#pragma unroll
    for (int j = 0; j < 8; ++j) { const int n = (lane >> 3) + 8 * j; const LAS float* s = scr + (8 * c) * 65 + n;
        v4u o; o.x = pk2(s[0 * 65], s[1 * 65]); o.y = pk2(s[2 * 65], s[3 * 65]); o.z = pk2(s[4 * 65], s[5 * 65]); o.w = pk2(s[6 * 65], s[7 * 65]);
        *(GAS v4u*)(WT + (size_t)(drow0 + n) * ldt + k0 + 8 * c) = o; }
    LDS_WAIT(); asm volatile("" ::: "memory");
}
constexpr int CV_GU = (DM / 64) * (FF / 512), CV_D = (FF / 64) * (DM / 512), CV_IN = (DM / 64) * 5, CV_OUT = (DM / 64) * (DM / 512);
constexpr int CONV_PER_LAYER = 4 * CV_GU + 2 * CV_D + CV_IN + CV_OUT;
constexpr int CI_GU1 = 0, CI_GU2 = 2 * CV_GU, CI_D1 = 4 * CV_GU, CI_D2 = CI_D1 + CV_D, CI_IN = CI_D2 + CV_D, CI_OUT = CI_IN + CV_IN;
__device__ __forceinline__ void conv_item(const Ctx& C, ArgsP a, int l, int r) {
    const int lane = fresh_tid() & 63;
    unsigned char* wl = a->ws + WS_W + (size_t)l * W_LAYER;
    LAS float* scr = (LAS float*)(C.lds + C.wave * CONV_SCR);
    const float* W; int ldw, kb, nb, ldt; bf16* WT; int mode;
    if (r < 4 * CV_GU) { const int which = r / CV_GU; r %= CV_GU;
        W = ((which == 0) ? a->ffn1_gate : (which == 1) ? a->ffn1_up : (which == 2) ? a->ffn2_gate : a->ffn2_up) + (size_t)l * DM * FF;
        ldw = FF; kb = r / (FF / 512); nb = r % (FF / 512); WT = (bf16*)(wl + ((which < 2) ? WO_GU1 : WO_GU2)); ldt = DM; mode = which & 1; }
    else if ((r -= 4 * CV_GU) < 2 * CV_D) { const int which = r / CV_D; r %= CV_D;
        W = (which ? a->ffn2_down : a->ffn1_down) + (size_t)l * FF * DM; ldw = DM; kb = r / (DM / 512); nb = r % (DM / 512); WT = (bf16*)(wl + (which ? WO_D2 : WO_D1)); ldt = FFP; mode = 2; }
    else if ((r -= 2 * CV_D) < CV_IN) { W = a->w_in + (size_t)l * DM * IN_DIM; ldw = IN_DIM; kb = r / 5; nb = r % 5; WT = (bf16*)(wl + WO_IN); ldt = DM; mode = 3; }
    else { r -= CV_IN; W = a->w_out + (size_t)l * DM * DM; ldw = DM; kb = r / (DM / 512); nb = r % (DM / 512); WT = (bf16*)(wl + WO_OUT); ldt = DM; mode = 2; }
    int n0 = nb * 512 + C.wave * 64, drow0;
    if (mode == 3) { n0 = (nb < 2 ? 512 + nb * 512 : 2048 + (nb - 2) * 512) + C.wave * 64; drow0 = n0 < 2048 ? n0 : n0 - 512; }
    else if (mode == 2) drow0 = n0;
    else drow0 = (n0 >> 7) * 256 + mode * 128 + (n0 & 127);
    transpose_tile(W, ldw, kb * 64, n0, WT, ldt, drow0, scr, lane);
}
constexpr int CW_DYN = 12288;
__device__ __forceinline__ unsigned* dyn_heads(ArgsP a, int k) { return (unsigned*)(a->ws + WS_CTL) + CW_DYN + 1024 * k; }
__device__ __forceinline__ void fold_item(const Ctx& C, ArgsP a, int it) {
    const int khalf = it & 1, dblk = (it >> 1) & 3, g = (it >> 3) & 3, kind = (it >> 5) % 3, l = it / 96;
    LAS float* Mb = (LAS float*)C.lds;
    LAS float* Wl = (LAS float*)(C.lds + 16384);
    LAS float* tab = (LAS float*)(C.lds + 16384 + 64 * 129 * 4);
    const int tid = fresh_tid(), d0 = dblk * 32;
    __syncthreads();
    if (tid < 128) tab[tid] = cospif((float)tid * (1.0f / 64.0f));
    __syncthreads();
    if (kind == 0) {
        const float* pw = a->pool_w + ((size_t)(l * 4 + g) * 128) * 128; const float* ps = a->pool_scale + (size_t)l * 512 + g * 128;
        { float pv[8]; const float psv = ps[d0 + (tid & 31)];
#pragma unroll
          for (int u = 0; u < 8; ++u) { const int i = tid + u * NTHR; pv[u] = pw[(i >> 5) * 128 + d0 + (i & 31)]; }
          asm volatile("" ::: "memory");
#pragma unroll
          for (int u = 0; u < 8; ++u) Mb[tid + u * NTHR] = pv[u] * psv; }
    } else {
        const float* fw = a->fnet_w + ((size_t)(l * 4 + g) * 128) * 128;
        LAS float* Fl = (LAS float*)(C.lds + 65536);
#pragma unroll
        for (int j = 0; j < 2; ++j) { const int i = tid + j * NTHR, e = i >> 3, q = (i & 7) * 4; *(LAS f32x4*)(Fl + e * 32 + q) = *(const f32x4*)(fw + e * 128 + d0 + q); }
        __syncthreads();
        const int c = tid >> 2, dq = (tid & 3) * 8, sh = (kind == 2) ? 96 : 0;
        float acc[8];
#pragma unroll
        for (int j = 0; j < 8; ++j) acc[j] = 0.f;
#pragma unroll 8
        for (int e = 0; e < 128; ++e) { const float t = tab[(c * e + sh) & 127]; const f32x4 w0 = *(const LAS f32x4*)(Fl + e * 32 + dq), w1 = *(const LAS f32x4*)(Fl + e * 32 + dq + 4);
#pragma unroll
            for (int j = 0; j < 4; ++j) { acc[j] += t * w0[j]; acc[4 + j] += t * w1[j]; } }
#pragma unroll
        for (int j = 0; j < 8; ++j) Mb[c * 32 + dq + j] = acc[j];
    }
    __syncthreads();
    const int colbase = (kind == 0 ? 0 : 1536) + g * 128, rowbase = (kind == 0 ? 0 : (kind == 1 ? 3072 : 3584)) + g * 128 + d0;
    const float* Wi = a->w_in + (size_t)l * DM * IN_DIM;
    bf16* WT = (bf16*)(a->ws + WS_W + (size_t)l * W_LAYER + WO_IN);
    { typedef float f32x16v __attribute__((ext_vector_type(16)));
      const int lane = tid & 63, n = lane & 31, hf = lane >> 5;
      float am[64];
#pragma unroll
      for (int j = 0; j < 64; ++j) am[j] = Mb[(hf * 64 + j) * 32 + n];
      const int kw = khalf * 1024 + C.wave * 128;
      f32x4 w[16];
#pragma unroll
      for (int t = 0; t < 4; ++t) {
#pragma unroll
          for (int q = 0; q < 16; ++q) w[q] = *(const f32x4*)(Wi + (size_t)(kw + t * 32 + n) * IN_DIM + colbase + hf * 64 + 4 * q);
          asm volatile("" ::: "memory");
          f32x16v acc = {0.f, 0.f, 0.f, 0.f, 0.f, 0.f, 0.f, 0.f, 0.f, 0.f, 0.f, 0.f, 0.f, 0.f, 0.f, 0.f};
#pragma unroll
          for (int j = 0; j < 64; ++j) acc = __builtin_amdgcn_mfma_f32_32x32x2f32(am[j], w[j >> 2][j & 3], acc, 0, 0, 0);
          bf16* op = WT + (size_t)rowbase * DM + kw + t * 32 + n;
#pragma unroll
          for (int r = 0; r < 16; ++r) op[(size_t)((r & 3) + 8 * (r >> 2) + 4 * hf) * DM] = (bf16)f2bf(acc[r]);
          asm volatile("" ::: "memory");
      }
    }
    __syncthreads();
}
__device__ __forceinline__ void mod_item(const Ctx& C, ArgsP a, int it) {
    const int tid = fresh_tid(), lane = tid & 63;
    const int l = it / 144, ch = it % 144;
    LAS float* sc = (LAS float*)C.lds;
    LAS float* red = (LAS float*)(C.lds + 5 * 2048 * 4);
    __syncthreads();
    { float vv[5 * DM / NTHR];
#pragma unroll
      for (int u = 0; u < 5 * DM / NTHR; ++u) { const int i = tid + u * NTHR, s = i / DM, k = i % DM; vv[u] = s < 4 ? a->c[s * DM + k] : a->c_ctx[k]; }
      asm volatile("" ::: "memory");
#pragma unroll
      for (int u = 0; u < 5 * DM / NTHR; ++u) { const float v = vv[u]; sc[tid + u * NTHR] = v / (1.0f + __expf(-v)); } }
    __syncthreads();
    const float* wm = a->w_mod + (size_t)l * DM * NMOD + ch * 128 + 2 * lane;
    float acc[5][2];
#pragma unroll
    for (int s = 0; s < 5; ++s) { acc[s][0] = 0.f; acc[s][1] = 0.f; }
    const int kbeg = C.wave * 256;
    for (int k = kbeg; k < kbeg + 256; k += 16) {
        f32x2 w[16];
#pragma unroll
        for (int j = 0; j < 16; ++j) w[j] = __builtin_nontemporal_load((const f32x2*)(wm + (size_t)(k + j) * NMOD));
#pragma unroll
        for (int s = 0; s < 5; ++s)
#pragma unroll
            for (int q = 0; q < 4; ++q) { const f32x4 sv = *(const LAS f32x4*)(sc + s * DM + k + 4 * q);
#pragma unroll
                for (int j = 0; j < 4; ++j) { acc[s][0] += sv[j] * w[4 * q + j].x; acc[s][1] += sv[j] * w[4 * q + j].y; } }
    }
#pragma unroll
    for (int s = 0; s < 5; ++s) { red[(C.wave * 5 + s) * 128 + 2 * lane] = acc[s][0]; red[(C.wave * 5 + s) * 128 + 2 * lane + 1] = acc[s][1]; }
    __syncthreads();
    float* mv = (float*)(a->ws + WS_MODV) + (size_t)l * 5 * NMOD;
    for (int i = tid; i < 5 * 128; i += NTHR) { const int s = i >> 7, col = i & 127; float v = 0.f;
#pragma unroll
        for (int w = 0; w < 8; ++w) v += red[(w * 5 + s) * 128 + col];
        mv[(size_t)s * NMOD + ch * 128 + col] = v + a->b_mod[(size_t)l * NMOD + ch * 128 + col]; }
    __syncthreads();
}
__device__ __forceinline__ void gen_item(const Ctx& C, ArgsP a, int it) {
    const int tid = fresh_tid();
    bf16* M = (bf16*)(a->ws + WS_DFTC); const float sc = 0.00552427173f;
    for (int i = tid; i < 256 * 512; i += NTHR) { const int k = i >> 9, kk = i & 511, n = kk & 255; const int ph = (k * n) & 255; const float x = (float)ph * (1.0f / 128.0f);
        M[i] = (bf16)f2bf(kk >= 256 ? -sinpif(x) * sc : cospif(x) * sc); }
    float* R = (float*)(a->ws + WS_ROPE);
    for (int i = tid; i < 64 * 32; i += NTHR) { const int p = i >> 5, j = i & 31; const float inv = exp2f(-(float)j * (13.287712379549449f / 32.0f));
        const float ang = (float)p * inv; R[2 * i] = cosf(ang); R[2 * i + 1] = sinf(ang); }
}
struct TSeg { int type, l, first, count; };
__device__ __forceinline__ void run_item(const Ctx& C, ArgsP a, const TSeg& s, int i) {
    if (s.type == 0) conv_item(C, a, s.l, s.first + i);
    else if (s.type == 1) mod_item(C, a, s.first + i);
    else fold_item(C, a, s.first + i);
}
__device__ __forceinline__ void tail_items(const Ctx& C, unsigned* head, const TSeg s0, const TSeg s1) {
    ArgsP a = fresh_args();
    volatile LAS unsigned* slot = (volatile LAS unsigned*)(C.lds + MISC_OFF) + 24;
    for (;;) {
        __syncthreads();
        if (threadIdx.x == 0) *slot = __hip_atomic_fetch_add(head, 1u, __ATOMIC_RELAXED, __HIP_MEMORY_SCOPE_AGENT);
        __syncthreads();
        const int i = (int)*slot;
        if (i >= s0.count + s1.count) break;
        if (i < s0.count) run_item(C, a, s0, i); else run_item(C, a, s1, i - s0.count);
    }
}
constexpr int CW_P0Q = 8192;
__device__ __forceinline__ void prologue_phase(const Ctx& C, ArgsP a) {
    if (C.wg == C.G - 1) gen_item(C, a, 0);
    tail_items(C, (unsigned*)(a->ws + WS_CTL) + CW_P0Q, TSeg{1, 0, 0, 48}, TSeg{0, 0, CI_GU1, 2 * CV_GU});
}

__device__ __forceinline__ void norm_row(const float* src32, const h16* src16, const h16* slabrow, h16* xo, bf16* o, const f32x4 (&A)[8], const f32x4 (&Bv)[8], int lane) {
    f32x4 v[8]; float ss = 0.f;
    if (src32) {
#pragma unroll
        for (int j = 0; j < 8; ++j) v[j] = *(const f32x4*)(src32 + 4 * lane + 256 * j);
    } else {
#pragma unroll
        for (int j = 0; j < 8; ++j) v[j] = ld_h4(src16 + 4 * lane + 256 * j);
    }
    if (slabrow != nullptr) {
        v2u sl[4][8];
#pragma unroll
        for (int ks = 0; ks < 4; ++ks)
#pragma unroll
            for (int j = 0; j < 8; ++j) sl[ks][j] = *(const v2u*)(slabrow + (size_t)ks * TC * DM + 4 * lane + 256 * j);
        asm volatile("" ::: "memory");
#pragma unroll
        for (int ks = 0; ks < 4; ++ks)
#pragma unroll
            for (int j = 0; j < 8; ++j) v[j] += __builtin_convertvector(__builtin_bit_cast(h4, sl[ks][j]), f32x4);
#pragma unroll
        for (int j = 0; j < 8; ++j) { st_h4(xo + 4 * lane + 256 * j, v[j]); v[j] = ld_h4_reg(v[j]); }
    }
#pragma unroll
    for (int j = 0; j < 8; ++j) ss += (v[j].x * v[j].x + v[j].y * v[j].y) + (v[j].z * v[j].z + v[j].w * v[j].w);
    const float rs = 1.0f / sqrtf(wave_sum(ss) * (1.0f / DM) + EPS);
#pragma unroll
    for (int j = 0; j < 8; ++j) { const f32x4 y = v[j] * rs * A[j] + Bv[j]; v2u w; w.x = pk2(y.x, y.y); w.y = pk2(y.z, y.w); *(v2u*)(o + 4 * lane + 256 * j) = w; }
}
template <int NR>
__device__ __forceinline__ void norm_rows_h(__amdgpu_buffer_rsrc_t rx, __amdgpu_buffer_rsrc_t rh, int row0, int rstep, const f32x4 (&A)[8], const f32x4 (&Bv)[8], int lane) {
    f32x4 v[NR][8];
#pragma unroll
    for (int r = 0; r < NR; ++r) { const unsigned off = (unsigned)(row0 + r * rstep) * (DM * 2) + lane * 8;
#pragma unroll
        for (int j = 0; j < 8; ++j) { const v2u w = __builtin_amdgcn_raw_buffer_load_b64(rx, off + 512 * j, 0, 0); v[r][j] = __builtin_convertvector(__builtin_bit_cast(h4, w), f32x4); } }
#pragma unroll
    for (int r = 0; r < NR; ++r) { float ss = 0.f;
#pragma unroll
        for (int j = 0; j < 8; ++j) ss += (v[r][j].x * v[r][j].x + v[r][j].y * v[r][j].y) + (v[r][j].z * v[r][j].z + v[r][j].w * v[r][j].w);
        const float rs = 1.0f / sqrtf(wave_sum(ss) * (1.0f / DM) + EPS); const unsigned off = (unsigned)(row0 + r * rstep) * (DM * 2) + lane * 8;
#pragma unroll
        for (int j = 0; j < 8; ++j) { const f32x4 y = v[r][j] * rs * A[j] + Bv[j]; v2u w; w.x = pk2(y.x, y.y); w.y = pk2(y.z, y.w); __builtin_amdgcn_raw_buffer_store_b64(w, rh, off + 512 * j, 0, 0); } }
}
__device__ __forceinline__ void norm_phase(const Ctx& C, const float* sx32, const float* scx32, h16* XS, const float* gain, const float* modl, int ish, int isc, int nrows, bf16* H, const h16* slab) {
    const int lane = fresh_tid() & 63;
    int G = C.G; asm volatile("" : "+s"(G));
    const int ng = TX / 8; int g0 = (int)((unsigned)(ng * C.wg) / (unsigned)G), g1 = (int)((unsigned)(ng * (C.wg + 1)) / (unsigned)G);
    if (nrows > TX && ng == 8 * G && 2 * (TC / 8) == G) { if (C.wg < TC / 8) { g0 = 7 * C.wg; g1 = g0 + 7; } else { g0 = 7 * (TC / 8) + 9 * (C.wg - TC / 8); g1 = g0 + 9; } }
    int cur = -1; f32x4 A[8], Bv[8];
#define NORM_COEF(s_) do { if ((s_) != cur) { cur = (s_); _Pragma("unroll") for (int j = 0; j < 8; ++j) { const int col = 4 * lane + 256 * j; \
        const f32x4 gn = *(const f32x4*)(gain + col), scv = *(const f32x4*)(modl + (size_t)cur * NMOD + isc * DM + col); \
        A[j] = gn * (scv + 1.0f); Bv[j] = *(const f32x4*)(modl + (size_t)cur * NMOD + ish * DM + col); } } } while (0)
    int g = g0;
    if (!sx32) {
        const __amdgpu_buffer_rsrc_t rx = __builtin_amdgcn_make_buffer_rsrc((void*)XS, 0, TX * DM * 2, 0x00020000), rh = __builtin_amdgcn_make_buffer_rsrc((void*)H, 0, TX * DM * 2, 0x00020000);
        for (; g + 3 < g1 && ((g * 8) >> 12) == (((g + 3) * 8 + 7) >> 12); g += 4) { NORM_COEF((g * 8) >> 12); norm_rows_h<4>(rx, rh, g * 8 + C.wave, 8, A, Bv, lane); }
        for (; g + 1 < g1 && ((g * 8) >> 12) == (((g + 1) * 8 + 7) >> 12); g += 2) { NORM_COEF((g * 8) >> 12); norm_rows_h<2>(rx, rh, g * 8 + C.wave, 8, A, Bv, lane); }
    }
    for (; g < g1; ++g) {
        const int row = g * 8 + C.wave; NORM_COEF(row >> 12);
        norm_row(sx32 ? sx32 + (size_t)row * DM : nullptr, XS + (size_t)row * DM, nullptr, nullptr, H + (size_t)row * DM, A, Bv, lane);
    }
    if (nrows > TX) {
        for (int r = C.wg * NWAVES + C.wave; r < TC; r += G * NWAVES) { NORM_COEF(4);
            norm_row(scx32 ? scx32 + (size_t)r * DM : nullptr, XS + (size_t)(TX + r) * DM, slab ? slab + (size_t)r * DM : nullptr, XS + (size_t)(TX + r) * DM, H + (size_t)(TX + r) * DM, A, Bv, lane); }
    }
#undef NORM_COEF
}
__device__ __forceinline__ void final_phase(const Ctx& C, const h16* XS, const float* gain, float* out) {
    const int lane = fresh_tid() & 63;
    const int gw = C.wg * NWAVES + C.wave, NGW = C.G * NWAVES;
    f32x4 A[8];
#pragma unroll
    for (int j = 0; j < 8; ++j) A[j] = *(const f32x4*)(gain + 4 * lane + 256 * j);
    const __amdgpu_buffer_rsrc_t rx = __builtin_amdgcn_make_buffer_rsrc((void*)XS, 0, TX * DM * 2, 0x00020000), ro = __builtin_amdgcn_make_buffer_rsrc((void*)out, 0, TX * DM * 4, 0x00020000);
    for (int row = gw; row < TX; row += 2 * NGW) {
        const bool two = row + NGW < TX; f32x4 v[2][8];
#pragma unroll
        for (int r = 0; r < 2; ++r) if (r == 0 || two) { const unsigned off = (unsigned)(row + r * NGW) * (DM * 2) + lane * 8;
#pragma unroll
            for (int j = 0; j < 8; ++j) { const v2u w = __builtin_amdgcn_raw_buffer_load_b64(rx, off + 512 * j, 0, 0); v[r][j] = __builtin_convertvector(__builtin_bit_cast(h4, w), f32x4); } }
#pragma unroll
        for (int r = 0; r < 2; ++r) if (r == 0 || two) { float ss = 0.f;
#pragma unroll
            for (int j = 0; j < 8; ++j) ss += (v[r][j].x * v[r][j].x + v[r][j].y * v[r][j].y) + (v[r][j].z * v[r][j].z + v[r][j].w * v[r][j].w);
            const float rs = 1.0f / sqrtf(wave_sum(ss) * (1.0f / DM) + EPS); const unsigned off = (unsigned)(row + r * NGW) * (DM * 4) + lane * 16;
#pragma unroll
            for (int j = 0; j < 4; ++j) { __builtin_amdgcn_raw_buffer_store_b128(__builtin_bit_cast(v4u, v[r][j] * rs * A[j]), ro, off + 1024 * j, 0, 0);
                __builtin_amdgcn_raw_buffer_store_b128(__builtin_bit_cast(v4u, v[r][j + 4] * rs * A[j + 4]), ro, off + 4096 + 1024 * j, 0, 0); } }
    }
}

__device__ __forceinline__ void prep_phase(const Ctx& C, bf16* Z, bf16* CC, const float* qn, const float* kn, const float* rope) {
    const int gw = C.wg * NWAVES + C.wave, NGW = C.G * NWAVES, lane = fresh_tid() & 63, l16 = lane & 15, hq = lane >> 4;
    const bool has1 = hq < 2;
    for (int row = gw; row < T; row += NGW) {
        const bool isx = row < TX; const int t = isx ? (row & (SEQ - 1)) : ((row - TX) & (CTXL - 1)), seqlen = isx ? SEQ : CTXL, seq0 = row - t;
        bf16* zr = Z + (size_t)row * ZW;
        bf16* p0 = zr + ZGQ + hq * 128 + l16 * 8; bf16* p1 = p0 + 512;
        const v4u w0 = *(const v4u*)p0; v4u w1 = (v4u){0u, 0u, 0u, 0u}; if (has1) w1 = *(const v4u*)p1;
        f32x2 cs[4];
#pragma unroll
        for (int jj = 0; jj < 4; ++jj) { const int i = l16 * 4 + jj, pos = isx ? (i < 32 ? (t >> 6) : (t & 63)) : 0;
            cs[jj] = *(const f32x2*)(rope + (pos * 32 + (i & 31)) * 2); }
        const int half = 1 << hq; const int lo = (t - half) > 0 ? (t - half) : 0, hi = (t + half - 1) < (seqlen - 1) ? (t + half - 1) : (seqlen - 1);
        v4u wv[16];
#pragma unroll
        for (int d = 0; d < 16; ++d) { const int tt = t + d - 8; const bool ok = tt >= lo && tt <= hi; wv[d] = *(const v4u*)(Z + (size_t)(seq0 + (ok ? tt : t)) * ZW + ZP + lane * 8); }
        const float* gq = qn + l16 * 8; const float* gk = kn + l16 * 8;
        f32x4 g0a = *(const f32x4*)gq, g0b = *(const f32x4*)(gq + 4), g1a = *(const f32x4*)gk, g1b = *(const f32x4*)(gk + 4);
        asm volatile("" ::: "memory");
#pragma unroll
        for (int jj = 0; jj < 4; ++jj) { cs[jj].x = isx ? cs[jj].x : 1.f; cs[jj].y = isx ? cs[jj].y : 0.f; }
#pragma unroll
        for (int p = 0; p < 2; ++p) {
            if (p == 0 || has1) { const v4u w = p ? w1 : w0; const f32x4 ga = p ? g1a : g0a, gb = p ? g1b : g0b;
                float x[8] = {bflo(w.x), bfhi(w.x), bflo(w.y), bfhi(w.y), bflo(w.z), bfhi(w.z), bflo(w.w), bfhi(w.w)};
                float ss = 0.f;
#pragma unroll
                for (int j = 0; j < 8; ++j) ss += x[j] * x[j];
                ss = row16_sum(ss);
                const float rs = 1.0f / sqrtf(ss * (1.0f / 128.0f) + EPS);
#pragma unroll
                for (int j = 0; j < 4; ++j) { x[j] = x[j] * rs * ga[j]; x[4 + j] = x[4 + j] * rs * gb[j]; }
#pragma unroll
                for (int jj = 0; jj < 4; ++jj) { const float x1 = x[2 * jj], x2 = x[2 * jj + 1]; x[2 * jj] = x1 * cs[jj].x - x2 * cs[jj].y; x[2 * jj + 1] = x1 * cs[jj].y + x2 * cs[jj].x; }
                v4u o; o.x = pk2(x[0], x[1]); o.y = pk2(x[2], x[3]); o.z = pk2(x[4], x[5]); o.w = pk2(x[6], x[7]); *(v4u*)(p ? p1 : p0) = o; } }
        { float sm[8] = {0.f, 0.f, 0.f, 0.f, 0.f, 0.f, 0.f, 0.f};
#pragma unroll
            for (int d = 0; d < 16; ++d) { const int tt = t + d - 8; const float m = (tt >= lo && tt <= hi) ? 1.0f : 0.0f; const v4u w = wv[d];
                sm[0] += m * bflo(w.x); sm[1] += m * bfhi(w.x); sm[2] += m * bflo(w.y); sm[3] += m * bfhi(w.y); sm[4] += m * bflo(w.z); sm[5] += m * bfhi(w.z); sm[6] += m * bflo(w.w); sm[7] += m * bfhi(w.w); }
            const v4u w = wv[8]; const float inv = 1.0f / (float)(hi - lo + 1);
            const float u[8] = {bflo(w.x), bfhi(w.x), bflo(w.y), bfhi(w.y), bflo(w.z), bfhi(w.z), bflo(w.w), bfhi(w.w)};
            v4u o; o.x = pk2(sm[0] * inv - u[0], sm[1] * inv - u[1]); o.y = pk2(sm[2] * inv - u[2], sm[3] * inv - u[3]); o.z = pk2(sm[4] * inv - u[4], sm[5] * inv - u[5]); o.w = pk2(sm[6] * inv - u[6], sm[7] * inv - u[7]);
            *(v4u*)(CC + (size_t)row * DM + lane * 8) = o; }
    }
}

namespace fa {
using bf16x8 = __attribute__((ext_vector_type(8))) short;
using s16x4  = __attribute__((ext_vector_type(4))) short;
using f32x16 = __attribute__((ext_vector_type(16))) float;
using u32x4  = __attribute__((ext_vector_type(4))) unsigned;
constexpr int D = 128, NW = 8, QBLK = 32, KVBLK = 64;
constexpr float SCALE = 0.088388347648318440f, THR = 8.f;
constexpr int SHM_V = KVBLK * D * 2, SHM_K = KVBLK * D * 2, SHM_ATTN = 2 * SHM_V + 2 * SHM_K + NW * 64 * 4;
constexpr int TAB_OFF = 68 * 1024, TAB_ORG = 512, TAB_N = 2048;
constexpr float NEGBIG = -1e30f;
#define KSWZ(row, colB) ((row) * 256 + ((colB) ^ (((row) & 7) << 4)))
#define SBAR() __builtin_amdgcn_sched_barrier(0)
__device__ __forceinline__ int crow(int r, int hi) { return (r & 3) + 8 * (r >> 2) + 4 * hi; }
__device__ __forceinline__ unsigned cvtpk(float lo, float hi) { unsigned r; asm volatile("v_cvt_pk_bf16_f32 %0, %1, %2" : "=v"(r) : "v"(lo), "v"(hi)); return r; }
__device__ __forceinline__ void partialSM(f32x16& p0, f32x16& p1, float& m_reg, float& mn, float& alpha) {
  constexpr float C = SCALE * 1.4426950408889634f;
  float pmax = p0[0];
#pragma unroll
  for (int r = 1; r < 16; ++r) pmax = fmaxf(pmax, p0[r]);
#pragma unroll
  for (int r = 0; r < 16; ++r) pmax = fmaxf(pmax, p1[r]);
  { auto rr = __builtin_amdgcn_permlane32_swap(__float_as_uint(pmax), __float_as_uint(pmax), false, false);
    pmax = fmaxf(__uint_as_float(rr[0]), __uint_as_float(rr[1])); }
  if (__builtin_expect(__all(pmax - m_reg <= THR / SCALE), 1)) { mn = m_reg; alpha = 1.f; }
  else { mn = fmaxf(m_reg, pmax); alpha = __builtin_amdgcn_exp2f((m_reg - mn) * C); m_reg = mn; }
  float mnC = -mn * C;
#pragma unroll
  for (int r = 0; r < 16; ++r) p0[r] = fmaf(p0[r], C, mnC);
#pragma unroll
  for (int r = 0; r < 16; ++r) p1[r] = fmaf(p1[r], C, mnC);
#pragma unroll
  for (int r = 0; r < 16; ++r) p0[r] = __builtin_amdgcn_exp2f(p0[r]);
}
__device__ __forceinline__ void finishSM(f32x16& p0, f32x16& p1, float alpha, float& l_reg, bf16x8& pa0, bf16x8& pa1, bf16x8& pa2, bf16x8& pa3) {
#pragma unroll
  for (int r = 0; r < 16; ++r) p1[r] = __builtin_amdgcn_exp2f(p1[r]);
  float ps = 0;
#pragma unroll
  for (int r = 0; r < 16; ++r) ps += p0[r];
#pragma unroll
  for (int r = 0; r < 16; ++r) ps += p1[r];
  { auto rr = __builtin_amdgcn_permlane32_swap(__float_as_uint(ps), __float_as_uint(ps), false, false);
    ps = __uint_as_float(rr[0]) + __uint_as_float(rr[1]); }
  l_reg = l_reg * alpha + ps;
#define PK4(P, BASE, OUT) do { unsigned a0 = cvtpk(P[BASE + 0], P[BASE + 1]), a1 = cvtpk(P[BASE + 2], P[BASE + 3]);   \
    unsigned b0 = cvtpk(P[BASE + 4], P[BASE + 5]), b1 = cvtpk(P[BASE + 6], P[BASE + 7]);                              \
    auto r0 = __builtin_amdgcn_permlane32_swap(a0, b0, false, false); auto r1 = __builtin_amdgcn_permlane32_swap(a1, b1, false, false); \
    u32x4 w = {r0[0], r1[0], r0[1], r1[1]}; OUT = *reinterpret_cast<bf16x8*>(&w); } while (0)
  PK4(p0, 0, pa0); PK4(p0, 8, pa1); PK4(p1, 0, pa2); PK4(p1, 8, pa3);
#undef PK4
}
__device__ __forceinline__ void qkt(f32x16& p0, f32x16& p1, const char* Ks, const bf16x8* qr, int r32, int hi) {
  p0 = f32x16{}; p1 = f32x16{};
#pragma unroll
  for (int d0 = 0; d0 < 8; ++d0) { int cb = (d0 * 16 + hi * 8) * 2;
    bf16x8 b0 = *reinterpret_cast<const bf16x8*>(Ks + KSWZ(r32, cb));
    bf16x8 b1 = *reinterpret_cast<const bf16x8*>(Ks + KSWZ(32 + r32, cb));
    p0 = __builtin_amdgcn_mfma_f32_32x32x16_bf16(b0, qr[d0], p0, 0, 0, 0);
    p1 = __builtin_amdgcn_mfma_f32_32x32x16_bf16(b1, qr[d0], p1, 0, 0, 0); }
}
__device__ __forceinline__ int v_st(int k, int c) { const int kk = (k & ~0xC) | ((k & 4) << 1) | ((k & 8) >> 1); return ((kk >> 3) * 4 + (c >> 5)) * 512 + ((kk & 7) * 32 + (c & 31)) * 2; }
__device__ __forceinline__ int v_rd_base(int lane) { return ((lane & 3) << 3) | (((lane >> 2) & 3) << 6) | (((lane >> 4) & 1) << 5) | (((lane >> 5) & 1) << 8); }
constexpr int v_rd_off(int d0, int ks, int half) { return d0 * 512 + ks * 4096 + half * 2048; }
template <int OFF> __device__ __forceinline__ s16x4 tr_read(int vb) {
  s16x4 r; asm volatile("ds_read_b64_tr_b16 %0, %1 offset:%2" : "=&v"(r) : "v"(vb), "i"(OFF) : "memory"); return r;
}
template <int D0> __device__ __forceinline__ void pv_one(f32x16& od, int vb, bf16x8 pa0, bf16x8 pa1, bf16x8 pa2, bf16x8 pa3) {
  const s16x4 l0 = tr_read<v_rd_off(D0, 0, 0)>(vb), h0 = tr_read<v_rd_off(D0, 0, 1)>(vb), l1 = tr_read<v_rd_off(D0, 1, 0)>(vb), h1 = tr_read<v_rd_off(D0, 1, 1)>(vb);
  const s16x4 l2 = tr_read<v_rd_off(D0, 2, 0)>(vb), h2 = tr_read<v_rd_off(D0, 2, 1)>(vb), l3 = tr_read<v_rd_off(D0, 3, 0)>(vb), h3 = tr_read<v_rd_off(D0, 3, 1)>(vb);
  asm volatile("s_waitcnt lgkmcnt(0)" ::: "memory"); SBAR();
#define PK(L, H) (bf16x8){L[0], L[1], L[2], L[3], H[0], H[1], H[2], H[3]}
  od = __builtin_amdgcn_mfma_f32_32x32x16_bf16(pa0, PK(l0, h0), od, 0, 0, 0);
  od = __builtin_amdgcn_mfma_f32_32x32x16_bf16(pa1, PK(l1, h1), od, 0, 0, 0);
  od = __builtin_amdgcn_mfma_f32_32x32x16_bf16(pa2, PK(l2, h2), od, 0, 0, 0);
  od = __builtin_amdgcn_mfma_f32_32x32x16_bf16(pa3, PK(l3, h3), od, 0, 0, 0);
#undef PK
}
__device__ __forceinline__ void pv_d0(f32x16* o, int vb, bf16x8 pa0, bf16x8 pa1, bf16x8 pa2, bf16x8 pa3) {
  pv_one<0>(o[0], vb, pa0, pa1, pa2, pa3); pv_one<1>(o[1], vb, pa0, pa1, pa2, pa3); pv_one<2>(o[2], vb, pa0, pa1, pa2, pa3); pv_one<3>(o[3], vb, pa0, pa1, pa2, pa3);
}
struct TileDense { int lat0, nlat, ctx0;
  __device__ __forceinline__ void operator()(int j, int& base, int& hoff) const { base = j < nlat ? lat0 + 64 * j : ctx0 + 64 * (j - nlat); hoff = 32; } };
struct TileNa { int ctx0, loc0;
  __device__ __forceinline__ void operator()(int j, int& base, int& hoff) const { if (j < 4) { base = ctx0 + 64 * j; hoff = 32; } else { base = loc0 + (j - 4) * 128; hoff = 64; } } };
__device__ __forceinline__ void na_bias(f32x16& p0, f32x16& p1, int krow, int kc0, int qr, int qc, int rs, int cs, const float* tab, int hi) {
  const bool rv0 = (unsigned)(krow - rs) < 8u, rv1 = (unsigned)(krow + 1 - rs) < 8u;
  const int cb = kc0 + 4 * hi - cs, ib = (krow - qr + 7) * 31 + (kc0 + 4 * hi - qc + 15);
  const float* t0 = tab + ib;
#pragma unroll
  for (int r = 0; r < 16; ++r) { const int co = (r & 3) + 8 * (r >> 2); const bool cv = (unsigned)(cb + co) < 16u;
    const float b0 = t0[co], b1 = t0[31 + co];
    p0[r] = (rv0 && cv) ? p0[r] + b0 : NEGBIG; p1[r] = (rv1 && cv) ? p1[r] + b1 : NEGBIG; }
}
template <bool NA, class TileF, int SD>
__device__ __forceinline__ void attn_unit(const bf16* __restrict__ Z, bf16* __restrict__ CC, int qcol, int kcol, int vcol, int outcol, int NT, const TileF& TF,
                                          int q0, int nb, int R0, int C0, int kr0, int kc0, char* lds) {
  const int tid = fresh_tid(), wid = tid >> 6, lane = tid & 63, r32 = lane & 31, hi = lane >> 5;
  char* V_lds = lds; char* K_lds = lds + 2 * SHM_V;
  float* ws = (float*)(lds + 2 * SHM_V + 2 * SHM_K) + wid * 64; float* li_l = ws; float* al_l = ws + 32;
  const float* tab = (const float*)(lds + TAB_OFF) + TAB_ORG;
  float m_reg = -1e30f, l_reg = 0; f32x16 o[4] = {}; bf16x8 qr[8];
  const int qg_r = R0 + 2 * wid + (r32 >> 4), qg_c = C0 + (r32 & 15);
  const int myrow = NA ? nb * SEQ + qg_r * 64 + qg_c : q0 + wid * 32 + r32;
  { const bf16* Qw = Z + (size_t)myrow * ZW + qcol + hi * 8;
#pragma unroll
    for (int d0 = 0; d0 < 8; ++d0) qr[d0] = *reinterpret_cast<const bf16x8*>(Qw + d0 * 16); }
  const int sr = tid >> 4, sc = (tid & 15) * 8, vst0 = v_st(sr, sc), vst1 = v_st(32 + sr, sc);
  const int vb0 = (int)(uintptr_t)V_lds + v_rd_base(lane);
  struct { bf16x8 vs0, vs1, ks0, ks1; } sr_[SD];
#define SLOAD(i, j) do { int _b, _h; TF((j), _b, _h); const bf16* _p0 = Z + (size_t)(_b + sr) * ZW + sc; const bf16* _p1 = Z + (size_t)(_b + _h + sr) * ZW + sc; \
    sr_[i].vs0 = *reinterpret_cast<const bf16x8*>(_p0 + vcol); sr_[i].vs1 = *reinterpret_cast<const bf16x8*>(_p1 + vcol); \
    sr_[i].ks0 = *reinterpret_cast<const bf16x8*>(_p0 + kcol); sr_[i].ks1 = *reinterpret_cast<const bf16x8*>(_p1 + kcol); } while (0)
#define SWRITE(b, i) do { *(bf16x8*)(V_lds + (b) * SHM_V + vst0) = sr_[i].vs0; *(bf16x8*)(V_lds + (b) * SHM_V + vst1) = sr_[i].vs1; int kc = sc * 2; \
    *(bf16x8*)(K_lds + (b) * SHM_K + KSWZ(sr, kc)) = sr_[i].ks0; *(bf16x8*)(K_lds + (b) * SHM_K + KSWZ(32 + sr, kc)) = sr_[i].ks1; } while (0)
#define SWAIT() do { if constexpr (SD == 2) asm volatile("s_waitcnt vmcnt(4)" ::: "memory"); else asm volatile("s_waitcnt vmcnt(0)" ::: "memory"); } while (0)
#define RESC(a) do { if (__any((a) < 1.f)) { if (hi == 0) al_l[r32] = (a); asm volatile("s_waitcnt lgkmcnt(0)" ::: "memory"); \
    _Pragma("unroll") for (int d = 0; d < 4; ++d) _Pragma("unroll") for (int r = 0; r < 16; ++r) o[d][r] *= al_l[crow(r, hi)]; } } while (0)
#define BIAS(P0, P1, j) do { if (NA) { if ((j) >= 4) { const int t_ = fresh_tid(), qr_ = R0 + 2 * (t_ >> 6) + ((t_ & 31) >> 4), qc_ = C0 + (t_ & 15); \
    int rs_ = qr_ - 4; rs_ = rs_ < 0 ? 0 : (rs_ > 56 ? 56 : rs_); int cs_ = qc_ - 8; cs_ = cs_ < 0 ? 0 : (cs_ > 48 ? 48 : cs_); \
    na_bias(P0, P1, kr0 + 2 * ((j) - 4), kc0, qr_, qc_, rs_, cs_, tab, (t_ >> 5) & 1); } } } while (0)
  f32x16 pA0, pA1, pB0, pB1; float mnA, mnB, alA = 1.f, alB = 1.f; bf16x8 pa0, pa1, pa2, pa3;
  const int wq_ = R0 + 2 * __builtin_amdgcn_readfirstlane(tid >> 6);
  const int rsl_ = (wq_ - 4) < 0 ? 0 : ((wq_ - 4) > 56 ? 56 : (wq_ - 4)), rsh_ = ((wq_ - 3) < 0 ? 0 : ((wq_ - 3) > 56 ? 56 : (wq_ - 3))) + 7;
#define ACT(j) (!NA || (j) < 4 || ((kr0 + 2 * ((j) - 4) + 1 >= rsl_) && (kr0 + 2 * ((j) - 4) <= rsh_)))
  constexpr int SE = 0, SO = SD - 1;
  SLOAD(SE, 0); asm volatile("s_waitcnt vmcnt(0)" ::: "memory"); SWRITE(0, SE); __syncthreads();
  qkt(pA0, pA1, K_lds, qr, r32, hi); BIAS(pA0, pA1, 0); partialSM(pA0, pA1, m_reg, mnA, alA);
  SLOAD(SO, 1); if constexpr (SD == 2) { if (2 < NT) SLOAD(SE, 2); }
  SWAIT(); SWRITE(1, SO); __syncthreads();
  bool aA = true, aB;
  for (int j = 1; j + 1 < NT; j += 2) {
    aB = ACT(j);
    SBAR(); if (aB) { qkt(pB0, pB1, K_lds + SHM_K, qr, r32, hi); BIAS(pB0, pB1, j); }
    if (aA) finishSM(pA0, pA1, alA, l_reg, pa0, pa1, pa2, pa3); SBAR();
    SLOAD(SO, j + SD); SBAR();
    if (aA) pv_d0(o, vb0, pa0, pa1, pa2, pa3); if (aB) partialSM(pB0, pB1, m_reg, mnB, alB);
    __syncthreads(); SWAIT(); SWRITE(0, SE);
    if (aB) RESC(alB); __syncthreads();
    aA = ACT(j + 1);
    SBAR(); if (aA) { qkt(pA0, pA1, K_lds, qr, r32, hi); BIAS(pA0, pA1, j + 1); }
    if (aB) finishSM(pB0, pB1, alB, l_reg, pa0, pa1, pa2, pa3); SBAR();
    if (SD == 1 || j + 3 < NT) SLOAD(SE, j + 1 + SD); SBAR();
    if (aB) pv_d0(o, vb0 + SHM_V, pa0, pa1, pa2, pa3); if (aA) partialSM(pA0, pA1, m_reg, mnA, alA);
    __syncthreads(); SWAIT(); SWRITE(1, SO);
    if (aA) RESC(alA); __syncthreads();
  }
  aB = ACT(NT - 1);
  SBAR(); if (aB) { qkt(pB0, pB1, K_lds + SHM_K, qr, r32, hi); BIAS(pB0, pB1, NT - 1); }
  if (aA) finishSM(pA0, pA1, alA, l_reg, pa0, pa1, pa2, pa3); SBAR();
  if (aA) pv_d0(o, vb0, pa0, pa1, pa2, pa3); if (aB) partialSM(pB0, pB1, m_reg, mnB, alB);
  __syncthreads(); if (aB) RESC(alB);
  if (aB) { finishSM(pB0, pB1, alB, l_reg, pa0, pa1, pa2, pa3); SBAR();
    pv_d0(o, vb0 + SHM_V, pa0, pa1, pa2, pa3); }
#undef ACT
  if (hi == 0) li_l[r32] = l_reg; asm volatile("s_waitcnt lgkmcnt(0)" ::: "memory");
  float rli[16];
#pragma unroll
  for (int r = 0; r < 16; ++r) rli[r] = __builtin_amdgcn_rcpf(li_l[crow(r, hi)]);
  __syncthreads();
  char* stg = lds + wid * 8192;
#pragma unroll
  for (int r = 0; r < 16; ++r) { const int orow = crow(r, hi);
#pragma unroll
    for (int d0 = 0; d0 < 4; ++d0) *(unsigned short*)(stg + orow * 256 + (d0 * 32 + r32) * 2) = (unsigned short)f2bf(o[d0][r] * rli[r]); }
  asm volatile("s_waitcnt lgkmcnt(0)" ::: "memory");
#pragma unroll
  for (int i = 0; i < 8; ++i) { const int row = (lane >> 4) + 4 * i, ch = lane & 15; const v4u w = *(const v4u*)(stg + row * 256 + ch * 16);
    const int orow = NA ? nb * SEQ + (R0 + 2 * wid + (row >> 4)) * 64 + C0 + (row & 15) : q0 + wid * 32 + row;
    *(v4u*)(CC + (size_t)orow * DM + outcol + ch * 8) = w; }
  __syncthreads();
#undef SLOAD
#undef SWRITE
#undef SWAIT
#undef RESC
#undef BIAS
}
}

__device__ __forceinline__ void dense_attn_units(const Ctx& C, const bf16* Z, bf16* CC, bool with_ctx, char* lds) {
    for (int k = C.wg; k < 256 + 32 * C.G; k += C.G) {
        int u;
        if (k < 256) u = k;
        else { const int v = (k - 256) / C.G; if (!with_ctx || v >= 32) break; if ((144 + v) % C.G != C.wg) continue; u = 256 + v; }
        int b, qcol, kcol, vcol, outcol, NT, q0; fa::TileDense TF;
        if (u < 256) { const int bk = u & 7, idx = u >> 3, kvh = bk & 1, hq = 2 * kvh + (idx >> 4); b = bk >> 1;
            qcol = ZGQ + hq * 128; kcol = ZGK + kvh * 128; vcol = ZGV + kvh * 128; outcol = 512 + hq * 128; NT = 68; q0 = b * SEQ + (idx & 15) * 256; TF = fa::TileDense{b * SEQ, 64, TX + b * CTXL}; }
        else if (u < 272) { const int v = u - 256, hq = v & 3; b = v >> 2;
            qcol = ZGQ + hq * 128; kcol = ZGK + (hq >> 1) * 128; vcol = ZGV + (hq >> 1) * 128; outcol = 512 + hq * 128; NT = 4; q0 = TX + b * CTXL; TF = fa::TileDense{0, 0, TX + b * CTXL}; }
        else { const int v = u - 272, h = v & 3; b = v >> 2;
            qcol = ZNQ + h * 128; kcol = ZNK + h * 128; vcol = ZNV + h * 128; outcol = 1536 + h * 128; NT = 4; q0 = TX + b * CTXL; TF = fa::TileDense{0, 0, TX + b * CTXL}; }
        fa::attn_unit<false, fa::TileDense, 2>(Z, CC, qcol, kcol, vcol, outcol, NT, TF, q0, 0, 0, 0, 0, 0, lds);
    }
}
__device__ __forceinline__ void na_units(const Ctx& C, const bf16* Z, bf16* CC, const float* rpb_l, char* lds) {
    float* tabz = (float*)(lds + fa::TAB_OFF);
    for (int u = C.wg; u < 256; u += C.G) {
        const int patch = u & 15, bh = u >> 4, h = bh & 3, b = bh >> 2, R0 = (patch >> 2) * 16, C0 = (patch & 3) * 16;
        int kr0 = R0 - 4; kr0 = kr0 < 0 ? 0 : (kr0 > 40 ? 40 : kr0); int kc0 = C0 - 8; kc0 = kc0 < 0 ? 0 : (kc0 > 32 ? 32 : kc0);
        { const int tid = fresh_tid();
            float tv[fa::TAB_N / NTHR];
#pragma unroll
            for (int j = 0; j < fa::TAB_N / NTHR; ++j) { const int k = tid + j * NTHR - fa::TAB_ORG; const int kc = k < 0 ? 0 : (k > 15 * 31 - 1 ? 15 * 31 - 1 : k); tv[j] = rpb_l[h * (15 * 31) + kc]; }
            asm volatile("" ::: "memory");
#pragma unroll
            for (int j = 0; j < fa::TAB_N / NTHR; ++j) { const int k = tid + j * NTHR - fa::TAB_ORG; tabz[tid + j * NTHR] = (k >= 0 && k < 15 * 31) ? tv[j] * (1.0f / fa::SCALE) : 0.f; } }
        __syncthreads();
        fa::TileNa TF{TX + b * CTXL, b * SEQ + kr0 * 64 + kc0};
        fa::attn_unit<true, fa::TileNa, 1>(Z, CC, ZNQ + h * 128, ZNK + h * 128, ZNV + h * 128, 1536 + h * 128, 16, TF, 0, b, R0, C0, kr0, kc0, lds);
    }
}

__device__ __forceinline__ void ph_gu(const Ctx& C0_, int step) {
    const Ctx C = fresh_ctx(C0_);
    ArgsP a = fresh_args(); unsigned char* ws = a->ws; const int l = step >> 1, second = step & 1; const bool last = (l == NL - 1);
    const unsigned char* wl = ws + WS_W + (size_t)l * W_LAYER;
    pg8::Dims g{DM, DM, DM}; pg8::DynOrder S; S.so.init((second && last) ? TX : T, NGU, C.G, C.wg); S.nstat = S.so.nwg / C.G - 1; S.heads = dyn_heads(a, step); S.slot = (volatile LAS unsigned*)(C.lds + MISC_OFF) + 26;
    ProbPlain P{(const char*)(ws + WS_H), (const char*)(wl + (second ? WO_GU2 : WO_GU1)), (size_t)256 * DM * 2, (size_t)256 * DM * 2}; EpiSwiglu E{(bf16*)(ws + WS_GU)};
    pg8::gemm_phase<EpiSwiglu, pg8::DynOrder, ProbPlain>(C.lds, g, P, S, E);
    if (step < 3) tail_items(C, dyn_heads(a, step) + 512, TSeg{1, 0, step == 0 ? 48 : (step == 1 ? 144 : 192), step == 1 ? 48 : 32}, TSeg{0, step == 0 ? 0 : 1, step == 1 ? CI_GU1 : CI_D1, step == 1 ? CV_GU : CV_D});
}
__device__ __forceinline__ void resid_gemm(const Ctx& C, int kq, const char* A, const char* B, int K, int ld, bool base_in, int gate_off, float coef, bool with_ctx) {
    for (int pass = 0; pass < (with_ctx ? 2 : 1); ++pass) {
        pg8::Dims g{pass ? K / 4 : K, ld, ld}; pg8::DynOrder S; S.so.init(pass ? 16 * 256 : TX, DM, C.G, C.wg); S.nstat = pass ? 0 : 2; S.ncls = pass ? 0 : 1; S.heads = dyn_heads(fresh_args(), kq) + (pass ? 32 : 0);
        S.slot = (volatile LAS unsigned*)(C.lds + MISC_OFF) + 26;
        ProbSplit P{pass ? A + (size_t)TX * ld * 2 : A, B, (size_t)256 * ld * 2, (size_t)256 * ld * 2, pass ? 3 : 0xFFFF, pass ? 2 : 16, (size_t)(K / 4) * 2};
        EpiResid E{gate_off, coef, (base_in ? 1 : 0) | (pass ? 2 : 0)};
        pg8::gemm_phase<EpiResid, pg8::DynOrder, ProbSplit>(C.lds, g, P, S, E);
    }
}
__device__ __forceinline__ void ph_inft(const Ctx& C0_, int l) {
    const Ctx C = fresh_ctx(C0_);
    ArgsP a = fresh_args(); unsigned char* ws = a->ws; const unsigned char* wl = ws + WS_W + (size_t)l * W_LAYER;
    pg8::Dims g{DM, DM, DM}; pg8::DynOrder S; S.so.init(T, NIN, C.G, C.wg); S.nstat = S.so.nwg / C.G - 1; S.heads = dyn_heads(a, 8 + l); S.slot = (volatile LAS unsigned*)(C.lds + MISC_OFF) + 26;
    ProbInFt P{(const char*)(ws + WS_H), (const char*)(wl + WO_IN)}; EpiZ E{(bf16*)(ws + WS_Z), (bf16*)(ws + WS_ABT), (bf16*)(ws + WS_ABTC)};
    pg8::gemm_phase<EpiZ, pg8::DynOrder, ProbInFt>(C.lds, g, P, S, E);
    if (l == 0) tail_items(C, dyn_heads(a, 8 + l) + 512, TSeg{1, 0, 80, 64}, TSeg{0, 0, CI_GU2, 2 * CV_GU});
    else tail_items(C, dyn_heads(a, 8 + l) + 512, TSeg{0, 1, CI_GU2, 2 * CV_GU}, TSeg{0, 1, CI_D2, CV_D});
}
struct cpx { float r, i; };
__device__ __forceinline__ cpx cadd(cpx a, cpx b) { return cpx{a.r + b.r, a.i + b.i}; }
__device__ __forceinline__ cpx csub(cpx a, cpx b) { return cpx{a.r - b.r, a.i - b.i}; }
__device__ __forceinline__ cpx cmul(cpx a, cpx w) { return cpx{a.r * w.r - a.i * w.i, a.r * w.i + a.i * w.r}; }
__device__ __forceinline__ void dft4(cpx x0, cpx x1, cpx x2, cpx x3, cpx& y0, cpx& y1, cpx& y2, cpx& y3) {
    const cpx t0 = cadd(x0, x2), t1 = csub(x0, x2), t2 = cadd(x1, x3), t3 = csub(x1, x3);
    y0 = cadd(t0, t2); y2 = csub(t0, t2); y1 = cpx{t1.r + t3.i, t1.i - t3.r}; y3 = cpx{t1.r - t3.i, t1.i + t3.r};
}
__device__ __forceinline__ constexpr float cos16(int m) {
    return m == 0 ? 1.f : m == 1 ? 0.92387953251128674f : m == 2 ? 0.70710678118654752f : m == 3 ? 0.38268343236508977f : m == 4 ? 0.f : m == 5 ? -0.38268343236508977f : m == 6 ? -0.70710678118654752f :
           m == 7 ? -0.92387953251128674f : m == 8 ? -1.f : m == 9 ? -0.92387953251128674f : m == 10 ? -0.70710678118654752f : m == 11 ? -0.38268343236508977f : m == 12 ? 0.f : m == 13 ? 0.38268343236508977f :
           m == 14 ? 0.70710678118654752f : 0.92387953251128674f;
}
__device__ __forceinline__ void fft16(const cpx (&z)[16], int n2, float (&oP)[16], float (&oQ)[16]) {
    cpx V[4][4];
#pragma unroll
    for (int bb = 0; bb < 4; ++bb) { dft4(z[bb], z[4 + bb], z[8 + bb], z[12 + bb], V[bb][0], V[bb][1], V[bb][2], V[bb][3]);
#pragma unroll
        for (int cc = 1; cc < 4; ++cc) if (bb) V[bb][cc] = cmul(V[bb][cc], cpx{cos16((bb * cc) & 15), -cos16((bb * cc + 12) & 15)}); }
    cpx Y[16];
#pragma unroll
    for (int cc = 0; cc < 4; ++cc) dft4(V[0][cc], V[1][cc], V[2][cc], V[3][cc], Y[cc], Y[cc + 4], Y[cc + 8], Y[cc + 12]);
    float s1, c1; sincospif((float)n2 * (1.0f / 2048.0f), &s1, &c1);
    const cpx t1{c1, -s1}; cpx tk{0.25f, 0.f};
#pragma unroll
    for (int k1 = 0; k1 < 16; ++k1) { const cpx y = cmul(Y[k1], tk); oP[k1] = y.r; oQ[k1] = -y.i; tk = cmul(tk, t1); }
}
__device__ __forceinline__ void fft_stage1(const Ctx& C, bf16* ABT) {
    const int tid = fresh_tid();
    for (int it = C.wg * NTHR + tid; it < 512 * NB * 128; it += C.G * NTHR) {
        const int n2 = (it & 127) * 2, b = (it >> 7) & 3, c = it >> 9;
        bf16* base = ABT + (size_t)c * LDT + b * (2 * SEQ) + n2;
        unsigned rp[16], rq[16];
#pragma unroll
        for (int n1 = 0; n1 < 16; ++n1) { rp[n1] = *(const unsigned*)(base + 256 * n1); rq[n1] = *(const unsigned*)(base + SEQ + 256 * n1); }
        asm volatile("" ::: "memory");
        cpx z[16]; float aP[16], aQ[16], bP[16], bQ[16];
#pragma unroll
        for (int n1 = 0; n1 < 16; ++n1) { z[n1].r = bflo(rp[n1]); z[n1].i = -bflo(rq[n1]); }
        fft16(z, n2, aP, aQ);
#pragma unroll
        for (int n1 = 0; n1 < 16; ++n1) { z[n1].r = bfhi(rp[n1]); z[n1].i = -bfhi(rq[n1]); }
        fft16(z, n2 + 1, bP, bQ);
#pragma unroll
        for (int k1 = 0; k1 < 16; ++k1) { *(unsigned*)(base + 512 * k1) = pk2(aP[k1], bP[k1]); *(unsigned*)(base + 512 * k1 + 256) = pk2(aQ[k1], bQ[k1]); }
    }
}
__device__ __forceinline__ void ph_prep(const Ctx& C0_, int l) {
    const Ctx C = fresh_ctx(C0_);
    ArgsP a = fresh_args(); unsigned char* ws = a->ws;
    prep_phase(C, (bf16*)(ws + WS_Z), (bf16*)(ws + WS_CC), a->q_norm + (size_t)l * 128, a->k_norm + (size_t)l * 128, (const float*)(ws + WS_ROPE));
}
__device__ __forceinline__ void ph_prep_fft(const Ctx& C0_, int l) {
    const Ctx C = fresh_ctx(C0_);
    ArgsP a = fresh_args(); unsigned char* ws = a->ws;
    fft_stage1(C, (bf16*)(ws + WS_ABT));
}
__device__ __forceinline__ void ph_dft(const Ctx& C0_, int l) {
    const Ctx C = fresh_ctx(C0_);
    ArgsP a = fresh_args(); unsigned char* ws = a->ws; const bool last = (l == NL - 1);
    bf16* CC = (bf16*)(ws + WS_CC);
    for (int pass = 0; pass < (last ? 1 : 2); ++pass) {
        pg8::Dims g{2 * CTXL, 2 * CTXL, pass ? LDTC : LDT};
        pg8::StaticOrder S; S.init(pass ? TC : 64 * 256, 512, C.G, pass ? (C.wg + C.G - 136 % C.G) % C.G : C.wg);
        ProbDft P = pass ? ProbDft{(const char*)(ws + WS_DFTC), (const char*)(ws + WS_ABTC), 0, 0, (size_t)2 * CTXL * 2, 0, (size_t)256 * LDTC * 2}
                         : ProbDft{(const char*)(ws + WS_DFTC), (const char*)(ws + WS_ABT), 4, 15, (size_t)2 * SEQ * 2, (size_t)512 * 2, (size_t)256 * LDT * 2};
        EpiDft E = pass ? EpiDft{CC + 1024, DM, TX, 0, 0, CTXL, 1} : EpiDft{CC + 1024, DM, 0, 4, 15, SEQ, 16};
        pg8::gemm_phase<EpiDft, pg8::StaticOrder, ProbDft>(C.lds, g, P, S, E);
    }
}
__device__ __forceinline__ void ph_attn(const Ctx& C0_, int l, char* lds) {
    const Ctx C = fresh_ctx(C0_);
    ArgsP a = fresh_args(); unsigned char* ws = a->ws; const bool last = (l == NL - 1);
    dense_attn_units(C, (const bf16*)(ws + WS_Z), (bf16*)(ws + WS_CC), !last, lds);
}
__device__ __forceinline__ void ph_na(const Ctx& C0_, int l, char* lds) {
    const Ctx C = fresh_ctx(C0_);
    ArgsP a = fresh_args(); unsigned char* ws = a->ws;
    na_units(C, (const bf16*)(ws + WS_Z), (bf16*)(ws + WS_CC), a->na_rpb + (size_t)l * 4 * 15 * 31, lds);
}
__device__ __forceinline__ void ph_norm(const Ctx& C0_, int blk) {
    const Ctx C = fresh_ctx(C0_);
    ArgsP a = fresh_args(); unsigned char* ws = a->ws; const int l = blk / 3, kind = blk % 3; const bool last = (l == NL - 1);
    h16* XS = (h16*)(ws + WS_XS); const float* modl = (const float*)(ws + WS_MODV) + (size_t)l * 5 * NMOD;
    const bool from_in = (blk == 0), ctx_in = (blk <= 1);
    const float* sx = from_in ? a->x : nullptr; const float* scx = ctx_in ? a->ctx : nullptr;
    const bool fold = (blk != 0) && !(kind == 2 && last);
    const float* gain = (kind == 0 ? a->ffn1_norm : (kind == 1 ? a->mix_norm : a->ffn2_norm)) + (size_t)l * DM;
    norm_phase(C, sx, scx, XS, gain, modl, 3 * kind, 3 * kind + 1, (kind == 2 && last) ? TX : T, (bf16*)(ws + WS_H), fold ? (const h16*)(ws + WS_SLAB) : nullptr);
}
__device__ __forceinline__ void ph_resid(const Ctx& C0_, int blk) {
    const Ctx C = fresh_ctx(C0_);
    ArgsP a = fresh_args(); unsigned char* ws = a->ws; const int l = blk / 3, kind = blk % 3; const bool last = (l == NL - 1);
    const unsigned char* wl = ws + WS_W + (size_t)l * W_LAYER;
    const bool mix = (kind == 1);
    const char* A = (const char*)(ws + (mix ? WS_CC : WS_GU)); const char* B = (const char*)(wl + (mix ? WO_OUT : (kind == 0 ? WO_D1 : WO_D2)));
    const bool with_ctx = mix ? !last : !(kind == 2 && last);
    resid_gemm(C, 10 + blk, A, B, mix ? DM : FF, mix ? DM : FFP, blk == 0, l * 5 * NMOD + (3 * kind + 2) * DM, mix ? 1.0f : 0.5f, with_ctx);
    unsigned* th = dyn_heads(a, 10 + blk) + 512;
    if (blk == 0) tail_items(C, th, TSeg{2, 0, 0, 96}, TSeg{0, 0, CI_IN, CV_IN + CV_OUT});
    else if (blk == 1) tail_items(C, th, TSeg{0, 0, CI_D2, CV_D}, TSeg{0, 0, 0, 0});
    else if (blk == 2) tail_items(C, th, TSeg{2, 1, 96, 96}, TSeg{0, 1, CI_GU1 + CV_GU, CV_GU});
    else if (blk == 3) tail_items(C, th, TSeg{1, 1, 144 + 80, 64}, TSeg{0, 1, CI_IN, CV_IN + CV_OUT});
}

#ifndef PROBE_MASK
#define PROBE_MASK 0
#endif
#define TP_BEGIN(id) do { if ((PROBE_MASK >> (id)) & 1) { if (blockIdx.x == 0 && threadIdx.x == 0) { const unsigned long long t = __builtin_amdgcn_s_memrealtime(); MISC[16] = (unsigned)t; MISC[17] = (unsigned)(t >> 32); } } } while (0)
#define TP_END(id) do { if ((PROBE_MASK >> (id)) & 1) { if (blockIdx.x == 0 && threadIdx.x == 0) { const unsigned long long t0 = ((unsigned long long)MISC[17] << 32) | MISC[16]; \
    const unsigned long long acc = (((unsigned long long)MISC[19] << 32) | MISC[18]) + (__builtin_amdgcn_s_memrealtime() - t0); MISC[18] = (unsigned)acc; MISC[19] = (unsigned)(acc >> 32); } } } while (0)
__global__ void __launch_bounds__(NTHR, 2) dit_fwd(Args a_unused) {
    extern __shared__ __attribute__((aligned(16))) unsigned char lds_raw[];
    Ctx C; C.lds = (LAS unsigned char*)lds_raw; C.wave = __builtin_amdgcn_readfirstlane((int)threadIdx.x >> 6); C.wg = blockIdx.x; C.G = gridDim.x;
    volatile LAS unsigned* MISC = (volatile LAS unsigned*)(C.lds + MISC_OFF);
    for (int u = threadIdx.x; u < (LDS_BYTES - LDSCTL_OFF) / 4; u += NTHR) ((LAS unsigned*)(C.lds + LDSCTL_OFF))[u] = 0u;
    __syncthreads();
    XcdBarrier bar = xcd_barrier_post((unsigned*)(fresh_args()->ws + WS_CTL) + CW_BAR, MISC + 8);

    TP_BEGIN(0); prologue_phase(C, fresh_args()); xcd_barrier(bar); TP_END(0);

    for (int blk = 0; blk < 3 * NL; ++blk) {
        const int l = blk / 3, kind = blk % 3;
        TP_BEGIN(1); ph_norm(C, blk); xcd_barrier(bar); TP_END(1);
        if (kind != 1) { TP_BEGIN(2); ph_gu(C, 2 * l + (kind == 2)); xcd_barrier(bar); TP_END(2); }
        else {
            TP_BEGIN(5); ph_inft(C, l);     xcd_barrier(bar); TP_END(5);
            TP_BEGIN(6); TP_BEGIN(8); ph_prep(C, l); TP_END(8); TP_BEGIN(9); ph_prep_fft(C, l); TP_END(9); xcd_barrier(bar); TP_END(6);
            TP_BEGIN(7); ph_dft(C, l); ph_attn(C, l, (char*)lds_raw); ph_na(C, l, (char*)lds_raw); xcd_barrier(bar); TP_END(7);
        }
        TP_BEGIN(3); ph_resid(C, blk); xcd_barrier(bar); TP_END(3);
    }
    { ArgsP a = fresh_args(); final_phase(C, (const h16*)(a->ws + WS_XS), a->final_norm, a->out); }
    if (PROBE_MASK) { if (blockIdx.x == 0 && threadIdx.x == 0) { const unsigned long long acc = ((unsigned long long)MISC[19] << 32) | MISC[18], t0 = __builtin_amdgcn_s_memrealtime();
        while (__builtin_amdgcn_s_memrealtime() - t0 < acc) __builtin_amdgcn_s_sleep(8); } }
}

extern "C" void kernel_launch(void* const* d_in, const int* in_sizes, int n_in, void* d_out, int out_size, void* d_ws, size_t ws_size, hipStream_t stream) {
    static int grid = 0;
    if (grid == 0) {
        if (n_in != 24 || in_sizes[0] != TX * DM || out_size != TX * DM || ws_size < WS_END) { fprintf(stderr, "kernel_launch: shape/workspace mismatch (n_in %d, in0 %d, out %d, ws %zu < %zu)\n", n_in, n_in > 0 ? in_sizes[0] : -1, out_size, ws_size, (size_t)WS_END); grid = -1; return; }
        int dev = 0, cus = 0, per_cu = 0;
        if (hipGetDevice(&dev) != hipSuccess || hipDeviceGetAttribute(&cus, hipDeviceAttributeMultiprocessorCount, dev) != hipSuccess) { grid = -1; return; }
        if (hipFuncSetAttribute((const void*)dit_fwd, hipFuncAttributeMaxDynamicSharedMemorySize, LDS_BYTES) != hipSuccess) { fprintf(stderr, "kernel_launch: hipFuncSetAttribute failed\n"); grid = -1; return; }
        if (hipOccupancyMaxActiveBlocksPerMultiprocessor(&per_cu, (const void*)dit_fwd, NTHR, LDS_BYTES) != hipSuccess || per_cu < 1) fprintf(stderr, "kernel_launch: occupancy query reports %d\n", per_cu);
        (void)hipGetLastError();
        grid = cus;
    }
    if (grid < 0) return;
    if (hipMemsetAsync((char*)d_ws + WS_CTL, 0, CTL_ZERO_BYTES, stream) != hipSuccess) return;
    Args a{};
    const float* const* in = (const float* const*)d_in;
    a.x = in[0]; a.c = in[1]; a.ctx = in[2]; a.c_ctx = in[3]; a.w_mod = in[4]; a.b_mod = in[5]; a.ffn1_norm = in[6]; a.ffn1_gate = in[7]; a.ffn1_up = in[8]; a.ffn1_down = in[9];
    a.mix_norm = in[10]; a.w_in = in[11]; a.w_out = in[12]; a.pool_w = in[13]; a.pool_scale = in[14]; a.q_norm = in[15]; a.k_norm = in[16]; a.fnet_w = in[17]; a.na_rpb = in[18];
    a.ffn2_norm = in[19]; a.ffn2_gate = in[20]; a.ffn2_up = in[21]; a.ffn2_down = in[22]; a.final_norm = in[23];
    a.out = (float*)d_out; a.ws = (unsigned char*)d_ws;
    hipLaunchKernelGGL(dit_fwd, dim3(grid), dim3(NTHR), LDS_BYTES, stream, a);
    const hipError_t le = hipPeekAtLastError();
    if (le != hipSuccess) fprintf(stderr, "kernel_launch: launch failed: %s\n", hipGetErrorName(le));
}
```

```cpp
#include <hip/hip_runtime.h>
#include <cstdio>
#include <cstdint>

namespace pg8 {
#define PG8_LAS __attribute__((address_space(3)))
typedef unsigned short bf16_t;
typedef short bf16x8 __attribute__((ext_vector_type(8)));
typedef float f32x4 __attribute__((ext_vector_type(4)));
typedef unsigned u32x4 __attribute__((ext_vector_type(4)));
constexpr int BM = 256, BK = 64, HALF = 128, HTB = HALF * BK * 2, STAGE_BYTES = 8 * HTB, NXCD = 8, WGM = 8;

__host__ __device__ __forceinline__ int lds_byte(int r, int c) { const int st = (r >> 4) * 2 + (c >> 5), rr = r & 15, cc = c & 31, ob = rr * 64 + cc * 2; return st * 1024 + (ob ^ (((ob >> 9) & 1) << 5)); }
__host__ __device__ __forceinline__ void stage_rc(int b, int& R, int& C) { const int st = b / 1024, sb = b % 1024, swz = sb ^ (((sb >> 9) & 1) << 5); R = (st >> 1) * 16 + swz / 64; C = (st & 1) * 32 + (swz % 64) / 2; }
__host__ __device__ __forceinline__ int perm32(int rho) { const int n = rho >> 4, i = rho & 15; return 8 * (i >> 2) + 4 * n + (i & 3); }

struct Unit { int pm, pn; };
struct Dims { int K, lda, ldb; };
__device__ __forceinline__ int fresh_tid_pg8() { int t = threadIdx.x; asm volatile("" : "+v"(t)); return t; }

struct StaticOrder {
    int nM, nN, nwg, G, c;
    __host__ __device__ void init(int M, int N, int G_, int c_) { nM = M / BM; nN = N / BM; nwg = nM * nN; G = G_; c = c_; }
    __host__ __device__ bool next(int i, Unit& u) const { return at((long)i * G + c, u); }
    __host__ __device__ bool at(long L, Unit& u) const {
        if (L >= nwg) return false;
        int wgid = (int)L; { const int q = nwg / NXCD, r = nwg % NXCD, xcd = wgid % NXCD, off = wgid / NXCD; wgid = (xcd < r ? xcd * (q + 1) : r * (q + 1) + (xcd - r) * q) + off; }
        const int nig = WGM * nN, gid = wgid / nig, fm = gid * WGM, gsz = (nM - fm) < WGM ? (nM - fm) : WGM;
        u.pm = fm + ((wgid % nig) % gsz); u.pn = (wgid % nig) / gsz; return true;
    }
};

struct DynOrder {
    StaticOrder so; int nstat; unsigned* heads; volatile PG8_LAS unsigned* slot; int ncls = 1, gtail = 64;
    __device__ __forceinline__ bool next(int i, Unit& u) const {
        if (i < nstat || (so.G & 7)) return so.at((long)i * so.G + so.c, u);
        if (threadIdx.x == 0) {
            const unsigned one = 1u; long lsplit = (long)(nstat + ncls) * so.G; if (ncls && so.nwg - gtail > lsplit) lsplit = so.nwg - gtail;
            bool ex = (ncls == 0) || ((i > nstat) && slot[1] != 0u); if (i == nstat) slot[1] = 0u;
            long L = so.nwg;
            if (!ex) { unsigned m_; unsigned* hp = heads + 64 * (so.c & 7);
                asm volatile("global_atomic_add %0, %1, %2, off sc0\n\ts_waitcnt vmcnt(0)" : "=&v"(m_) : "v"(hp), "v"(one) : "memory");
                L = (long)nstat * so.G + 8l * m_ + (so.c & 7); if (L >= lsplit) { slot[1] = 1u; ex = true; L = so.nwg; } }
            if (ex && lsplit < so.nwg) { unsigned g_; unsigned* hp = heads + 768;
                asm volatile("global_atomic_add %0, %1, %2, off sc0\n\ts_waitcnt vmcnt(0)" : "=&v"(g_) : "v"(hp), "v"(one) : "memory");
                L = lsplit + g_; }
            *slot = (unsigned)(L < so.nwg ? L : so.nwg); asm volatile("s_waitcnt lgkmcnt(0)" ::: "memory"); }
        asm volatile("" ::: "memory"); __builtin_amdgcn_s_barrier(); asm volatile("" ::: "memory");
        const unsigned Lc = *slot;
        return so.at((long)Lc, u);
    }
};
__device__ __forceinline__ unsigned cvt_pk_bf16(float lo, float hi) { unsigned r; asm volatile("v_cvt_pk_bf16_f32 %0, %1, %2" : "=v"(r) : "v"(lo), "v"(hi)); return r; }

template <class Epi, class Sched, class Prob, bool ALIGN_EPI = true, bool SP2 = true>
__device__ __forceinline__ void gemm_phase(PG8_LAS unsigned char* lds, const Dims g, const Prob& P, const Sched& S, const Epi& E) {
    const int tid = fresh_tid_pg8(), wid = __builtin_amdgcn_readfirstlane(tid >> 6), lane = tid & 63, wr = wid >> 2, wc = wid & 3, fr = lane & 15, fq = lane >> 4;
    const int K = g.K, nt = K / BK;
    unsigned voffA[2], voffB[2];
#pragma unroll
    for (int i = 0; i < 2; ++i) { int R, C; stage_rc(tid * 16 + i * 8192, R, C); const int Rb = Epi::PERM ? ((R & ~31) + perm32(R & 31)) : R;
        voffA[i] = (unsigned)(R * g.lda + C) * 2u; voffB[i] = (unsigned)(Rb * g.ldb + C) * 2u; }
    const size_t kstep = (size_t)(BK * 2);
    const size_t hstepA = (size_t)HALF * g.lda * 2, hstepB = (size_t)HALF * g.ldb * 2;
    const unsigned ldsw = (unsigned)wid * 1024u;
    const int aoff = lds_byte(wr * 64 + fr, fq * 8), boff = lds_byte(wc * 32 + fr, fq * 8);
#define PG8_SA(b, h) (((b) * 2 + (h)) * HTB)
#define PG8_SB(b, h) ((4 + (b) * 2 + (h)) * HTB)
#define PG8_STAGE(bufoff, gbase, voff) do { _Pragma("unroll") for (int _i = 0; _i < 2; ++_i) \
        __builtin_amdgcn_global_load_lds((const unsigned*)((const char*)(gbase) + (voff)[_i]), (PG8_LAS unsigned*)(lds + (bufoff) + ldsw + _i * 8192), 16, 0, 0); } while (0)
#define PG8_LDA(dst, b, h) do { _Pragma("unroll") for (int m = 0; m < 4; ++m) _Pragma("unroll") for (int k = 0; k < 2; ++k) dst[m][k] = *(const PG8_LAS bf16x8*)(lds + PG8_SA(b, h) + aoff + m * 2048 + k * 1024); } while (0)
#define PG8_LDB(dst, b, h) do { _Pragma("unroll") for (int n = 0; n < 2; ++n) _Pragma("unroll") for (int k = 0; k < 2; ++k) dst[n][k] = *(const PG8_LAS bf16x8*)(lds + PG8_SB(b, h) + boff + n * 2048 + k * 1024); } while (0)
#define PG8_MMA(ai, bj, At, Bt) do { __builtin_amdgcn_s_setprio(1); _Pragma("unroll") for (int m = 0; m < 4; ++m) _Pragma("unroll") for (int n = 0; n < 2; ++n) _Pragma("unroll") for (int k = 0; k < 2; ++k) \
        acc[ai][bj][m][n] = __builtin_amdgcn_mfma_f32_16x16x32_bf16(Bt[n][k], At[m][k], acc[ai][bj][m][n], 0, 0, 0); __builtin_amdgcn_s_setprio(0); } while (0)
#define PG8_WAIT_V(n) asm volatile("s_waitcnt vmcnt(" #n ")" ::: "memory")
#define PG8_WAIT_L(n) asm volatile("s_waitcnt lgkmcnt(" #n ")" ::: "memory")
#define PG8_BAR __builtin_amdgcn_s_barrier()
#define PG8_SCHED __builtin_amdgcn_sched_barrier(0)
    Unit cur, nxt; int ui = 0;
    if (!S.next(0, cur)) return;
    f32x4 acc[2][2][4][2];
#pragma unroll
    for (int a = 0; a < 2; ++a)
#pragma unroll
        for (int b = 0; b < 2; ++b)
#pragma unroll
            for (int m = 0; m < 4; ++m)
#pragma unroll
                for (int n = 0; n < 2; ++n) acc[a][b][m][n] = (f32x4){0.f, 0.f, 0.f, 0.f};
    bf16x8 At[4][2], B0[2][2], B1[2][2];
    const char* cA = P.a_panel(cur); const char* cB = P.b_panel(cur);
    if constexpr (SP2) {
        PG8_STAGE(PG8_SB(0, 0), cB, voffB); PG8_STAGE(PG8_SB(0, 1), cB + hstepB, voffB); PG8_STAGE(PG8_SA(0, 0), cA, voffA); PG8_STAGE(PG8_SA(0, 1), cA + hstepA, voffA);
        if (wr == 1) PG8_BAR;
        PG8_WAIT_V(2); PG8_BAR;
        PG8_STAGE(PG8_SB(1, 0), cB + kstep, voffB); PG8_STAGE(PG8_SA(1, 0), cA + kstep, voffA); PG8_STAGE(PG8_SB(1, 1), cB + hstepB + kstep, voffB);
        PG8_WAIT_V(6); PG8_BAR;
    } else {
        PG8_STAGE(PG8_SB(0, 0), cB, voffB); PG8_STAGE(PG8_SA(0, 0), cA, voffA); PG8_STAGE(PG8_SB(0, 1), cB + hstepB, voffB); PG8_STAGE(PG8_SA(0, 1), cA + hstepA, voffA);
        if (wr == 1) PG8_BAR;
        PG8_WAIT_V(4); PG8_BAR;
        PG8_STAGE(PG8_SB(1, 0), cB + kstep, voffB); PG8_STAGE(PG8_SA(1, 0), cA + kstep, voffA); PG8_STAGE(PG8_SB(1, 1), cB + hstepB + kstep, voffB);
        PG8_WAIT_V(6); PG8_BAR;
    }
    for (;;) {
        const bool has_next = S.next(ui + 1, nxt);
        const char* nA = has_next ? P.a_panel(nxt) : cA; const char* nB = has_next ? P.b_panel(nxt) : cB;
        for (int t = 0; t < nt; t += 2) {
            const bool last = (t == nt - 2);
            const char* a1 = cA + (size_t)(t + 1) * kstep;
            const char* a2 = last ? nA : cA + (size_t)(t + 2) * kstep; const char* b2 = last ? nB : cB + (size_t)(t + 2) * kstep;
            const char* a3 = a2 + kstep; const char* b3 = b2 + kstep;
            if constexpr (SP2) {
            PG8_LDB(B0, 0, 0); PG8_LDB(B1, 0, 1); PG8_SCHED; PG8_LDA(At, 0, 0); PG8_STAGE(PG8_SA(1, 1), a1 + hstepA, voffA);
            PG8_WAIT_V(8); PG8_WAIT_L(0); PG8_BAR; PG8_MMA(0, 0, At, B0); PG8_MMA(0, 1, At, B1); PG8_BAR; PG8_SCHED;
            PG8_LDA(At, 0, 1); PG8_STAGE(PG8_SB(0, 0), b2, voffB); PG8_STAGE(PG8_SB(0, 1), b2 + hstepB, voffB); PG8_STAGE(PG8_SA(0, 0), a2, voffA);
            PG8_WAIT_V(8); PG8_WAIT_L(0); PG8_BAR; PG8_MMA(1, 0, At, B0); PG8_MMA(1, 1, At, B1); PG8_BAR; PG8_SCHED;
            PG8_LDB(B0, 1, 0); PG8_LDB(B1, 1, 1); PG8_SCHED; PG8_LDA(At, 1, 0); PG8_STAGE(PG8_SA(0, 1), a2 + hstepA, voffA);
            PG8_WAIT_V(8); PG8_WAIT_L(0); PG8_BAR; PG8_MMA(0, 0, At, B0); PG8_MMA(0, 1, At, B1); PG8_BAR; PG8_SCHED;
            PG8_LDA(At, 1, 1); PG8_STAGE(PG8_SB(1, 0), b3, voffB); PG8_STAGE(PG8_SB(1, 1), b3 + hstepB, voffB); PG8_STAGE(PG8_SA(1, 0), a3, voffA);
            PG8_WAIT_V(8); PG8_WAIT_L(0); PG8_BAR; PG8_MMA(1, 0, At, B0); PG8_MMA(1, 1, At, B1); PG8_BAR; PG8_SCHED;
            } else {
            PG8_LDB(B0, 0, 0); PG8_SCHED; PG8_LDA(At, 0, 0); PG8_STAGE(PG8_SA(1, 1), a1 + hstepA, voffA);
            PG8_WAIT_L(8); PG8_BAR; PG8_WAIT_L(0); PG8_MMA(0, 0, At, B0); PG8_BAR; PG8_SCHED;
            PG8_LDB(B1, 0, 1); PG8_STAGE(PG8_SB(0, 0), b2, voffB);
            PG8_BAR; PG8_WAIT_L(0); PG8_MMA(0, 1, At, B1); PG8_BAR;
            PG8_LDA(At, 0, 1); PG8_STAGE(PG8_SA(0, 0), a2, voffA);
            PG8_BAR; PG8_WAIT_L(0); PG8_MMA(1, 0, At, B0); PG8_BAR; PG8_SCHED;
            PG8_STAGE(PG8_SB(0, 1), b2 + hstepB, voffB);
            PG8_WAIT_V(6); PG8_BAR; PG8_MMA(1, 1, At, B1); PG8_BAR;
            PG8_LDB(B0, 1, 0); PG8_SCHED; PG8_LDA(At, 1, 0); PG8_STAGE(PG8_SA(0, 1), a2 + hstepA, voffA);
            PG8_WAIT_L(8); PG8_BAR; PG8_WAIT_L(0); PG8_MMA(0, 0, At, B0); PG8_BAR; PG8_SCHED;
            PG8_LDB(B1, 1, 1); PG8_STAGE(PG8_SB(1, 0), b3, voffB);
            PG8_BAR; PG8_WAIT_L(0); PG8_MMA(0, 1, At, B1); PG8_BAR;
            PG8_LDA(At, 1, 1); PG8_STAGE(PG8_SA(1, 0), a3, voffA);
            PG8_BAR; PG8_WAIT_L(0); PG8_MMA(1, 0, At, B0); PG8_BAR; PG8_SCHED;
            PG8_STAGE(PG8_SB(1, 1), b3 + hstepB, voffB);
            PG8_WAIT_V(6); PG8_BAR; PG8_MMA(1, 1, At, B1); PG8_BAR;
            }
        }
        if constexpr (ALIGN_EPI) { if (wr == 0) PG8_BAR; }
        E(acc, cur, wr, wc, fr, fq);
        if (!has_next) break;
#pragma unroll
        for (int a = 0; a < 2; ++a)
#pragma unroll
            for (int b = 0; b < 2; ++b)
#pragma unroll
                for (int m = 0; m < 4; ++m)
#pragma unroll
                    for (int n = 0; n < 2; ++n) acc[a][b][m][n] = (f32x4){0.f, 0.f, 0.f, 0.f};
        cur = nxt; cA = nA; cB = nB; ++ui;
        if constexpr (ALIGN_EPI) { if (wr == 1) PG8_BAR; }
    }
    PG8_WAIT_V(0);
    if constexpr (!ALIGN_EPI) { if (wr == 0) PG8_BAR; }
    PG8_BAR;
#undef PG8_SA
#undef PG8_SB
#undef PG8_STAGE
#undef PG8_LDA
#undef PG8_LDB
#undef PG8_MMA
#undef PG8_WAIT_V
#undef PG8_WAIT_L
#undef PG8_BAR
#undef PG8_SCHED
}
}

constexpr int NWAVES = 8, NTHR = 512;
constexpr int NB = 4, SEQ = 4096, CTXL = 256, DM = 2048, FF = 5632, NGU = 2 * FF, NL = 2;
constexpr int FFP = FF + 64;
constexpr int TX = NB * SEQ, TC = NB * CTXL, T = TX + TC;
constexpr int ZW = 3072;
constexpr int ZP = 0, ZGQ = 512, ZGK = 1024, ZGV = 1280, ZNQ = 1536, ZNK = 2048, ZNV = 2560;
constexpr int NIN = 4096;
constexpr int LDT = 2 * NB * SEQ + 64, LDTC = 2 * NB * CTXL + 64;
constexpr int NMOD = 9 * DM;
constexpr float EPS = 1e-6f;
constexpr int IN_DIM = 3584;

constexpr size_t MiB = 1u << 20;
constexpr size_t WS_CTL = 0, CTL_ZERO_BYTES = 1 * MiB;
constexpr size_t WS_MODV = 1 * MiB;
constexpr size_t WS_ROPE = 1 * MiB + 768 * 1024;
constexpr size_t WS_DFTC = 2 * MiB;
constexpr size_t WS_ABTC = 3 * MiB;
constexpr size_t WS_W = 8 * MiB, W_LAYER = 158 * MiB;
constexpr size_t WO_GU1 = 0, WO_D1 = 44 * MiB, WO_IN = 67 * MiB, WO_OUT = 83 * MiB, WO_GU2 = 91 * MiB, WO_D2 = 135 * MiB;
constexpr size_t WS_DFTM = 324 * MiB;
constexpr size_t WS_XS = 388 * MiB;
constexpr size_t WS_H = 524 * MiB;
constexpr size_t WS_GU = 592 * MiB;
constexpr size_t WS_Z = 592 * MiB;
constexpr size_t WS_CC = 694 * MiB;
constexpr size_t WS_ABT = 782 * MiB;
constexpr size_t WS_SLAB = 815 * MiB;
constexpr size_t WS_END = 847 * MiB;
static_assert(WS_Z + (size_t)T * ZW * 2 <= WS_CC && WS_CC + (size_t)T * DM * 2 <= WS_GU + (size_t)T * FFP * 2 && WS_GU + (size_t)T * FFP * 2 <= WS_ABT && WS_ABT + (size_t)512 * LDT * 2 <= WS_SLAB && WS_SLAB + (size_t)4 * TC * DM * 4 <= WS_END, "ws map");
static_assert(WS_XS + (size_t)T * DM * 4 <= WS_H && WS_H + (size_t)T * DM * 2 <= WS_GU && WS_DFTM + (size_t)4096 * 8192 * 2 <= WS_XS && WS_W + NL * W_LAYER <= WS_DFTM, "ws map 2");
static_assert((size_t)DM * FFP * 2 <= 23 * MiB && (size_t)NGU * DM * 2 <= 44 * MiB, "weight regions");
constexpr int CW_BAR = 4096;

constexpr int RING_BYTES = 131072, CONV_SCR = 17408  , LDSCTL_OFF = 143360, MISC_OFF = LDSCTL_OFF + 320, LDS_BYTES = 147456;
static_assert(8 * CONV_SCR <= LDSCTL_OFF && 64 * 65 * 4 <= CONV_SCR, "LDS map");

#define GAS __attribute__((address_space(1)))
#define LAS __attribute__((address_space(3)))
typedef unsigned short bf16;
typedef unsigned v4u __attribute__((ext_vector_type(4)));
typedef unsigned v2u __attribute__((ext_vector_type(2)));
typedef float f32x4 __attribute__((ext_vector_type(4)));
typedef float f32x2 __attribute__((ext_vector_type(2)));
#define LDS_WAIT() asm volatile("s_waitcnt lgkmcnt(0)" ::: "memory")
__device__ __forceinline__ unsigned f2bf(float f) { unsigned u = __builtin_bit_cast(unsigned, f); return (u + 0x7fffu + ((u >> 16) & 1u)) >> 16; }
__device__ __forceinline__ unsigned pk2(float lo, float hi) { return f2bf(lo) | (f2bf(hi) << 16); }
typedef _Float16 h16;
typedef _Float16 h4 __attribute__((ext_vector_type(4)));
__device__ __forceinline__ f32x4 ld_h4(const h16* p) { return __builtin_convertvector(*(const h4*)p, f32x4); }
__device__ __forceinline__ void st_h4(h16* p, f32x4 v) { *(h4*)p = __builtin_convertvector(v, h4); }
__device__ __forceinline__ f32x4 ld_h4_reg(f32x4 v) { return __builtin_convertvector(__builtin_convertvector(v, h4), f32x4); }
__device__ __forceinline__ float bflo(unsigned w) { return __builtin_bit_cast(float, w << 16); }
__device__ __forceinline__ float bfhi(unsigned w) { return __builtin_bit_cast(float, w & 0xffff0000u); }

#define XB_TMO      128
#define XB_XCNT(j)  (256  + 64 * (j))
#define XB_XSUB(j)  (1280 + 64 * (j))
#define XB_XGEN(j)  (2304 + 64 * (j))
#define XB_TOP      3328
#define XB_TOPGEN   3392
#define XCD_BAR_WORDS 3456
#define XB_SPIN_CAP (1u << 18)
__device__ __forceinline__ unsigned xb_ld(unsigned* p)              { return __hip_atomic_load(p, __ATOMIC_RELAXED, __HIP_MEMORY_SCOPE_AGENT); }
__device__ __forceinline__ unsigned xb_add(unsigned* p, unsigned v) { return __hip_atomic_fetch_add(p, v, __ATOMIC_RELAXED, __HIP_MEMORY_SCOPE_AGENT); }
__device__ __forceinline__ unsigned xb_xcc_id() { return (unsigned)__builtin_amdgcn_s_getreg((3 << 11) | 20) & 0xFu; }
#define XB_SPIN(cond, bar) do { unsigned _sp = 0; while (cond) { __builtin_amdgcn_s_sleep(1); \
    if ((++_sp & 255u) == 0u) { if (xb_ld(&(bar)[XB_TMO])) break; if (_sp > XB_SPIN_CAP) { atomicAdd(&(bar)[XB_TMO], 1u); break; } } } } while (0)
struct XcdBarrier { unsigned* bar; unsigned x; volatile LAS unsigned* st; };
__device__ __forceinline__ unsigned* xb_bar_ptr();
__device__ __forceinline__ XcdBarrier xcd_barrier_post(unsigned* bar, volatile LAS unsigned* st) {
    XcdBarrier b; b.bar = bar; b.x = xb_xcc_id(); b.st = st;
    if (threadIdx.x == 0) (void)xb_add(&bar[XB_XCNT(b.x)], 1u);
    return b;
}
__device__ __forceinline__ void xcd_barrier_complete(unsigned* bar, unsigned x, unsigned& nloc, unsigned& nx) {
    const unsigned G = gridDim.x * gridDim.y * gridDim.z;
    unsigned sum, cnt, mine, sp = 0u;
    for (;;) {
        sum = 0u; cnt = 0u; mine = 0u;
#pragma unroll
        for (unsigned j = 0; j < 16; ++j) { const unsigned c = xb_ld(&bar[XB_XCNT(j)]); sum += c; cnt += (c > 0u) ? 1u : 0u; mine = (j == x) ? c : mine; }
        if (sum == G) break;
        __builtin_amdgcn_s_sleep(1);
        if ((++sp & 255u) == 0u) { if (xb_ld(&bar[XB_TMO])) break; if (sp > XB_SPIN_CAP) { atomicAdd(&bar[XB_TMO], 1u); break; } }
    }
    nloc = mine > 0u ? mine : 1u; nx = cnt > 0u ? cnt : 1u;
}
__device__ __forceinline__ void xcd_barrier(const XcdBarrier& b_in) {
    XcdBarrier b; b.st = b_in.st; b.bar = xb_bar_ptr(); b.x = (unsigned)__builtin_amdgcn_readfirstlane((int)xb_xcc_id());
    asm volatile("s_waitcnt vmcnt(0)" ::: "memory");
    __syncthreads();
    if (threadIdx.x == 0) {
        unsigned* bar = b.bar;
        __builtin_amdgcn_s_waitcnt(0);
        unsigned nloc = b.st[0], nx = b.st[1];
        if (nloc == 0u) { xcd_barrier_complete(bar, b.x, nloc, nx); b.st[0] = nloc; b.st[1] = nx; }
        const unsigned old = xb_add(&bar[XB_XSUB(b.x)], 1u);
        const unsigned gen = old / nloc;
        if (old + 1u == (gen + 1u) * nloc) {
            __builtin_amdgcn_fence(__ATOMIC_RELEASE, "agent");
            asm volatile("s_waitcnt vmcnt(0)" ::: "memory");
            const unsigned og = xb_add(&bar[XB_TOP], 1u);
            const unsigned tg = og / nx;
            if (og + 1u == (tg + 1u) * nx) xb_add(&bar[XB_TOPGEN], 1u);
            else XB_SPIN(xb_ld(&bar[XB_TOPGEN]) == tg, bar);
            __builtin_amdgcn_fence(__ATOMIC_ACQUIRE, "agent");
            xb_add(&bar[XB_XGEN(b.x)], 1u);
            asm volatile("s_waitcnt vmcnt(0)" ::: "memory");
        } else {
            XB_SPIN(xb_ld(&bar[XB_XGEN(b.x)]) == gen, bar);
            __builtin_amdgcn_fence(__ATOMIC_ACQUIRE, "agent");
            asm volatile("s_waitcnt vmcnt(0)" ::: "memory");
        }
    }
    __syncthreads();
}

struct Args {
    const float *x, *c, *ctx, *c_ctx, *w_mod, *b_mod, *ffn1_norm, *ffn1_gate, *ffn1_up, *ffn1_down, *mix_norm, *w_in, *w_out, *pool_w, *pool_scale,
                *q_norm, *k_norm, *fnet_w, *na_rpb, *ffn2_norm, *ffn2_gate, *ffn2_up, *ffn2_down, *final_norm;
    float* out; unsigned char* ws;
};
struct Ctx {
    LAS unsigned char* lds; int wave, wg, G;
};
__device__ __forceinline__ Ctx fresh_ctx(const Ctx& C) { Ctx L = C; asm volatile("" : "+s"(L.wave), "+s"(L.wg), "+s"(L.G)); return L; }
__device__ __forceinline__ int fresh_tid() { int t = threadIdx.x; asm volatile("" : "+v"(t)); return t; }
typedef const Args __attribute__((address_space(4))) * ArgsP;
__device__ __forceinline__ ArgsP fresh_args() { ArgsP p = (ArgsP)__builtin_amdgcn_kernarg_segment_ptr(); asm volatile("" : "+s"(p)); return p; }
struct EpiResid {
    static constexpr bool PERM = false;
    int gate_off;
    float coef;
    int flags;
    __device__ __forceinline__ void operator()(const pg8::f32x4 (&acc)[2][2][4][2], const pg8::Unit& u, int wr, int wc, int fr, int fq) const {
        ArgsP a_ = fresh_args(); unsigned char* ws_ = a_->ws;
        const float* base_f32 = (flags & 1) ? a_->x : nullptr; h16* XS = (h16*)(ws_ + WS_XS); const float* gate = (const float*)(ws_ + WS_MODV) + gate_off;
        h16* slab = (flags & 2) ? (h16*)(ws_ + WS_SLAB) : nullptr;
        const int s = slab ? 4 : (u.pm >> 4);
        int fr_ = fr, fq_ = fq; asm volatile("" : "+v"(fr_), "+v"(fq_));
        const int r0 = wr * 64 + fr_, col0 = u.pn * 256 + wc * 32 + 4 * fq_;
        f32x4 gv[2][2];
        { const float* gp = gate + (size_t)s * NMOD + col0;
          const f32x4 g00 = *(const f32x4*)(gp), g01 = *(const f32x4*)(gp + 16), g10 = *(const f32x4*)(gp + 128), g11 = *(const f32x4*)(gp + 144);
          gv[0][0] = g00; gv[0][1] = g01; gv[1][0] = g10; gv[1][1] = g11; }
#define GV_SCALE() do { _Pragma("unroll") for (int bj = 0; bj < 2; ++bj) _Pragma("unroll") for (int n = 0; n < 2; ++n) gv[bj][n] = gv[bj][n] * coef; } while (0)
        if (slab) {
            GV_SCALE();
            h16* op = slab + ((size_t)(u.pm >> 2) * TC + (size_t)(u.pm & 3) * 256) * DM;
#pragma unroll
            for (int ai = 0; ai < 2; ++ai)
#pragma unroll
                for (int m = 0; m < 4; ++m) { const size_t off = (size_t)(r0 + ai * 128 + m * 16) * DM + col0;
#pragma unroll
                    for (int bj = 0; bj < 2; ++bj)
#pragma unroll
                        for (int n = 0; n < 2; ++n) st_h4(op + off + bj * 128 + n * 16, gv[bj][n] * acc[ai][bj][m][n]); }
        } else {
            h16* op = XS + (size_t)u.pm * 256 * DM;
#define RESID_BATCH(LOADEXPR) _Pragma("unroll") for (int ai = 0; ai < 2; ++ai) _Pragma("unroll") for (int mp = 0; mp < 2; ++mp) { \
                f32x4 b000, b001, b010, b011, b100, b101, b110, b111; \
                { const size_t off = (size_t)(r0 + ai * 128 + (2 * mp) * 16) * DM + col0; b000 = LOADEXPR(off); b001 = LOADEXPR(off + 16); b010 = LOADEXPR(off + 128); b011 = LOADEXPR(off + 144); } \
                { const size_t off = (size_t)(r0 + ai * 128 + (2 * mp + 1) * 16) * DM + col0; b100 = LOADEXPR(off); b101 = LOADEXPR(off + 16); b110 = LOADEXPR(off + 128); b111 = LOADEXPR(off + 144); } \
                asm volatile("" ::: "memory"); \
                { const size_t off = (size_t)(r0 + ai * 128 + (2 * mp) * 16) * DM + col0; \
                  st_h4(op + off, b000 + gv[0][0] * acc[ai][0][2 * mp][0]); st_h4(op + off + 16, b001 + gv[0][1] * acc[ai][0][2 * mp][1]); \
                  st_h4(op + off + 128, b010 + gv[1][0] * acc[ai][1][2 * mp][0]); st_h4(op + off + 144, b011 + gv[1][1] * acc[ai][1][2 * mp][1]); } \
                { const size_t off = (size_t)(r0 + ai * 128 + (2 * mp + 1) * 16) * DM + col0; \
                  st_h4(op + off, b100 + gv[0][0] * acc[ai][0][2 * mp + 1][0]); st_h4(op + off + 16, b101 + gv[0][1] * acc[ai][0][2 * mp + 1][1]); \
                  st_h4(op + off + 128, b110 + gv[1][0] * acc[ai][1][2 * mp + 1][0]); st_h4(op + off + 144, b111 + gv[1][1] * acc[ai][1][2 * mp + 1][1]); } \
                asm volatile("" ::: "memory"); }
            if (base_f32) { const float* bp = base_f32 + (size_t)u.pm * 256 * DM; GV_SCALE();
#define LD32(o) (*(const f32x4*)(bp + (o)))
                RESID_BATCH(LD32)
#undef LD32
            } else {
                const __amdgpu_buffer_rsrc_t rx = __builtin_amdgcn_make_buffer_rsrc((void*)op, 0, 256 * DM * 2, 0x00020000);
                const unsigned vo = (unsigned)(r0 * DM + col0) * 2u;
#define ROFF(AI, M, BJ, N) ((((AI) * 128 + (M) * 16) * DM + (BJ) * 128 + (N) * 16) * 2)
                v2u raw[2][4][2][2];
#pragma unroll
                for (int ai = 0; ai < 2; ++ai)
#pragma unroll
                    for (int m = 0; m < 4; ++m)
#pragma unroll
                        for (int bj = 0; bj < 2; ++bj)
#pragma unroll
                            for (int n = 0; n < 2; ++n) raw[ai][m][bj][n] = __builtin_amdgcn_raw_buffer_load_b64(rx, vo, ROFF(ai, m, bj, n), 0);
                asm volatile("" ::: "memory");
                { float cf = coef; asm volatile("" : "+v"(cf));
#pragma unroll
                  for (int bj = 0; bj < 2; ++bj)
#pragma unroll
                      for (int n = 0; n < 2; ++n) gv[bj][n] = gv[bj][n] * cf; }
#pragma unroll
                for (int ai = 0; ai < 2; ++ai)
#pragma unroll
                    for (int m = 0; m < 4; ++m)
#pragma unroll
                        for (int bj = 0; bj < 2; ++bj)
#pragma unroll
                            for (int n = 0; n < 2; ++n) { const f32x4 v_ = __builtin_convertvector(__builtin_bit_cast(h4, raw[ai][m][bj][n]), f32x4) + gv[bj][n] * acc[ai][bj][m][n];
                                __builtin_amdgcn_raw_buffer_store_b64(__builtin_bit_cast(v2u, __builtin_convertvector(v_, h4)), rx, vo, ROFF(ai, m, bj, n), 0); }
#undef ROFF
            }
#undef RESID_BATCH
#undef GV_SCALE
        }
    }
};
template <int CTRL> __device__ __forceinline__ float dpp_f(float v) { return __builtin_bit_cast(float, __builtin_amdgcn_update_dpp(0, __builtin_bit_cast(int, v), CTRL, 0xf, 0xf, false)); }
__device__ __forceinline__ float row16_sum(float v) {
    v += dpp_f<0xB1>(v); v += dpp_f<0x4E>(v); v += dpp_f<0x141>(v); v += dpp_f<0x140>(v); return v;
}
__device__ __forceinline__ unsigned* xb_bar_ptr() { return (unsigned*)(fresh_args()->ws + WS_CTL) + CW_BAR; }
__device__ __forceinline__ float row16_sum_bp(float v, int lane) {
#pragma unroll
    for (int m = 1; m < 16; m <<= 1) v += __builtin_bit_cast(float, __builtin_amdgcn_ds_bpermute((lane ^ m) << 2, __builtin_bit_cast(int, v)));
    return v;
}
__device__ __forceinline__ float wave_sum(float v) {
    v = row16_sum(v);
    const float r0 = __builtin_bit_cast(float, __builtin_amdgcn_readlane(__builtin_bit_cast(int, v), 0)), r1 = __builtin_bit_cast(float, __builtin_amdgcn_readlane(__builtin_bit_cast(int, v), 16));
    const float r2 = __builtin_bit_cast(float, __builtin_amdgcn_readlane(__builtin_bit_cast(int, v), 32)), r3 = __builtin_bit_cast(float, __builtin_amdgcn_readlane(__builtin_bit_cast(int, v), 48));
    return (r0 + r1) + (r2 + r3);
}

struct EpiSwiglu {
    static constexpr bool PERM = true;
    bf16* GU;
    __device__ __forceinline__ void operator()(const pg8::f32x4 (&acc)[2][2][4][2], const pg8::Unit& u, int wr, int wc, int fr, int fq) const {
        const int row0 = u.pm * 256 + wr * 64 + fr, col0 = u.pn * 128 + wc * 32 + 8 * fq;
#pragma unroll
        for (int ai = 0; ai < 2; ++ai)
#pragma unroll
            for (int m = 0; m < 4; ++m) {
                unsigned wv[4];
#pragma unroll
                for (int q = 0; q < 4; ++q) { const int n = q >> 1, j = (q & 1) * 2;
                    const f32x2 g = {acc[ai][0][m][n][j], acc[ai][0][m][n][j + 1]}, up = {acc[ai][1][m][n][j], acc[ai][1][m][n][j + 1]};
                    const f32x2 t = g * -1.4426950408889634f, gu = g * up;
                    f32x2 d = {__builtin_amdgcn_exp2f(t.x), __builtin_amdgcn_exp2f(t.y)}; d = d + 1.0f;
                    const f32x2 rr = {__builtin_amdgcn_rcpf(d.x), __builtin_amdgcn_rcpf(d.y)}, o = gu * rr;
                    unsigned pk; asm("v_cvt_pk_bf16_f32 %0, %1, %2" : "=v"(pk) : "v"(o.x), "v"(o.y)); wv[q] = pk; }
                v4u w; w.x = wv[0]; w.y = wv[1]; w.z = wv[2]; w.w = wv[3];
                *(v4u*)(GU + (size_t)(row0 + ai * 128 + m * 16) * FFP + col0) = w; }
    }
};
struct EpiZ {
    static constexpr bool PERM = true;
    bf16* Z; bf16* ABT; bf16* ABTC;
    __device__ __forceinline__ void operator()(const pg8::f32x4 (&acc)[2][2][4][2], const pg8::Unit& u, int wr, int wc, int fr, int fq) const {
        bf16* base; size_t ld;
        if (u.pn < 12) { base = Z + (size_t)u.pm * 256 * ZW + u.pn * 256; ld = ZW; }
        else { const int cc = (u.pn - 12) * 256, trig = cc >> 9, c0 = cc & 511;
            if (u.pm < 64) { const int b = u.pm >> 4, n0 = (u.pm & 15) * 256; base = ABT + (size_t)c0 * LDT + b * (2 * SEQ) + trig * SEQ + n0; ld = LDT; }
            else { const int b = u.pm - 64; base = ABTC + (size_t)c0 * LDTC + b * (2 * CTXL) + trig * CTXL; ld = LDTC; } }
        const int r0 = wr * 64 + fr, col0 = wc * 32 + 8 * fq;
#pragma unroll
        for (int ai = 0; ai < 2; ++ai)
#pragma unroll
            for (int m = 0; m < 4; ++m) { bf16* rowp = base + (size_t)(r0 + ai * 128 + m * 16) * ld + col0;
#pragma unroll
                for (int bj = 0; bj < 2; ++bj) { const pg8::f32x4 v0 = acc[ai][bj][m][0], v1 = acc[ai][bj][m][1];
                    v4u w; w.x = pg8::cvt_pk_bf16(v0[0], v0[1]); w.y = pg8::cvt_pk_bf16(v0[2], v0[3]); w.z = pg8::cvt_pk_bf16(v1[0], v1[1]); w.w = pg8::cvt_pk_bf16(v1[2], v1[3]);
                    *(v4u*)(rowp + bj * 128) = w; } }
    }
};
struct ProbPlain { const char* A; const char* B; size_t ta, tb;
    __device__ __forceinline__ const char* a_panel(const pg8::Unit& u) const { return A + (size_t)u.pm * ta; }
    __device__ __forceinline__ const char* b_panel(const pg8::Unit& u) const { return B + (size_t)u.pn * tb; } };
struct ProbSplit { const char* A; const char* B; size_t ta, tb; int pmask, kshift; size_t kbytes;
    __device__ __forceinline__ const char* a_panel(const pg8::Unit& u) const { return A + (size_t)(u.pm & pmask) * ta + (size_t)(u.pm >> kshift) * kbytes; }
    __device__ __forceinline__ const char* b_panel(const pg8::Unit& u) const { return B + (size_t)u.pn * tb + (size_t)(u.pm >> kshift) * kbytes; } };
struct ProbInFt { const char* H; const char* W;
    __device__ __forceinline__ const char* a_panel(const pg8::Unit& u) const { return u.pn < 12 ? H + (size_t)u.pm * (256 * DM * 2) : W + (size_t)u.pn * (256 * DM * 2); }
    __device__ __forceinline__ const char* b_panel(const pg8::Unit& u) const { return u.pn < 12 ? W + (size_t)u.pn * (256 * DM * 2) : H + (size_t)u.pm * (256 * DM * 2); } };
struct ProbDft { const char* A; const char* B; int bshift, bmask; size_t bbatch, bsub, bpanel;
    __device__ __forceinline__ const char* a_panel(const pg8::Unit& u) const { return A; }
    __device__ __forceinline__ const char* b_panel(const pg8::Unit& u) const { return B + (size_t)(u.pm >> bshift) * bbatch + (size_t)(u.pm & bmask) * bsub + (size_t)u.pn * bpanel; } };
struct EpiDft {
    static constexpr bool PERM = true;
    bf16* O; int ldc, row0, rshift, rmask, rbatch, rstride;
    __device__ __forceinline__ void operator()(const pg8::f32x4 (&acc)[2][2][4][2], const pg8::Unit& u, int wr, int wc, int fr, int fq) const {
        const int rb = row0 + (u.pm >> rshift) * rbatch + (u.pm & rmask);
        bf16* base = O + u.pn * 256 + wc * 32 + 8 * fq;
        const int r0 = wr * 64 + fr;
#pragma unroll
        for (int ai = 0; ai < 2; ++ai)
#pragma unroll
            for (int m = 0; m < 4; ++m) { bf16* rowp = base + (size_t)(rb + rstride * (r0 + ai * 128 + m * 16)) * ldc;
#pragma unroll
                for (int bj = 0; bj < 2; ++bj) { const pg8::f32x4 v0 = acc[ai][bj][m][0], v1 = acc[ai][bj][m][1];
                    v4u w; w.x = pg8::cvt_pk_bf16(v0[0], v0[1]); w.y = pg8::cvt_pk_bf16(v0[2], v0[3]); w.z = pg8::cvt_pk_bf16(v1[0], v1[1]); w.w = pg8::cvt_pk_bf16(v1[2], v1[3]);
                    *(v4u*)(rowp + bj * 128) = w; } }
    }
};

__device__ __forceinline__ void transpose_tile(const float* W, int ldw, int k0, int n0, bf16* WT, int ldt, int drow0, LAS float* scr, int lane) {
    const int lr = lane >> 4, lc = (lane & 15) * 4;
    f32x4 v[16];
#pragma unroll
    for (int i = 0; i < 16; ++i) v[i] = __builtin_nontemporal_load((const f32x4*)(W + (size_t)(k0 + 4 * i + lr) * ldw + n0 + lc));
#pragma unroll
    for (int i = 0; i < 16; ++i) { LAS float* d = scr + (4 * i + lr) * 65 + lc; d[0] = v[i].x; d[1] = v[i].y; d[2] = v[i].z; d[3] = v[i].w; }
    LDS_WAIT(); asm volatile("" ::: "memory");
    const int c = lane & 7;
#pragma unroll
    for (int j = 0; j < 8; ++j) { const int n = (lane >> 3) + 8 * j; const LAS float* s = scr + (8 * c) * 65 + n;
        v4u o; o.x = pk2(s[0 * 65], s[1 * 65]); o.y = pk2(s[2 * 65], s[3 * 65]); o.z = pk2(s[4 * 65], s[5 * 65]); o.w = pk2(s[6 * 65], s[7 * 65]);
        *(GAS v4u*)(WT + (size_t)(drow0 + n) * ldt + k0 + 8 * c) = o; }
    LDS_WAIT(); asm volatile("" ::: "memory");
}
constexpr int CV_GU = (DM / 64) * (FF / 512), CV_D = (FF / 64) * (DM / 512), CV_IN = (DM / 64) * 5, CV_OUT = (DM / 64) * (DM / 512);
constexpr int CONV_PER_LAYER = 4 * CV_GU + 2 * CV_D + CV_IN + CV_OUT;
constexpr int CI_GU1 = 0, CI_GU2 = 2 * CV_GU, CI_D1 = 4 * CV_GU, CI_D2 = CI_D1 + CV_D, CI_IN = CI_D2 + CV_D, CI_OUT = CI_IN + CV_IN;
__device__ __forceinline__ void conv_item(const Ctx& C, ArgsP a, int l, int r) {
    const int lane = fresh_tid() & 63;
    unsigned char* wl = a->ws + WS_W + (size_t)l * W_LAYER;
    LAS float* scr = (LAS float*)(C.lds + C.wave * CONV_SCR);
    const float* W; int ldw, kb, nb, ldt; bf16* WT; int mode;
    if (r < 4 * CV_GU) { const int which = r / CV_GU; r %= CV_GU;
        W = ((which == 0) ? a->ffn1_gate : (which == 1) ? a->ffn1_up : (which == 2) ? a->ffn2_gate : a->ffn2_up) + (size_t)l * DM * FF;
        ldw = FF; kb = r / (FF / 512); nb = r % (FF / 512); WT = (bf16*)(wl + ((which < 2) ? WO_GU1 : WO_GU2)); ldt = DM; mode = which & 1; }
    else if ((r -= 4 * CV_GU) < 2 * CV_D) { const int which = r / CV_D; r %= CV_D;
        W = (which ? a->ffn2_down : a->ffn1_down) + (size_t)l * FF * DM; ldw = DM; kb = r / (DM / 512); nb = r % (DM / 512); WT = (bf16*)(wl + (which ? WO_D2 : WO_D1)); ldt = FFP; mode = 2; }
    else if ((r -= 2 * CV_D) < CV_IN) { W = a->w_in + (size_t)l * DM * IN_DIM; ldw = IN_DIM; kb = r / 5; nb = r % 5; WT = (bf16*)(wl + WO_IN); ldt = DM; mode = 3; }
    else { r -= CV_IN; W = a->w_out + (size_t)l * DM * DM; ldw = DM; kb = r / (DM / 512); nb = r % (DM / 512); WT = (bf16*)(wl + WO_OUT); ldt = DM; mode = 2; }
    int n0 = nb * 512 + C.wave * 64, drow0;
    if (mode == 3) { n0 = (nb < 2 ? 512 + nb * 512 : 2048 + (nb - 2) * 512) + C.wave * 64; drow0 = n0 < 2048 ? n0 : n0 - 512; }
    else if (mode == 2) drow0 = n0;
    else drow0 = (n0 >> 7) * 256 + mode * 128 + (n0 & 127);
    transpose_tile(W, ldw, kb * 64, n0, WT, ldt, drow0, scr, lane);
}
constexpr int CW_DYN = 12288;
__device__ __forceinline__ unsigned* dyn_heads(ArgsP a, int k) { return (unsigned*)(a->ws + WS_CTL) + CW_DYN + 1024 * k; }
__device__ __forceinline__ void fold_item(const Ctx& C, ArgsP a, int it) {
    const int khalf = it & 1, dblk = (it >> 1) & 3, g = (it >> 3) & 3, kind = (it >> 5) % 3, l = it / 96;
    LAS float* Mb = (LAS float*)C.lds;
    LAS float* Wl = (LAS float*)(C.lds + 16384);
    LAS float* tab = (LAS float*)(C.lds + 16384 + 64 * 129 * 4);
    const int tid = fresh_tid(), d0 = dblk * 32;
    __syncthreads();
    if (tid < 128) tab[tid] = cospif((float)tid * (1.0f / 64.0f));
    __syncthreads();
    if (kind == 0) {
        const float* pw = a->pool_w + ((size_t)(l * 4 + g) * 128) * 128; const float* ps = a->pool_scale + (size_t)l * 512 + g * 128;
        { float pv[8]; const float psv = ps[d0 + (tid & 31)];
#pragma unroll
          for (int u = 0; u < 8; ++u) { const int i = tid + u * NTHR; pv[u] = pw[(i >> 5) * 128 + d0 + (i & 31)]; }
          asm volatile("" ::: "memory");
#pragma unroll
          for (int u = 0; u < 8; ++u) Mb[tid + u * NTHR] = pv[u] * psv; }
    } else {
        const float* fw = a->fnet_w + ((size_t)(l * 4 + g) * 128) * 128;
        LAS float* Fl = (LAS float*)(C.lds + 65536);
#pragma unroll
        for (int j = 0; j < 2; ++j) { const int i = tid + j * NTHR, e = i >> 3, q = (i & 7) * 4; *(LAS f32x4*)(Fl + e * 32 + q) = *(const f32x4*)(fw + e * 128 + d0 + q); }
        __syncthreads();
        const int c = tid >> 2, dq = (tid & 3) * 8, sh = (kind == 2) ? 96 : 0;
        float acc[8];
#pragma unroll
        for (int j = 0; j < 8; ++j) acc[j] = 0.f;
#pragma unroll 8
        for (int e = 0; e < 128; ++e) { const float t = tab[(c * e + sh) & 127]; const f32x4 w0 = *(const LAS f32x4*)(Fl + e * 32 + dq), w1 = *(const LAS f32x4*)(Fl + e * 32 + dq + 4);
#pragma unroll
            for (int j = 0; j < 4; ++j) { acc[j] += t * w0[j]; acc[4 + j] += t * w1[j]; } }
#pragma unroll
        for (int j = 0; j < 8; ++j) Mb[c * 32 + dq + j] = acc[j];
    }
    __syncthreads();
    const int colbase = (kind == 0 ? 0 : 1536) + g * 128, rowbase = (kind == 0 ? 0 : (kind == 1 ? 3072 : 3584)) + g * 128 + d0;
    const float* Wi = a->w_in + (size_t)l * DM * IN_DIM;
    bf16* WT = (bf16*)(a->ws + WS_W + (size_t)l * W_LAYER + WO_IN);
    { typedef float f32x16v __attribute__((ext_vector_type(16)));
      const int lane = tid & 63, n = lane & 31, hf = lane >> 5;
      float am[64];
#pragma unroll
      for (int j = 0; j < 64; ++j) am[j] = Mb[(hf * 64 + j) * 32 + n];
      const int kw = khalf * 1024 + C.wave * 128;
      f32x4 w[16];
#pragma unroll
      for (int t = 0; t < 4; ++t) {
#pragma unroll
          for (int q = 0; q < 16; ++q) w[q] = *(const f32x4*)(Wi + (size_t)(kw + t * 32 + n) * IN_DIM + colbase + hf * 64 + 4 * q);
          asm volatile("" ::: "memory");
          f32x16v acc = {0.f, 0.f, 0.f, 0.f, 0.f, 0.f, 0.f, 0.f, 0.f, 0.f, 0.f, 0.f, 0.f, 0.f, 0.f, 0.f};
#pragma unroll
          for (int j = 0; j < 64; ++j) acc = __builtin_amdgcn_mfma_f32_32x32x2f32(am[j], w[j >> 2][j & 3], acc, 0, 0, 0);
          bf16* op = WT + (size_t)rowbase * DM + kw + t * 32 + n;
#pragma unroll
          for (int r = 0; r < 16; ++r) op[(size_t)((r & 3) + 8 * (r >> 2) + 4 * hf) * DM] = (bf16)f2bf(acc[r]);
          asm volatile("" ::: "memory");
      }
    }
    __syncthreads();
}
__device__ __forceinline__ void mod_item(const Ctx& C, ArgsP a, int it) {
    const int tid = fresh_tid(), lane = tid & 63;
    const int l = it / 144, ch = it % 144;
    LAS float* sc = (LAS float*)C.lds;
    LAS float* red = (LAS float*)(C.lds + 5 * 2048 * 4);
    __syncthreads();
    { float vv[5 * DM / NTHR];
#pragma unroll
      for (int u = 0; u < 5 * DM / NTHR; ++u) { const int i = tid + u * NTHR, s = i / DM, k = i % DM; vv[u] = s < 4 ? a->c[s * DM + k] : a->c_ctx[k]; }
      asm volatile("" ::: "memory");
#pragma unroll
      for (int u = 0; u < 5 * DM / NTHR; ++u) { const float v = vv[u]; sc[tid + u * NTHR] = v / (1.0f + __expf(-v)); } }
    __syncthreads();
    const float* wm = a->w_mod + (size_t)l * DM * NMOD + ch * 128 + 2 * lane;
    float acc[5][2];
#pragma unroll
    for (int s = 0; s < 5; ++s) { acc[s][0] = 0.f; acc[s][1] = 0.f; }
    const int kbeg = C.wave * 256;
    for (int k = kbeg; k < kbeg + 256; k += 16) {
        f32x2 w[16];
#pragma unroll
        for (int j = 0; j < 16; ++j) w[j] = __builtin_nontemporal_load((const f32x2*)(wm + (size_t)(k + j) * NMOD));
#pragma unroll
        for (int s = 0; s < 5; ++s)
#pragma unroll
            for (int q = 0; q < 4; ++q) { const f32x4 sv = *(const LAS f32x4*)(sc + s * DM + k + 4 * q);
#pragma unroll
                for (int j = 0; j < 4; ++j) { acc[s][0] += sv[j] * w[4 * q + j].x; acc[s][1] += sv[j] * w[4 * q + j].y; } }
    }
#pragma unroll
    for (int s = 0; s < 5; ++s) { red[(C.wave * 5 + s) * 128 + 2 * lane] = acc[s][0]; red[(C.wave * 5 + s) * 128 + 2 * lane + 1] = acc[s][1]; }
    __syncthreads();
    float* mv = (float*)(a->ws + WS_MODV) + (size_t)l * 5 * NMOD;
    for (int i = tid; i < 5 * 128; i += NTHR) { const int s = i >> 7, col = i & 127; float v = 0.f;
#pragma unroll
        for (int w = 0; w < 8; ++w) v += red[(w * 5 + s) * 128 + col];
        mv[(size_t)s * NMOD + ch * 128 + col] = v + a->b_mod[(size_t)l * NMOD + ch * 128 + col]; }
    __syncthreads();
}
__device__ __forceinline__ void gen_item(const Ctx& C, ArgsP a, int it) {
    const int tid = fresh_tid();
    bf16* M = (bf16*)(a->ws + WS_DFTC); const float sc = 0.00552427173f;
    for (int i = tid; i < 256 * 512; i += NTHR) { const int k = i >> 9, kk = i & 511, n = kk & 255; const int ph = (k * n) & 255; const float x = (float)ph * (1.0f / 128.0f);
        M[i] = (bf16)f2bf(kk >= 256 ? -sinpif(x) * sc : cospif(x) * sc); }
    float* R = (float*)(a->ws + WS_ROPE);
    for (int i = tid; i < 64 * 32; i += NTHR) { const int p = i >> 5, j = i & 31; const float inv = exp2f(-(float)j * (13.287712379549449f / 32.0f));
        const float ang = (float)p * inv; R[2 * i] = cosf(ang); R[2 * i + 1] = sinf(ang); }
}
struct TSeg { int type, l, first, count; };
__device__ __forceinline__ void run_item(const Ctx& C, ArgsP a, const TSeg& s, int i) {
    if (s.type == 0) conv_item(C, a, s.l, s.first + i);
    else if (s.type == 1) mod_item(C, a, s.first + i);
    else fold_item(C, a, s.first + i);
}
__device__ __forceinline__ void tail_items(const Ctx& C, unsigned* head, const TSeg s0, const TSeg s1) {
    ArgsP a = fresh_args();
    volatile LAS unsigned* slot = (volatile LAS unsigned*)(C.lds + MISC_OFF) + 24;
    for (;;) {
        __syncthreads();
        if (threadIdx.x == 0) *slot = __hip_atomic_fetch_add(head, 1u, __ATOMIC_RELAXED, __HIP_MEMORY_SCOPE_AGENT);
        __syncthreads();
        const int i = (int)*slot;
        if (i >= s0.count + s1.count) break;
        if (i < s0.count) run_item(C, a, s0, i); else run_item(C, a, s1, i - s0.count);
    }
}
constexpr int CW_P0Q = 8192;
__device__ __forceinline__ void prologue_phase(const Ctx& C, ArgsP a) {
    if (C.wg == C.G - 1) gen_item(C, a, 0);
    tail_items(C, (unsigned*)(a->ws + WS_CTL) + CW_P0Q, TSeg{1, 0, 0, 48}, TSeg{0, 0, CI_GU1, 2 * CV_GU});
}

__device__ __forceinline__ void norm_row(const float* src32, const h16* src16, const h16* slabrow, h16* xo, bf16* o, const f32x4 (&A)[8], const f32x4 (&Bv)[8], int lane) {
    f32x4 v[8]; float ss = 0.f;
    if (src32) {
#pragma unroll
        for (int j = 0; j < 8; ++j) v[j] = *(const f32x4*)(src32 + 4 * lane + 256 * j);
    } else {
#pragma unroll
        for (int j = 0; j < 8; ++j) v[j] = ld_h4(src16 + 4 * lane + 256 * j);
    }
    if (slabrow != nullptr) {
        v2u sl[4][8];
#pragma unroll
        for (int ks = 0; ks < 4; ++ks)
#pragma unroll
            for (int j = 0; j < 8; ++j) sl[ks][j] = *(const v2u*)(slabrow + (size_t)ks * TC * DM + 4 * lane + 256 * j);
        asm volatile("" ::: "memory");
#pragma unroll
        for (int ks = 0; ks < 4; ++ks)
#pragma unroll
            for (int j = 0; j < 8; ++j) v[j] += __builtin_convertvector(__builtin_bit_cast(h4, sl[ks][j]), f32x4);
#pragma unroll
        for (int j = 0; j < 8; ++j) { st_h4(xo + 4 * lane + 256 * j, v[j]); v[j] = ld_h4_reg(v[j]); }
    }
#pragma unroll
    for (int j = 0; j < 8; ++j) ss += (v[j].x * v[j].x + v[j].y * v[j].y) + (v[j].z * v[j].z + v[j].w * v[j].w);
    const float rs = 1.0f / sqrtf(wave_sum(ss) * (1.0f / DM) + EPS);
#pragma unroll
    for (int j = 0; j < 8; ++j) { const f32x4 y = v[j] * rs * A[j] + Bv[j]; v2u w; w.x = pk2(y.x, y.y); w.y = pk2(y.z, y.w); *(v2u*)(o + 4 * lane + 256 * j) = w; }
}
template <int NR>
__device__ __forceinline__ void norm_rows_h(__amdgpu_buffer_rsrc_t rx, __amdgpu_buffer_rsrc_t rh, int row0, int rstep, const f32x4 (&A)[8], const f32x4 (&Bv)[8], int lane) {
    f32x4 v[NR][8];
#pragma unroll
    for (int r = 0; r < NR; ++r) { const unsigned off = (unsigned)(row0 + r * rstep) * (DM * 2) + lane * 8;
#pragma unroll
        for (int j = 0; j < 8; ++j) { const v2u w = __builtin_amdgcn_raw_buffer_load_b64(rx, off + 512 * j, 0, 0); v[r][j] = __builtin_convertvector(__builtin_bit_cast(h4, w), f32x4); } }
#pragma unroll
    for (int r = 0; r < NR; ++r) { float ss = 0.f;
#pragma unroll
        for (int j = 0; j < 8; ++j) ss += (v[r][j].x * v[r][j].x + v[r][j].y * v[r][j].y) + (v[r][j].z * v[r][j].z + v[r][j].w * v[r][j].w);
        const float rs = 1.0f / sqrtf(wave_sum(ss) * (1.0f / DM) + EPS); const unsigned off = (unsigned)(row0 + r * rstep) * (DM * 2) + lane * 8;
#pragma unroll
        for (int j = 0; j < 8; ++j) { const f32x4 y = v[r][j] * rs * A[j] + Bv[j]; v2u w; w.x = pk2(y.x, y.y); w.y = pk2(y.z, y.w); __builtin_amdgcn_raw_buffer_store_b64(w, rh, off + 512 * j, 0, 0); } }
}
__device__ __forceinline__ void norm_phase(const Ctx& C, const float* sx32, const float* scx32, h16* XS, const float* gain, const float* modl, int ish, int isc, int nrows, bf16* H, const h16* slab) {
    const int lane = fresh_tid() & 63;
    int G = C.G; asm volatile("" : "+s"(G));
    const int ng = TX / 8; int g0 = (int)((unsigned)(ng * C.wg) / (unsigned)G), g1 = (int)((unsigned)(ng * (C.wg + 1)) / (unsigned)G);
    if (nrows > TX && ng == 8 * G && 2 * (TC / 8) == G) { if (C.wg < TC / 8) { g0 = 7 * C.wg; g1 = g0 + 7; } else { g0 = 7 * (TC / 8) + 9 * (C.wg - TC / 8); g1 = g0 + 9; } }
    int cur = -1; f32x4 A[8], Bv[8];
#define NORM_COEF(s_) do { if ((s_) != cur) { cur = (s_); _Pragma("unroll") for (int j = 0; j < 8; ++j) { const int col = 4 * lane + 256 * j; \
        const f32x4 gn = *(const f32x4*)(gain + col), scv = *(const f32x4*)(modl + (size_t)cur * NMOD + isc * DM + col); \
        A[j] = gn * (scv + 1.0f); Bv[j] = *(const f32x4*)(modl + (size_t)cur * NMOD + ish * DM + col); } } } while (0)
    int g = g0;
    if (!sx32) {
        const __amdgpu_buffer_rsrc_t rx = __builtin_amdgcn_make_buffer_rsrc((void*)XS, 0, TX * DM * 2, 0x00020000), rh = __builtin_amdgcn_make_buffer_rsrc((void*)H, 0, TX * DM * 2, 0x00020000);
        for (; g + 3 < g1 && ((g * 8) >> 12) == (((g + 3) * 8 + 7) >> 12); g += 4) { NORM_COEF((g * 8) >> 12); norm_rows_h<4>(rx, rh, g * 8 + C.wave, 8, A, Bv, lane); }
        for (; g + 1 < g1 && ((g * 8) >> 12) == (((g + 1) * 8 + 7) >> 12); g += 2) { NORM_COEF((g * 8) >> 12); norm_rows_h<2>(rx, rh, g * 8 + C.wave, 8, A, Bv, lane); }
    }
    for (; g < g1; ++g) {
        const int row = g * 8 + C.wave; NORM_COEF(row >> 12);
        norm_row(sx32 ? sx32 + (size_t)row * DM : nullptr, XS + (size_t)row * DM, nullptr, nullptr, H + (size_t)row * DM, A, Bv, lane);
    }
    if (nrows > TX) {
        for (int r = C.wg * NWAVES + C.wave; r < TC; r += G * NWAVES) { NORM_COEF(4);
            norm_row(scx32 ? scx32 + (size_t)r * DM : nullptr, XS + (size_t)(TX + r) * DM, slab ? slab + (size_t)r * DM : nullptr, XS + (size_t)(TX + r) * DM, H + (size_t)(TX + r) * DM, A, Bv, lane); }
    }
#undef NORM_COEF
}
__device__ __forceinline__ void final_phase(const Ctx& C, const h16* XS, const float* gain, float* out) {
    const int lane = fresh_tid() & 63;
    const int gw = C.wg * NWAVES + C.wave, NGW = C.G * NWAVES;
    f32x4 A[8];
#pragma unroll
    for (int j = 0; j < 8; ++j) A[j] = *(const f32x4*)(gain + 4 * lane + 256 * j);
    const __amdgpu_buffer_rsrc_t rx = __builtin_amdgcn_make_buffer_rsrc((void*)XS, 0, TX * DM * 2, 0x00020000), ro = __builtin_amdgcn_make_buffer_rsrc((void*)out, 0, TX * DM * 4, 0x00020000);
    for (int row = gw; row < TX; row += 2 * NGW) {
        const bool two = row + NGW < TX; f32x4 v[2][8];
#pragma unroll
        for (int r = 0; r < 2; ++r) if (r == 0 || two) { const unsigned off = (unsigned)(row + r * NGW) * (DM * 2) + lane * 8;
#pragma unroll
            for (int j = 0; j < 8; ++j) { const v2u w = __builtin_amdgcn_raw_buffer_load_b64(rx, off + 512 * j, 0, 0); v[r][j] = __builtin_convertvector(__builtin_bit_cast(h4, w), f32x4); } }
#pragma unroll
        for (int r = 0; r < 2; ++r) if (r == 0 || two) { float ss = 0.f;
#pragma unroll
            for (int j = 0; j < 8; ++j) ss += (v[r][j].x * v[r][j].x + v[r][j].y * v[r][j].y) + (v[r][j].z * v[r][j].z + v[r][j].w * v[r][j].w);
            const float rs = 1.0f / sqrtf(wave_sum(ss) * (1.0f / DM) + EPS); const unsigned off = (unsigned)(row + r * NGW) * (DM * 4) + lane * 16;
#pragma unroll
            for (int j = 0; j < 4; ++j) { __builtin_amdgcn_raw_buffer_store_b128(__builtin_bit_cast(v4u, v[r][j] * rs * A[j]), ro, off + 1024 * j, 0, 0);
                __builtin_amdgcn_raw_buffer_store_b128(__builtin_bit_cast(v4u, v[r][j + 4] * rs * A[j + 4]), ro, off + 4096 + 1024 * j, 0, 0); } }
    }
}

__device__ __forceinline__ void prep_phase(const Ctx& C, bf16* Z, bf16* CC, const float* qn, const float* kn, const float* rope) {
    const int gw = C.wg * NWAVES + C.wave, NGW = C.G * NWAVES, lane = fresh_tid() & 63, l16 = lane & 15, hq = lane >> 4;
    const bool has1 = hq < 2;
    for (int row = gw; row < T; row += NGW) {
        const bool isx = row < TX; const int t = isx ? (row & (SEQ - 1)) : ((row - TX) & (CTXL - 1)), seqlen = isx ? SEQ : CTXL, seq0 = row - t;
        bf16* zr = Z + (size_t)row * ZW;
        bf16* p0 = zr + ZGQ + hq * 128 + l16 * 8; bf16* p1 = p0 + 512;
        const v4u w0 = *(const v4u*)p0; v4u w1 = (v4u){0u, 0u, 0u, 0u}; if (has1) w1 = *(const v4u*)p1;
        f32x2 cs[4];
#pragma unroll
        for (int jj = 0; jj < 4; ++jj) { const int i = l16 * 4 + jj, pos = isx ? (i < 32 ? (t >> 6) : (t & 63)) : 0;
            cs[jj] = *(const f32x2*)(rope + (pos * 32 + (i & 31)) * 2); }
        const int half = 1 << hq; const int lo = (t - half) > 0 ? (t - half) : 0, hi = (t + half - 1) < (seqlen - 1) ? (t + half - 1) : (seqlen - 1);
        v4u wv[16];
#pragma unroll
        for (int d = 0; d < 16; ++d) { const int tt = t + d - 8; const bool ok = tt >= lo && tt <= hi; wv[d] = *(const v4u*)(Z + (size_t)(seq0 + (ok ? tt : t)) * ZW + ZP + lane * 8); }
        const float* gq = qn + l16 * 8; const float* gk = kn + l16 * 8;
        f32x4 g0a = *(const f32x4*)gq, g0b = *(const f32x4*)(gq + 4), g1a = *(const f32x4*)gk, g1b = *(const f32x4*)(gk + 4);
        asm volatile("" ::: "memory");
#pragma unroll
        for (int jj = 0; jj < 4; ++jj) { cs[jj].x = isx ? cs[jj].x : 1.f; cs[jj].y = isx ? cs[jj].y : 0.f; }
#pragma unroll
        for (int p = 0; p < 2; ++p) {
            if (p == 0 || has1) { const v4u w = p ? w1 : w0; const f32x4 ga = p ? g1a : g0a, gb = p ? g1b : g0b;
                float x[8] = {bflo(w.x), bfhi(w.x), bflo(w.y), bfhi(w.y), bflo(w.z), bfhi(w.z), bflo(w.w), bfhi(w.w)};
                float ss = 0.f;
#pragma unroll
                for (int j = 0; j < 8; ++j) ss += x[j] * x[j];
                ss = row16_sum(ss);
                const float rs = 1.0f / sqrtf(ss * (1.0f / 128.0f) + EPS);
#pragma unroll
                for (int j = 0; j < 4; ++j) { x[j] = x[j] * rs * ga[j]; x[4 + j] = x[4 + j] * rs * gb[j]; }
#pragma unroll
                for (int jj = 0; jj < 4; ++jj) { const float x1 = x[2 * jj], x2 = x[2 * jj + 1]; x[2 * jj] = x1 * cs[jj].x - x2 * cs[jj].y; x[2 * jj + 1] = x1 * cs[jj].y + x2 * cs[jj].x; }
                v4u o; o.x = pk2(x[0], x[1]); o.y = pk2(x[2], x[3]); o.z = pk2(x[4], x[5]); o.w = pk2(x[6], x[7]); *(v4u*)(p ? p1 : p0) = o; } }
        { float sm[8] = {0.f, 0.f, 0.f, 0.f, 0.f, 0.f, 0.f, 0.f};
#pragma unroll
            for (int d = 0; d < 16; ++d) { const int tt = t + d - 8; const float m = (tt >= lo && tt <= hi) ? 1.0f : 0.0f; const v4u w = wv[d];
                sm[0] += m * bflo(w.x); sm[1] += m * bfhi(w.x); sm[2] += m * bflo(w.y); sm[3] += m * bfhi(w.y); sm[4] += m * bflo(w.z); sm[5] += m * bfhi(w.z); sm[6] += m * bflo(w.w); sm[7] += m * bfhi(w.w); }
            const v4u w = wv[8]; const float inv = 1.0f / (float)(hi - lo + 1);
            const float u[8] = {bflo(w.x), bfhi(w.x), bflo(w.y), bfhi(w.y), bflo(w.z), bfhi(w.z), bflo(w.w), bfhi(w.w)};
            v4u o; o.x = pk2(sm[0] * inv - u[0], sm[1] * inv - u[1]); o.y = pk2(sm[2] * inv - u[2], sm[3] * inv - u[3]); o.z = pk2(sm[4] * inv - u[4], sm[5] * inv - u[5]); o.w = pk2(sm[6] * inv - u[6], sm[7] * inv - u[7]);
            *(v4u*)(CC + (size_t)row * DM + lane * 8) = o; }
    }
}

namespace fa {
using bf16x8 = __attribute__((ext_vector_type(8))) short;
using s16x4  = __attribute__((ext_vector_type(4))) short;
using f32x16 = __attribute__((ext_vector_type(16))) float;
using u32x4  = __attribute__((ext_vector_type(4))) unsigned;
constexpr int D = 128, NW = 8, QBLK = 32, KVBLK = 64;
constexpr float SCALE = 0.088388347648318440f, THR = 8.f;
constexpr int SHM_V = KVBLK * D * 2, SHM_K = KVBLK * D * 2, SHM_ATTN = 2 * SHM_V + 2 * SHM_K + NW * 64 * 4;
constexpr int TAB_OFF = 68 * 1024, TAB_ORG = 512, TAB_N = 2048;
constexpr float NEGBIG = -1e30f;
#define KSWZ(row, colB) ((row) * 256 + ((colB) ^ (((row) & 7) << 4)))
#define SBAR() __builtin_amdgcn_sched_barrier(0)
__device__ __forceinline__ int crow(int r, int hi) { return (r & 3) + 8 * (r >> 2) + 4 * hi; }
__device__ __forceinline__ unsigned cvtpk(float lo, float hi) { unsigned r; asm volatile("v_cvt_pk_bf16_f32 %0, %1, %2" : "=v"(r) : "v"(lo), "v"(hi)); return r; }
__device__ __forceinline__ void partialSM(f32x16& p0, f32x16& p1, float& m_reg, float& mn, float& alpha) {
  constexpr float C = SCALE * 1.4426950408889634f;
  float pmax = p0[0];
#pragma unroll
  for (int r = 1; r < 16; ++r) pmax = fmaxf(pmax, p0[r]);
#pragma unroll
  for (int r = 0; r < 16; ++r) pmax = fmaxf(pmax, p1[r]);
  { auto rr = __builtin_amdgcn_permlane32_swap(__float_as_uint(pmax), __float_as_uint(pmax), false, false);
    pmax = fmaxf(__uint_as_float(rr[0]), __uint_as_float(rr[1])); }
  if (__builtin_expect(__all(pmax - m_reg <= THR / SCALE), 1)) { mn = m_reg; alpha = 1.f; }
  else { mn = fmaxf(m_reg, pmax); alpha = __builtin_amdgcn_exp2f((m_reg - mn) * C); m_reg = mn; }
  float mnC = -mn * C;
#pragma unroll
  for (int r = 0; r < 16; ++r) p0[r] = fmaf(p0[r], C, mnC);
#pragma unroll
  for (int r = 0; r < 16; ++r) p1[r] = fmaf(p1[r], C, mnC);
#pragma unroll
  for (int r = 0; r < 16; ++r) p0[r] = __builtin_amdgcn_exp2f(p0[r]);
}
__device__ __forceinline__ void finishSM(f32x16& p0, f32x16& p1, float alpha, float& l_reg, bf16x8& pa0, bf16x8& pa1, bf16x8& pa2, bf16x8& pa3) {
#pragma unroll
  for (int r = 0; r < 16; ++r) p1[r] = __builtin_amdgcn_exp2f(p1[r]);
  float ps = 0;
#pragma unroll
  for (int r = 0; r < 16; ++r) ps += p0[r];
#pragma unroll
  for (int r = 0; r < 16; ++r) ps += p1[r];
  { auto rr = __builtin_amdgcn_permlane32_swap(__float_as_uint(ps), __float_as_uint(ps), false, false);
    ps = __uint_as_float(rr[0]) + __uint_as_float(rr[1]); }
  l_reg = l_reg * alpha + ps;
#define PK4(P, BASE, OUT) do { unsigned a0 = cvtpk(P[BASE + 0], P[BASE + 1]), a1 = cvtpk(P[BASE + 2], P[BASE + 3]);   \
    unsigned b0 = cvtpk(P[BASE + 4], P[BASE + 5]), b1 = cvtpk(P[BASE + 6], P[BASE + 7]);                              \
    auto r0 = __builtin_amdgcn_permlane32_swap(a0, b0, false, false); auto r1 = __builtin_amdgcn_permlane32_swap(a1, b1, false, false); \
    u32x4 w = {r0[0], r1[0], r0[1], r1[1]}; OUT = *reinterpret_cast<bf16x8*>(&w); } while (0)
  PK4(p0, 0, pa0); PK4(p0, 8, pa1); PK4(p1, 0, pa2); PK4(p1, 8, pa3);
#undef PK4
}
__device__ __forceinline__ void qkt(f32x16& p0, f32x16& p1, const char* Ks, const bf16x8* qr, int r32, int hi) {
  p0 = f32x16{}; p1 = f32x16{};
#pragma unroll
  for (int d0 = 0; d0 < 8; ++d0) { int cb = (d0 * 16 + hi * 8) * 2;
    bf16x8 b0 = *reinterpret_cast<const bf16x8*>(Ks + KSWZ(r32, cb));
    bf16x8 b1 = *reinterpret_cast<const bf16x8*>(Ks + KSWZ(32 + r32, cb));
    p0 = __builtin_amdgcn_mfma_f32_32x32x16_bf16(b0, qr[d0], p0, 0, 0, 0);
    p1 = __builtin_amdgcn_mfma_f32_32x32x16_bf16(b1, qr[d0], p1, 0, 0, 0); }
}
__device__ __forceinline__ int v_st(int k, int c) { const int kk = (k & ~0xC) | ((k & 4) << 1) | ((k & 8) >> 1); return ((kk >> 3) * 4 + (c >> 5)) * 512 + ((kk & 7) * 32 + (c & 31)) * 2; }
__device__ __forceinline__ int v_rd_base(int lane) { return ((lane & 3) << 3) | (((lane >> 2) & 3) << 6) | (((lane >> 4) & 1) << 5) | (((lane >> 5) & 1) << 8); }
constexpr int v_rd_off(int d0, int ks, int half) { return d0 * 512 + ks * 4096 + half * 2048; }
template <int OFF> __device__ __forceinline__ s16x4 tr_read(int vb) {
  s16x4 r; asm volatile("ds_read_b64_tr_b16 %0, %1 offset:%2" : "=&v"(r) : "v"(vb), "i"(OFF) : "memory"); return r;
}
template <int D0> __device__ __forceinline__ void pv_one(f32x16& od, int vb, bf16x8 pa0, bf16x8 pa1, bf16x8 pa2, bf16x8 pa3) {
  const s16x4 l0 = tr_read<v_rd_off(D0, 0, 0)>(vb), h0 = tr_read<v_rd_off(D0, 0, 1)>(vb), l1 = tr_read<v_rd_off(D0, 1, 0)>(vb), h1 = tr_read<v_rd_off(D0, 1, 1)>(vb);
  const s16x4 l2 = tr_read<v_rd_off(D0, 2, 0)>(vb), h2 = tr_read<v_rd_off(D0, 2, 1)>(vb), l3 = tr_read<v_rd_off(D0, 3, 0)>(vb), h3 = tr_read<v_rd_off(D0, 3, 1)>(vb);
  asm volatile("s_waitcnt lgkmcnt(0)" ::: "memory"); SBAR();
#define PK(L, H) (bf16x8){L[0], L[1], L[2], L[3], H[0], H[1], H[2], H[3]}
  od = __builtin_amdgcn_mfma_f32_32x32x16_bf16(pa0, PK(l0, h0), od, 0, 0, 0);
  od = __builtin_amdgcn_mfma_f32_32x32x16_bf16(pa1, PK(l1, h1), od, 0, 0, 0);
  od = __builtin_amdgcn_mfma_f32_32x32x16_bf16(pa2, PK(l2, h2), od, 0, 0, 0);
  od = __builtin_amdgcn_mfma_f32_32x32x16_bf16(pa3, PK(l3, h3), od, 0, 0, 0);
#undef PK
}
__device__ __forceinline__ void pv_d0(f32x16* o, int vb, bf16x8 pa0, bf16x8 pa1, bf16x8 pa2, bf16x8 pa3) {
  pv_one<0>(o[0], vb, pa0, pa1, pa2, pa3); pv_one<1>(o[1], vb, pa0, pa1, pa2, pa3); pv_one<2>(o[2], vb, pa0, pa1, pa2, pa3); pv_one<3>(o[3], vb, pa0, pa1, pa2, pa3);
}
struct TileDense { int lat0, nlat, ctx0;
  __device__ __forceinline__ void operator()(int j, int& base, int& hoff) const { base = j < nlat ? lat0 + 64 * j : ctx0 + 64 * (j - nlat); hoff = 32; } };
struct TileNa { int ctx0, loc0;
  __device__ __forceinline__ void operator()(int j, int& base, int& hoff) const { if (j < 4) { base = ctx0 + 64 * j; hoff = 32; } else { base = loc0 + (j - 4) * 128; hoff = 64; } } };
__device__ __forceinline__ void na_bias(f32x16& p0, f32x16& p1, int krow, int kc0, int qr, int qc, int rs, int cs, const float* tab, int hi) {
  const bool rv0 = (unsigned)(krow - rs) < 8u, rv1 = (unsigned)(krow + 1 - rs) < 8u;
  const int cb = kc0 + 4 * hi - cs, ib = (krow - qr + 7) * 31 + (kc0 + 4 * hi - qc + 15);
  const float* t0 = tab + ib;
#pragma unroll
  for (int r = 0; r < 16; ++r) { const int co = (r & 3) + 8 * (r >> 2); const bool cv = (unsigned)(cb + co) < 16u;
    const float b0 = t0[co], b1 = t0[31 + co];
    p0[r] = (rv0 && cv) ? p0[r] + b0 : NEGBIG; p1[r] = (rv1 && cv) ? p1[r] + b1 : NEGBIG; }
}
template <bool NA, class TileF, int SD>
__device__ __forceinline__ void attn_unit(const bf16* __restrict__ Z, bf16* __restrict__ CC, int qcol, int kcol, int vcol, int outcol, int NT, const TileF& TF,
                                          int q0, int nb, int R0, int C0, int kr0, int kc0, char* lds) {
  const int tid = fresh_tid(), wid = tid >> 6, lane = tid & 63, r32 = lane & 31, hi = lane >> 5;
  char* V_lds = lds; char* K_lds = lds + 2 * SHM_V;
  float* ws = (float*)(lds + 2 * SHM_V + 2 * SHM_K) + wid * 64; float* li_l = ws; float* al_l = ws + 32;
  const float* tab = (const float*)(lds + TAB_OFF) + TAB_ORG;
  float m_reg = -1e30f, l_reg = 0; f32x16 o[4] = {}; bf16x8 qr[8];
  const int qg_r = R0 + 2 * wid + (r32 >> 4), qg_c = C0 + (r32 & 15);
  const int myrow = NA ? nb * SEQ + qg_r * 64 + qg_c : q0 + wid * 32 + r32;
  { const bf16* Qw = Z + (size_t)myrow * ZW + qcol + hi * 8;
#pragma unroll
    for (int d0 = 0; d0 < 8; ++d0) qr[d0] = *reinterpret_cast<const bf16x8*>(Qw + d0 * 16); }
  const int sr = tid >> 4, sc = (tid & 15) * 8, vst0 = v_st(sr, sc), vst1 = v_st(32 + sr, sc);
  const int vb0 = (int)(uintptr_t)V_lds + v_rd_base(lane);
  struct { bf16x8 vs0, vs1, ks0, ks1; } sr_[SD];
#define SLOAD(i, j) do { int _b, _h; TF((j), _b, _h); const bf16* _p0 = Z + (size_t)(_b + sr) * ZW + sc; const bf16* _p1 = Z + (size_t)(_b + _h + sr) * ZW + sc; \
    sr_[i].vs0 = *reinterpret_cast<const bf16x8*>(_p0 + vcol); sr_[i].vs1 = *reinterpret_cast<const bf16x8*>(_p1 + vcol); \
    sr_[i].ks0 = *reinterpret_cast<const bf16x8*>(_p0 + kcol); sr_[i].ks1 = *reinterpret_cast<const bf16x8*>(_p1 + kcol); } while (0)
#define SWRITE(b, i) do { *(bf16x8*)(V_lds + (b) * SHM_V + vst0) = sr_[i].vs0; *(bf16x8*)(V_lds + (b) * SHM_V + vst1) = sr_[i].vs1; int kc = sc * 2; \
    *(bf16x8*)(K_lds + (b) * SHM_K + KSWZ(sr, kc)) = sr_[i].ks0; *(bf16x8*)(K_lds + (b) * SHM_K + KSWZ(32 + sr, kc)) = sr_[i].ks1; } while (0)
#define SWAIT() do { if constexpr (SD == 2) asm volatile("s_waitcnt vmcnt(4)" ::: "memory"); else asm volatile("s_waitcnt vmcnt(0)" ::: "memory"); } while (0)
#define RESC(a) do { if (__any((a) < 1.f)) { if (hi == 0) al_l[r32] = (a); asm volatile("s_waitcnt lgkmcnt(0)" ::: "memory"); \
    _Pragma("unroll") for (int d = 0; d < 4; ++d) _Pragma("unroll") for (int r = 0; r < 16; ++r) o[d][r] *= al_l[crow(r, hi)]; } } while (0)
#define BIAS(P0, P1, j) do { if (NA) { if ((j) >= 4) { const int t_ = fresh_tid(), qr_ = R0 + 2 * (t_ >> 6) + ((t_ & 31) >> 4), qc_ = C0 + (t_ & 15); \
    int rs_ = qr_ - 4; rs_ = rs_ < 0 ? 0 : (rs_ > 56 ? 56 : rs_); int cs_ = qc_ - 8; cs_ = cs_ < 0 ? 0 : (cs_ > 48 ? 48 : cs_); \
    na_bias(P0, P1, kr0 + 2 * ((j) - 4), kc0, qr_, qc_, rs_, cs_, tab, (t_ >> 5) & 1); } } } while (0)
  f32x16 pA0, pA1, pB0, pB1; float mnA, mnB, alA = 1.f, alB = 1.f; bf16x8 pa0, pa1, pa2, pa3;
  const int wq_ = R0 + 2 * __builtin_amdgcn_readfirstlane(tid >> 6);
  const int rsl_ = (wq_ - 4) < 0 ? 0 : ((wq_ - 4) > 56 ? 56 : (wq_ - 4)), rsh_ = ((wq_ - 3) < 0 ? 0 : ((wq_ - 3) > 56 ? 56 : (wq_ - 3))) + 7;
#define ACT(j) (!NA || (j) < 4 || ((kr0 + 2 * ((j) - 4) + 1 >= rsl_) && (kr0 + 2 * ((j) - 4) <= rsh_)))
  constexpr int SE = 0, SO = SD - 1;
  SLOAD(SE, 0); asm volatile("s_waitcnt vmcnt(0)" ::: "memory"); SWRITE(0, SE); __syncthreads();
  qkt(pA0, pA1, K_lds, qr, r32, hi); BIAS(pA0, pA1, 0); partialSM(pA0, pA1, m_reg, mnA, alA);
  SLOAD(SO, 1); if constexpr (SD == 2) { if (2 < NT) SLOAD(SE, 2); }
  SWAIT(); SWRITE(1, SO); __syncthreads();
  bool aA = true, aB;
  for (int j = 1; j + 1 < NT; j += 2) {
    aB = ACT(j);
    SBAR(); if (aB) { qkt(pB0, pB1, K_lds + SHM_K, qr, r32, hi); BIAS(pB0, pB1, j); }
    if (aA) finishSM(pA0, pA1, alA, l_reg, pa0, pa1, pa2, pa3); SBAR();
    SLOAD(SO, j + SD); SBAR();
    if (aA) pv_d0(o, vb0, pa0, pa1, pa2, pa3); if (aB) partialSM(pB0, pB1, m_reg, mnB, alB);
    __syncthreads(); SWAIT(); SWRITE(0, SE);
    if (aB) RESC(alB); __syncthreads();
    aA = ACT(j + 1);
    SBAR(); if (aA) { qkt(pA0, pA1, K_lds, qr, r32, hi); BIAS(pA0, pA1, j + 1); }
    if (aB) finishSM(pB0, pB1, alB, l_reg, pa0, pa1, pa2, pa3); SBAR();
    if (SD == 1 || j + 3 < NT) SLOAD(SE, j + 1 + SD); SBAR();
    if (aB) pv_d0(o, vb0 + SHM_V, pa0, pa1, pa2, pa3); if (aA) partialSM(pA0, pA1, m_reg, mnA, alA);
    __syncthreads(); SWAIT(); SWRITE(1, SO);
    if (aA) RESC(alA); __syncthreads();
  }
  aB = ACT(NT - 1);
  SBAR(); if (aB) { qkt(pB0, pB1, K_lds + SHM_K, qr, r32, hi); BIAS(pB0, pB1, NT - 1); }
  if (aA) finishSM(pA0, pA1, alA, l_reg, pa0, pa1, pa2, pa3); SBAR();
  if (aA) pv_d0(o, vb0, pa0, pa1, pa2, pa3); if (aB) partialSM(pB0, pB1, m_reg, mnB, alB);
  __syncthreads(); if (aB) RESC(alB);
  if (aB) { finishSM(pB0, pB1, alB, l_reg, pa0, pa1, pa2, pa3); SBAR();
    pv_d0(o, vb0 + SHM_V, pa0, pa1, pa2, pa3); }
#undef ACT
  if (hi == 0) li_l[r32] = l_reg; asm volatile("s_waitcnt lgkmcnt(0)" ::: "memory");
  float rli[16];
#pragma unroll
  for (int r = 0; r < 16; ++r) rli[r] = __builtin_amdgcn_rcpf(li_l[crow(r, hi)]);
  __syncthreads();
  char* stg = lds + wid * 8192;
#pragma unroll
  for (int r = 0; r < 16; ++r) { const int orow = crow(r, hi);
#pragma unroll
    for (int d0 = 0; d0 < 4; ++d0) *(unsigned short*)(stg + orow * 256 + (d0 * 32 + r32) * 2) = (unsigned short)f2bf(o[d0][r] * rli[r]); }
  asm volatile("s_waitcnt lgkmcnt(0)" ::: "memory");
#pragma unroll
  for (int i = 0; i < 8; ++i) { const int row = (lane >> 4) + 4 * i, ch = lane & 15; const v4u w = *(const v4u*)(stg + row * 256 + ch * 16);
    const int orow = NA ? nb * SEQ + (R0 + 2 * wid + (row >> 4)) * 64 + C0 + (row & 15) : q0 + wid * 32 + row;
    *(v4u*)(CC + (size_t)orow * DM + outcol + ch * 8) = w; }
  __syncthreads();
#undef SLOAD
#undef SWRITE
#undef SWAIT
#undef RESC
#undef BIAS
}
}

__device__ __forceinline__ void dense_attn_units(const Ctx& C, const bf16* Z, bf16* CC, bool with_ctx, char* lds) {
    for (int k = C.wg; k < 256 + 32 * C.G; k += C.G) {
        int u;
        if (k < 256) u = k;
        else { const int v = (k - 256) / C.G; if (!with_ctx || v >= 32) break; if ((144 + v) % C.G != C.wg) continue; u = 256 + v; }
        int b, qcol, kcol, vcol, outcol, NT, q0; fa::TileDense TF;
        if (u < 256) { const int bk = u & 7, idx = u >> 3, kvh = bk & 1, hq = 2 * kvh + (idx >> 4); b = bk >> 1;
            qcol = ZGQ + hq * 128; kcol = ZGK + kvh * 128; vcol = ZGV + kvh * 128; outcol = 512 + hq * 128; NT = 68; q0 = b * SEQ + (idx & 15) * 256; TF = fa::TileDense{b * SEQ, 64, TX + b * CTXL}; }
        else if (u < 272) { const int v = u - 256, hq = v & 3; b = v >> 2;
            qcol = ZGQ + hq * 128; kcol = ZGK + (hq >> 1) * 128; vcol = ZGV + (hq >> 1) * 128; outcol = 512 + hq * 128; NT = 4; q0 = TX + b * CTXL; TF = fa::TileDense{0, 0, TX + b * CTXL}; }
        else { const int v = u - 272, h = v & 3; b = v >> 2;
            qcol = ZNQ + h * 128; kcol = ZNK + h * 128; vcol = ZNV + h * 128; outcol = 1536 + h * 128; NT = 4; q0 = TX + b * CTXL; TF = fa::TileDense{0, 0, TX + b * CTXL}; }
        fa::attn_unit<false, fa::TileDense, 2>(Z, CC, qcol, kcol, vcol, outcol, NT, TF, q0, 0, 0, 0, 0, 0, lds);
    }
}
__device__ __forceinline__ void na_units(const Ctx& C, const bf16* Z, bf16* CC, const float* rpb_l, char* lds) {
    float* tabz = (float*)(lds + fa::TAB_OFF);
    for (int u = C.wg; u < 256; u += C.G) {
        const int patch = u & 15, bh = u >> 4, h = bh & 3, b = bh >> 2, R0 = (patch >> 2) * 16, C0 = (patch & 3) * 16;
        int kr0 = R0 - 4; kr0 = kr0 < 0 ? 0 : (kr0 > 40 ? 40 : kr0); int kc0 = C0 - 8; kc0 = kc0 < 0 ? 0 : (kc0 > 32 ? 32 : kc0);
        { const int tid = fresh_tid();
            float tv[fa::TAB_N / NTHR];
#pragma unroll
            for (int j = 0; j < fa::TAB_N / NTHR; ++j) { const int k = tid + j * NTHR - fa::TAB_ORG; const int kc = k < 0 ? 0 : (k > 15 * 31 - 1 ? 15 * 31 - 1 : k); tv[j] = rpb_l[h * (15 * 31) + kc]; }
            asm volatile("" ::: "memory");
#pragma unroll
            for (int j = 0; j < fa::TAB_N / NTHR; ++j) { const int k = tid + j * NTHR - fa::TAB_ORG; tabz[tid + j * NTHR] = (k >= 0 && k < 15 * 31) ? tv[j] * (1.0f / fa::SCALE) : 0.f; } }
        __syncthreads();
        fa::TileNa TF{TX + b * CTXL, b * SEQ + kr0 * 64 + kc0};
        fa::attn_unit<true, fa::TileNa, 1>(Z, CC, ZNQ + h * 128, ZNK + h * 128, ZNV + h * 128, 1536 + h * 128, 16, TF, 0, b, R0, C0, kr0, kc0, lds);
    }
}

__device__ __forceinline__ void ph_gu(const Ctx& C0_, int step) {
    const Ctx C = fresh_ctx(C0_);
    ArgsP a = fresh_args(); unsigned char* ws = a->ws; const int l = step >> 1, second = step & 1; const bool last = (l == NL - 1);
    const unsigned char* wl = ws + WS_W + (size_t)l * W_LAYER;
    pg8::Dims g{DM, DM, DM}; pg8::DynOrder S; S.so.init((second && last) ? TX : T, NGU, C.G, C.wg); S.nstat = S.so.nwg / C.G - 1; S.heads = dyn_heads(a, step); S.slot = (volatile LAS unsigned*)(C.lds + MISC_OFF) + 26;
    ProbPlain P{(const char*)(ws + WS_H), (const char*)(wl + (second ? WO_GU2 : WO_GU1)), (size_t)256 * DM * 2, (size_t)256 * DM * 2}; EpiSwiglu E{(bf16*)(ws + WS_GU)};
    pg8::gemm_phase<EpiSwiglu, pg8::DynOrder, ProbPlain>(C.lds, g, P, S, E);
    if (step < 3) tail_items(C, dyn_heads(a, step) + 512, TSeg{1, 0, step == 0 ? 48 : (step == 1 ? 144 : 192), step == 1 ? 48 : 32}, TSeg{0, step == 0 ? 0 : 1, step == 1 ? CI_GU1 : CI_D1, step == 1 ? CV_GU : CV_D});
}
__device__ __forceinline__ void resid_gemm(const Ctx& C, int kq, const char* A, const char* B, int K, int ld, bool base_in, int gate_off, float coef, bool with_ctx) {
    for (int pass = 0; pass < (with_ctx ? 2 : 1); ++pass) {
        pg8::Dims g{pass ? K / 4 : K, ld, ld}; pg8::DynOrder S; S.so.init(pass ? 16 * 256 : TX, DM, C.G, C.wg); S.nstat = pass ? 0 : 1; S.ncls = pass ? 0 : 1; S.heads = dyn_heads(fresh_args(), kq) + (pass ? 32 : 0);
        S.slot = (volatile LAS unsigned*)(C.lds + MISC_OFF) + 26;
        ProbSplit P{pass ? A + (size_t)TX * ld * 2 : A, B, (size_t)256 * ld * 2, (size_t)256 * ld * 2, pass ? 3 : 0xFFFF, pass ? 2 : 16, (size_t)(K / 4) * 2};
        EpiResid E{gate_off, coef, (base_in ? 1 : 0) | (pass ? 2 : 0)};
        pg8::gemm_phase<EpiResid, pg8::DynOrder, ProbSplit>(C.lds, g, P, S, E);
    }
}
__device__ __forceinline__ void ph_inft(const Ctx& C0_, int l) {
    const Ctx C = fresh_ctx(C0_);
    ArgsP a = fresh_args(); unsigned char* ws = a->ws; const unsigned char* wl = ws + WS_W + (size_t)l * W_LAYER;
    pg8::Dims g{DM, DM, DM}; pg8::DynOrder S; S.so.init(T, NIN, C.G, C.wg); S.nstat = S.so.nwg / C.G - 1; S.heads = dyn_heads(a, 8 + l); S.slot = (volatile LAS unsigned*)(C.lds + MISC_OFF) + 26;
    ProbInFt P{(const char*)(ws + WS_H), (const char*)(wl + WO_IN)}; EpiZ E{(bf16*)(ws + WS_Z), (bf16*)(ws + WS_ABT), (bf16*)(ws + WS_ABTC)};
    pg8::gemm_phase<EpiZ, pg8::DynOrder, ProbInFt>(C.lds, g, P, S, E);
    if (l == 0) tail_items(C, dyn_heads(a, 8 + l) + 512, TSeg{1, 0, 80, 64}, TSeg{0, 0, CI_GU2, 2 * CV_GU});
    else tail_items(C, dyn_heads(a, 8 + l) + 512, TSeg{0, 1, CI_GU2, 2 * CV_GU}, TSeg{0, 1, CI_D2, CV_D});
}
struct cpx { float r, i; };
__device__ __forceinline__ cpx cadd(cpx a, cpx b) { return cpx{a.r + b.r, a.i + b.i}; }
__device__ __forceinline__ cpx csub(cpx a, cpx b) { return cpx{a.r - b.r, a.i - b.i}; }
__device__ __forceinline__ cpx cmul(cpx a, cpx w) { return cpx{a.r * w.r - a.i * w.i, a.r * w.i + a.i * w.r}; }
__device__ __forceinline__ void dft4(cpx x0, cpx x1, cpx x2, cpx x3, cpx& y0, cpx& y1, cpx& y2, cpx& y3) {
    const cpx t0 = cadd(x0, x2), t1 = csub(x0, x2), t2 = cadd(x1, x3), t3 = csub(x1, x3);
    y0 = cadd(t0, t2); y2 = csub(t0, t2); y1 = cpx{t1.r + t3.i, t1.i - t3.r}; y3 = cpx{t1.r - t3.i, t1.i + t3.r};
}
__device__ __forceinline__ constexpr float cos16(int m) {
    return m == 0 ? 1.f : m == 1 ? 0.92387953251128674f : m == 2 ? 0.70710678118654752f : m == 3 ? 0.38268343236508977f : m == 4 ? 0.f : m == 5 ? -0.38268343236508977f : m == 6 ? -0.70710678118654752f :
           m == 7 ? -0.92387953251128674f : m == 8 ? -1.f : m == 9 ? -0.92387953251128674f : m == 10 ? -0.70710678118654752f : m == 11 ? -0.38268343236508977f : m == 12 ? 0.f : m == 13 ? 0.38268343236508977f :
           m == 14 ? 0.70710678118654752f : 0.92387953251128674f;
}
__device__ __forceinline__ void fft16(const cpx (&z)[16], int n2, float (&oP)[16], float (&oQ)[16]) {
    cpx V[4][4];
#pragma unroll
    for (int bb = 0; bb < 4; ++bb) { dft4(z[bb], z[4 + bb], z[8 + bb], z[12 + bb], V[bb][0], V[bb][1], V[bb][2], V[bb][3]);
#pragma unroll
        for (int cc = 1; cc < 4; ++cc) if (bb) V[bb][cc] = cmul(V[bb][cc], cpx{cos16((bb * cc) & 15), -cos16((bb * cc + 12) & 15)}); }
    cpx Y[16];
#pragma unroll
    for (int cc = 0; cc < 4; ++cc) dft4(V[0][cc], V[1][cc], V[2][cc], V[3][cc], Y[cc], Y[cc + 4], Y[cc + 8], Y[cc + 12]);
    float s1, c1; sincospif((float)n2 * (1.0f / 2048.0f), &s1, &c1);
    const cpx t1{c1, -s1}; cpx tk{0.25f, 0.f};
#pragma unroll
    for (int k1 = 0; k1 < 16; ++k1) { const cpx y = cmul(Y[k1], tk); oP[k1] = y.r; oQ[k1] = -y.i; tk = cmul(tk, t1); }
}
__device__ __forceinline__ void fft_stage1(const Ctx& C, bf16* ABT) {
    const int tid = fresh_tid();
    for (int it = C.wg * NTHR + tid; it < 512 * NB * 128; it += C.G * NTHR) {
        const int n2 = (it & 127) * 2, b = (it >> 7) & 3, c = it >> 9;
        bf16* base = ABT + (size_t)c * LDT + b * (2 * SEQ) + n2;
        unsigned rp[16], rq[16];
#pragma unroll
        for (int n1 = 0; n1 < 16; ++n1) { rp[n1] = *(const unsigned*)(base + 256 * n1); rq[n1] = *(const unsigned*)(base + SEQ + 256 * n1); }
        asm volatile("" ::: "memory");
        cpx z[16]; float aP[16], aQ[16], bP[16], bQ[16];
#pragma unroll
        for (int n1 = 0; n1 < 16; ++n1) { z[n1].r = bflo(rp[n1]); z[n1].i = -bflo(rq[n1]); }
        fft16(z, n2, aP, aQ);
#pragma unroll
        for (int n1 = 0; n1 < 16; ++n1) { z[n1].r = bfhi(rp[n1]); z[n1].i = -bfhi(rq[n1]); }
        fft16(z, n2 + 1, bP, bQ);
#pragma unroll
        for (int k1 = 0; k1 < 16; ++k1) { *(unsigned*)(base + 512 * k1) = pk2(aP[k1], bP[k1]); *(unsigned*)(base + 512 * k1 + 256) = pk2(aQ[k1], bQ[k1]); }
    }
}
__device__ __forceinline__ void ph_prep(const Ctx& C0_, int l) {
    const Ctx C = fresh_ctx(C0_);
    ArgsP a = fresh_args(); unsigned char* ws = a->ws;
    prep_phase(C, (bf16*)(ws + WS_Z), (bf16*)(ws + WS_CC), a->q_norm + (size_t)l * 128, a->k_norm + (size_t)l * 128, (const float*)(ws + WS_ROPE));
}
__device__ __forceinline__ void ph_prep_fft(const Ctx& C0_, int l) {
    const Ctx C = fresh_ctx(C0_);
    ArgsP a = fresh_args(); unsigned char* ws = a->ws;
    fft_stage1(C, (bf16*)(ws + WS_ABT));
}
__device__ __forceinline__ void ph_dft(const Ctx& C0_, int l) {
    const Ctx C = fresh_ctx(C0_);
    ArgsP a = fresh_args(); unsigned char* ws = a->ws; const bool last = (l == NL - 1);
    bf16* CC = (bf16*)(ws + WS_CC);
    for (int pass = 0; pass < (last ? 1 : 2); ++pass) {
        pg8::Dims g{2 * CTXL, 2 * CTXL, pass ? LDTC : LDT};
        pg8::StaticOrder S; S.init(pass ? TC : 64 * 256, 512, C.G, pass ? (C.wg + C.G - 136 % C.G) % C.G : C.wg);
        ProbDft P = pass ? ProbDft{(const char*)(ws + WS_DFTC), (const char*)(ws + WS_ABTC), 0, 0, (size_t)2 * CTXL * 2, 0, (size_t)256 * LDTC * 2}
                         : ProbDft{(const char*)(ws + WS_DFTC), (const char*)(ws + WS_ABT), 4, 15, (size_t)2 * SEQ * 2, (size_t)512 * 2, (size_t)256 * LDT * 2};
        EpiDft E = pass ? EpiDft{CC + 1024, DM, TX, 0, 0, CTXL, 1} : EpiDft{CC + 1024, DM, 0, 4, 15, SEQ, 16};
        pg8::gemm_phase<EpiDft, pg8::StaticOrder, ProbDft>(C.lds, g, P, S, E);
    }
}
__device__ __forceinline__ void ph_attn(const Ctx& C0_, int l, char* lds) {
    const Ctx C = fresh_ctx(C0_);
    ArgsP a = fresh_args(); unsigned char* ws = a->ws; const bool last = (l == NL - 1);
    dense_attn_units(C, (const bf16*)(ws + WS_Z), (bf16*)(ws + WS_CC), !last, lds);
}
__device__ __forceinline__ void ph_na(const Ctx& C0_, int l, char* lds) {
    const Ctx C = fresh_ctx(C0_);
    ArgsP a = fresh_args(); unsigned char* ws = a->ws;
    na_units(C, (const bf16*)(ws + WS_Z), (bf16*)(ws + WS_CC), a->na_rpb + (size_t)l * 4 * 15 * 31, lds);
}
__device__ __forceinline__ void ph_norm(const Ctx& C0_, int blk) {
    const Ctx C = fresh_ctx(C0_);
    ArgsP a = fresh_args(); unsigned char* ws = a->ws; const int l = blk / 3, kind = blk % 3; const bool last = (l == NL - 1);
    h16* XS = (h16*)(ws + WS_XS); const float* modl = (const float*)(ws + WS_MODV) + (size_t)l * 5 * NMOD;
    const bool from_in = (blk == 0), ctx_in = (blk <= 1);
    const float* sx = from_in ? a->x : nullptr; const float* scx = ctx_in ? a->ctx : nullptr;
    const bool fold = (blk != 0) && !(kind == 2 && last);
    const float* gain = (kind == 0 ? a->ffn1_norm : (kind == 1 ? a->mix_norm : a->ffn2_norm)) + (size_t)l * DM;
    norm_phase(C, sx, scx, XS, gain, modl, 3 * kind, 3 * kind + 1, (kind == 2 && last) ? TX : T, (bf16*)(ws + WS_H), fold ? (const h16*)(ws + WS_SLAB) : nullptr);
}
__device__ __forceinline__ void ph_resid(const Ctx& C0_, int blk) {
    const Ctx C = fresh_ctx(C0_);
    ArgsP a = fresh_args(); unsigned char* ws = a->ws; const int l = blk / 3, kind = blk % 3; const bool last = (l == NL - 1);
    const unsigned char* wl = ws + WS_W + (size_t)l * W_LAYER;
    const bool mix = (kind == 1);
    const char* A = (const char*)(ws + (mix ? WS_CC : WS_GU)); const char* B = (const char*)(wl + (mix ? WO_OUT : (kind == 0 ? WO_D1 : WO_D2)));
    const bool with_ctx = mix ? !last : !(kind == 2 && last);
    resid_gemm(C, 10 + blk, A, B, mix ? DM : FF, mix ? DM : FFP, blk == 0, l * 5 * NMOD + (3 * kind + 2) * DM, mix ? 1.0f : 0.5f, with_ctx);
    unsigned* th = dyn_heads(a, 10 + blk) + 512;
    if (blk == 0) tail_items(C, th, TSeg{2, 0, 0, 96}, TSeg{0, 0, CI_IN, CV_IN + CV_OUT});
    else if (blk == 1) tail_items(C, th, TSeg{0, 0, CI_D2, CV_D}, TSeg{0, 0, 0, 0});
    else if (blk == 2) tail_items(C, th, TSeg{2, 1, 96, 96}, TSeg{0, 1, CI_GU1 + CV_GU, CV_GU});
    else if (blk == 3) tail_items(C, th, TSeg{1, 1, 144 + 80, 64}, TSeg{0, 1, CI_IN, CV_IN + CV_OUT});
}

#ifndef PROBE_MASK
#define PROBE_MASK 0
#endif
#define TP_BEGIN(id) do { if ((PROBE_MASK >> (id)) & 1) { if (blockIdx.x == 0 && threadIdx.x == 0) { const unsigned long long t = __builtin_amdgcn_s_memrealtime(); MISC[16] = (unsigned)t; MISC[17] = (unsigned)(t >> 32); } } } while (0)
#define TP_END(id) do { if ((PROBE_MASK >> (id)) & 1) { if (blockIdx.x == 0 && threadIdx.x == 0) { const unsigned long long t0 = ((unsigned long long)MISC[17] << 32) | MISC[16]; \
    const unsigned long long acc = (((unsigned long long)MISC[19] << 32) | MISC[18]) + (__builtin_amdgcn_s_memrealtime() - t0); MISC[18] = (unsigned)acc; MISC[19] = (unsigned)(acc >> 32); } } } while (0)
__global__ void __launch_bounds__(NTHR, 2) dit_fwd(Args a_unused) {
    extern __shared__ __attribute__((aligned(16))) unsigned char lds_raw[];
    Ctx C; C.lds = (LAS unsigned char*)lds_raw; C.wave = __builtin_amdgcn_readfirstlane((int)threadIdx.x >> 6); C.wg = blockIdx.x; C.G = gridDim.x;
    volatile LAS unsigned* MISC = (volatile LAS unsigned*)(C.lds + MISC_OFF);
    for (int u = threadIdx.x; u < (LDS_BYTES - LDSCTL_OFF) / 4; u += NTHR) ((LAS unsigned*)(C.lds + LDSCTL_OFF))[u] = 0u;
    __syncthreads();
    XcdBarrier bar = xcd_barrier_post((unsigned*)(fresh_args()->ws + WS_CTL) + CW_BAR, MISC + 8);

    TP_BEGIN(0); prologue_phase(C, fresh_args()); xcd_barrier(bar); TP_END(0);

    for (int blk = 0; blk < 3 * NL; ++blk) {
        const int l = blk / 3, kind = blk % 3;
        TP_BEGIN(1); ph_norm(C, blk); xcd_barrier(bar); TP_END(1);
        if (kind != 1) { TP_BEGIN(2); ph_gu(C, 2 * l + (kind == 2)); xcd_barrier(bar); TP_END(2); }
        else {
            TP_BEGIN(5); ph_inft(C, l);     xcd_barrier(bar); TP_END(5);
            TP_BEGIN(6); TP_BEGIN(8); ph_prep(C, l); TP_END(8); TP_BEGIN(9); ph_prep_fft(C, l); TP_END(9); xcd_barrier(bar); TP_END(6);
            TP_BEGIN(7); ph_dft(C, l); ph_attn(C, l, (char*)lds_raw); ph_na(C, l, (char*)lds_raw); xcd_barrier(bar); TP_END(7);
        }
        TP_BEGIN(3); ph_resid(C, blk); xcd_barrier(bar); TP_END(3);
    }
    { ArgsP a = fresh_args(); final_phase(C, (const h16*)(a->ws + WS_XS), a->final_norm, a->out); }
    if (PROBE_MASK) { if (blockIdx.x == 0 && threadIdx.x == 0) { const unsigned long long acc = ((unsigned long long)MISC[19] << 32) | MISC[18], t0 = __builtin_amdgcn_s_memrealtime();
        while (__builtin_amdgcn_s_memrealtime() - t0 < acc) __builtin_amdgcn_s_sleep(8); } }
}

extern "C" void kernel_launch(void* const* d_in, const int* in_sizes, int n_in, void* d_out, int out_size, void* d_ws, size_t ws_size, hipStream_t stream) {
    static int grid = 0;
    if (grid == 0) {
        if (n_in != 24 || in_sizes[0] != TX * DM || out_size != TX * DM || ws_size < WS_END) { fprintf(stderr, "kernel_launch: shape/workspace mismatch (n_in %d, in0 %d, out %d, ws %zu < %zu)\n", n_in, n_in > 0 ? in_sizes[0] : -1, out_size, ws_size, (size_t)WS_END); grid = -1; return; }
        int dev = 0, cus = 0, per_cu = 0;
        if (hipGetDevice(&dev) != hipSuccess || hipDeviceGetAttribute(&cus, hipDeviceAttributeMultiprocessorCount, dev) != hipSuccess) { grid = -1; return; }
        if (hipFuncSetAttribute((const void*)dit_fwd, hipFuncAttributeMaxDynamicSharedMemorySize, LDS_BYTES) != hipSuccess) { fprintf(stderr, "kernel_launch: hipFuncSetAttribute failed\n"); grid = -1; return; }
        if (hipOccupancyMaxActiveBlocksPerMultiprocessor(&per_cu, (const void*)dit_fwd, NTHR, LDS_BYTES) != hipSuccess || per_cu < 1) fprintf(stderr, "kernel_launch: occupancy query reports %d\n", per_cu);
        (void)hipGetLastError();
        grid = cus;
    }
    if (grid < 0) return;
    if (hipMemsetAsync((char*)d_ws + WS_CTL, 0, CTL_ZERO_BYTES, stream) != hipSuccess) return;
    Args a{};
    const float* const* in = (const float* const*)d_in;
    a.x = in[0]; a.c = in[1]; a.ctx = in[2]; a.c_ctx = in[3]; a.w_mod = in[4]; a.b_mod = in[5]; a.ffn1_norm = in[6]; a.ffn1_gate = in[7]; a.ffn1_up = in[8]; a.ffn1_down = in[9];
    a.mix_norm = in[10]; a.w_in = in[11]; a.w_out = in[12]; a.pool_w = in[13]; a.pool_scale = in[14]; a.q_norm = in[15]; a.k_norm = in[16]; a.fnet_w = in[17]; a.na_rpb = in[18];
    a.ffn2_norm = in[19]; a.ffn2_gate = in[20]; a.ffn2_up = in[21]; a.ffn2_down = in[22]; a.final_norm = in[23];
    a.out = (float*)d_out; a.ws = (unsigned char*)d_ws;
    hipLaunchKernelGGL(dit_fwd, dim3(grid), dim3(NTHR), LDS_BYTES, stream, a);
    const hipError_t le = hipPeekAtLastError();
    if (le != hipSuccess) fprintf(stderr, "kernel_launch: launch failed: %s\n", hipGetErrorName(le));
}
```
